# Optimizing an MI355X kernel written in HIP

```python
import math
import jax, jax.numpy as jnp
from jax import lax
import numpy as np

D_MODEL = 2048
BATCH = 8
SEQ = 2048
DEPTH = 2

D_RNN = 1024
LRU_BLOCKS = 8
LRU_CONV = 4
LRU_C = 8.0
SSM_D_INNER = 1024
SSM_HEAD_DIM = 64
SSM_HEADS = SSM_D_INNER // SSM_HEAD_DIM
SSM_GROUPS = 2
SSM_D_STATE = 128
SSM_CONV = 4
SSM_CHUNK = 128
SSM_XBC = SSM_D_INNER + 2 * SSM_GROUPS * SSM_D_STATE
ATT_HEAD_DIM = 128
ATT_KV_HEADS = 8
ATT_PATTERNS = ((128, 1), (512, 4), (2048, 16))
ATT_GROUPS = len(ATT_PATTERNS)
ATT_Q_HEADS = ATT_GROUPS * ATT_KV_HEADS
ATT_BLOCK = 128
ATT_D_OUT = ATT_KV_HEADS * ATT_HEAD_DIM
N_BRANCH = 3
IN_SIZES = (N_BRANCH * D_MODEL,
            D_RNN, D_RNN,
            SSM_D_INNER, SSM_XBC, SSM_HEADS,
            ATT_Q_HEADS * ATT_HEAD_DIM, ATT_D_OUT, ATT_D_OUT)
D_IN = sum(IN_SIZES)
N_EXPERTS = 64
EXPERT_DIM = 512
TOP_K = 8
N_EXPERT_GROUPS = 8
TOPK_GROUPS = 4
ROUTED_SCALE = 2.5
MOE_BLOCK = 128
DEEPNORM_ALPHA = (2 * DEPTH) ** 0.25
DEEPNORM_BETA = (8 * DEPTH) ** -0.25
LN_EPS = 1e-5
RMS_EPS = 1e-6

kernel_name = "hybrid_rglru_ssd_dilated_attn_moe"

F32 = jnp.float32


def layer_norm(x, g, b):
    xf = x.astype(F32)
    mu = xf.mean(-1, keepdims=True)
    xc = xf - mu
    var = (xc * xc).mean(-1, keepdims=True)
    return (xc * lax.rsqrt(var + LN_EPS) * g + b).astype(x.dtype)


def causal_dwconv(x, w, b):
    K = w.shape[0]
    T = x.shape[1]
    xp = jnp.pad(x, ((0, 0), (K - 1, 0), (0, 0)))
    return sum(xp[:, k:k + T] * w[k] for k in range(K)) + b


def rglru_branch(xr, gate, conv_w, conv_b, wr, br, wi, bi, lam):
    B, T, _ = xr.shape
    xc = causal_dwconv(xr, conv_w, conv_b)
    xb = xc.reshape(B, T, LRU_BLOCKS, D_RNN // LRU_BLOCKS)
    r = jax.nn.sigmoid((jnp.einsum("btnc,ncd->btnd", xb, wr).reshape(B, T, D_RNN) + br).astype(F32))
    i = jax.nn.sigmoid((jnp.einsum("btnc,ncd->btnd", xb, wi).reshape(B, T, D_RNN) + bi).astype(F32))
    log_a = -LRU_C * r * jax.nn.softplus(-lam.astype(F32))
    a = jnp.exp(log_a)
    u = jnp.sqrt(-jnp.expm1(2.0 * log_a)) * i * xc.astype(F32)

    def combine(left, right):
        a1, u1 = left
        a2, u2 = right
        return a1 * a2, a2 * u1 + u2

    _, h = lax.associative_scan(combine, (a, u), axis=1)
    return (h * jax.nn.gelu(gate.astype(F32))).astype(xr.dtype)


def ssd_chunked(xh, dt, a, bm, cm):
    B, T, H, P = xh.shape
    G, N = bm.shape[2], bm.shape[3]
    HG = H // G
    L = SSM_CHUNK
    NC = T // L
    xdt = (xh * dt[..., None]).reshape(B, NC, L, G, HG, P)
    adt = (dt * a).reshape(B, NC, L, G, HG).transpose(0, 1, 3, 4, 2)
    bc = bm.reshape(B, NC, L, G, N)
    cc = cm.reshape(B, NC, L, G, N)
    a_cum = jnp.cumsum(adt, axis=-1)
    causal = jnp.tril(jnp.ones((L, L), bool))
    seg = a_cum[..., :, None] - a_cum[..., None, :]
    decay = jnp.where(causal, jnp.exp(jnp.where(causal, seg, 0.0)), 0.0)
    cb = jnp.einsum("bclgn,bcsgn->bcgls", cc, bc)
    y_diag = jnp.einsum("bcghls,bcsghp->bclghp", cb[:, :, :, None] * decay, xdt)
    decay_states = jnp.exp(a_cum[..., -1:] - a_cum)
    states = jnp.einsum("bclgn,bcghl,bclghp->bcghpn", bc, decay_states, xdt)
    a_last = a_cum[..., -1]
    cl = jnp.cumsum(a_last, axis=1)
    cl_ex = cl - a_last
    chunk_causal = jnp.tril(jnp.ones((NC, NC), bool), k=-1)[None, :, :, None, None]
    seg_c = cl_ex[:, :, None] - cl[:, None, :]
    decay_c = jnp.where(chunk_causal, jnp.exp(jnp.where(chunk_causal, seg_c, 0.0)), 0.0)
    entering = jnp.einsum("bzcgh,bcghpn->bzghpn", decay_c, states)
    y_off = jnp.einsum("bclgn,bcghpn,bcghl->bclghp", cc, entering, jnp.exp(a_cum))
    return (y_diag + y_off).reshape(B, T, H, P)


def mamba2_branch(z, xbc, dt_raw, conv_w, conv_b, dt_bias, a_log, d_skip, norm_g):
    B, T, _ = z.shape
    xbc = jax.nn.silu(causal_dwconv(xbc, conv_w, conv_b))
    xs = xbc[..., :SSM_D_INNER]
    bm = xbc[..., SSM_D_INNER:SSM_D_INNER + SSM_GROUPS * SSM_D_STATE]
    cm = xbc[..., SSM_D_INNER + SSM_GROUPS * SSM_D_STATE:]
    xh = xs.reshape(B, T, SSM_HEADS, SSM_HEAD_DIM).astype(F32)
    bm = bm.reshape(B, T, SSM_GROUPS, SSM_D_STATE).astype(F32)
    cm = cm.reshape(B, T, SSM_GROUPS, SSM_D_STATE).astype(F32)
    dt = jax.nn.softplus(dt_raw.astype(F32) + dt_bias.astype(F32))
    a = -jnp.exp(a_log.astype(F32))
    y = ssd_chunked(xh, dt, a, bm, cm) + d_skip.astype(F32)[:, None] * xh
    y = y.reshape(B, T, SSM_D_INNER) * jax.nn.silu(z.astype(F32))
    yg = y.reshape(B, T, SSM_GROUPS, SSM_D_INNER // SSM_GROUPS)
    yg = yg * lax.rsqrt((yg * yg).mean(-1, keepdims=True) + RMS_EPS)
    return (yg.reshape(B, T, SSM_D_INNER) * norm_g).astype(z.dtype)


def alibi_slopes(n):
    return 2.0 ** (-8.0 * jnp.arange(1, n + 1, dtype=F32) / n)


def dilated_window_attention(q, k, v, slopes, window, dilation):
    B, T, H, Dh = q.shape
    U = T // dilation
    W = window // dilation
    blk = ATT_BLOCK
    nblk = -(-U // blk)
    U_pad = nblk * blk
    Z = B * dilation

    def to_sub(t):
        t = t.reshape(B, U, dilation, H, Dh).transpose(0, 2, 1, 3, 4).reshape(Z, U, H, Dh)
        return jnp.pad(t, ((0, 0), (0, U_pad - U), (0, 0), (0, 0)))

    def band(t):
        tp = jnp.pad(t, ((0, 0), (blk, 0), (0, 0), (0, 0))).reshape(Z, nblk + 1, blk, H, Dh)
        return jnp.concatenate([tp[:, :-1], tp[:, 1:]], axis=2)

    qb = to_sub(q).reshape(Z, nblk, blk, H, Dh)
    kb = band(to_sub(k))
    vb = band(to_sub(v))
    s = jnp.einsum("znqhd,znkhd->znhqk", qb, kb).astype(F32) * (Dh ** -0.5)
    dist = blk + jnp.arange(blk)[:, None] - jnp.arange(2 * blk)[None, :]
    key_pos = jnp.arange(nblk)[:, None] * blk - blk + jnp.arange(2 * blk)[None, :]
    valid = ((dist >= 0) & (dist <= W))[None] & (key_pos >= 0)[:, None, :]
    s = s - slopes[:, None, None] * (dilation * dist).astype(F32)
    s = jnp.where(valid[None, :, None], s, -jnp.inf)
    m = s.max(-1, keepdims=True)
    p = jnp.exp(s - m)
    l = p.sum(-1, keepdims=True)
    o = jnp.einsum("znhqk,znkhd->znqhd", (p / l).astype(v.dtype), vb)
    lse = (m + jnp.log(l))[..., 0]
    o = o.reshape(B, dilation, U_pad, H, Dh)[:, :, :U].transpose(0, 2, 1, 3, 4).reshape(B, T, H, Dh)
    lse = lse.transpose(0, 1, 3, 2).reshape(B, dilation, U_pad, H)[:, :, :U]
    lse = lse.transpose(0, 2, 1, 3).reshape(B, T, H)
    return o, lse


def attention_branch(q, k, v):
    B, T, _ = q.shape
    q = q.reshape(B, T, ATT_GROUPS, ATT_KV_HEADS, ATT_HEAD_DIM)
    k = k.reshape(B, T, ATT_KV_HEADS, ATT_HEAD_DIM)
    v = v.reshape(B, T, ATT_KV_HEADS, ATT_HEAD_DIM)
    slopes = alibi_slopes(ATT_Q_HEADS).reshape(ATT_GROUPS, ATT_KV_HEADS)
    outs, lses = [], []
    for gi, (window, dilation) in enumerate(ATT_PATTERNS):
        o, lse = dilated_window_attention(q[:, :, gi], k, v, slopes[gi], window, dilation)
        outs.append(o)
        lses.append(lse)
    wts = jax.nn.softmax(jnp.stack(lses), axis=0)
    o = (wts[..., None] * jnp.stack(outs).astype(F32)).sum(0)
    return o.reshape(B, T, ATT_D_OUT).astype(q.dtype)


def hybrid_mixer(x, w_in, b_gate, lru_conv_w, lru_conv_b, lru_wr, lru_br, lru_wi, lru_bi,
                 lru_lambda, ssm_conv_w, ssm_conv_b, ssm_dt_bias, ssm_a_log, ssm_d, ssm_norm_g,
                 w_proj_lru, w_proj_ssm, w_proj_att, w_out):
    B, T, _ = x.shape
    proj = x @ w_in
    splits = np.cumsum(IN_SIZES)[:-1].tolist()
    g_raw, lru_x, lru_g, ssm_z, ssm_xbc, ssm_dt, att_q, att_k, att_v = jnp.split(proj, splits, axis=-1)
    gates = jax.nn.sigmoid((g_raw + b_gate).astype(F32)).reshape(B, T, N_BRANCH, D_MODEL).astype(x.dtype)
    y_lru = rglru_branch(lru_x, lru_g, lru_conv_w, lru_conv_b, lru_wr, lru_br, lru_wi, lru_bi, lru_lambda)
    y_ssm = mamba2_branch(ssm_z, ssm_xbc, ssm_dt, ssm_conv_w, ssm_conv_b, ssm_dt_bias, ssm_a_log, ssm_d, ssm_norm_g)
    y_att = attention_branch(att_q, att_k, att_v)
    merged = (gates[:, :, 0] * (y_lru @ w_proj_lru)
              + gates[:, :, 1] * (y_ssm @ w_proj_ssm)
              + gates[:, :, 2] * (y_att @ w_proj_att))
    return merged @ w_out


def moe_ffn(x2d, router_w, router_bias, w1, w3, w2, ws1, ws3, ws2):
    N, D = x2d.shape
    E, K = N_EXPERTS, TOP_K
    A = N * K
    scores = jax.nn.sigmoid(x2d.astype(F32) @ router_w.astype(F32))
    choice = scores + router_bias.astype(F32)
    grp = choice.reshape(N, N_EXPERT_GROUPS, E // N_EXPERT_GROUPS)
    grp_score = lax.top_k(grp, 2)[0].sum(-1)
    _, grp_idx = lax.top_k(grp_score, TOPK_GROUPS)
    grp_keep = jax.nn.one_hot(grp_idx, N_EXPERT_GROUPS, dtype=F32).sum(1) > 0
    expert_keep = jnp.repeat(grp_keep, E // N_EXPERT_GROUPS, axis=1)
    _, idx = lax.top_k(jnp.where(expert_keep, choice, -jnp.inf), K)
    wts = jnp.take_along_axis(scores, idx, axis=1)
    wts = wts / wts.sum(-1, keepdims=True) * ROUTED_SCALE
    blk = MOE_BLOCK
    nb = (A + E * (blk - 1) + blk - 1) // blk
    P = nb * blk
    e_flat = idx.reshape(A)
    order = jnp.argsort(e_flat)
    e_sorted = e_flat[order]
    counts = jnp.bincount(e_flat, length=E)
    padded = (counts + blk - 1) // blk * blk
    pad_end = jnp.cumsum(padded)
    pad_start = pad_end - padded
    start = jnp.cumsum(counts) - counts
    dest = pad_start[e_sorted] + jnp.arange(A) - start[e_sorted]
    row_tok = jnp.full((P,), N, jnp.int32).at[dest].set((order // K).astype(jnp.int32))
    row_w = jnp.zeros((P,), F32).at[dest].set(wts.reshape(A)[order])
    block_e = jnp.minimum(jnp.searchsorted(pad_end, jnp.arange(nb) * blk, side="right"), E - 1)
    x_pad = jnp.concatenate([x2d, jnp.zeros((1, D), x2d.dtype)], axis=0)

    def expert_block(args):
        tok, wb, e = args
        xb = x_pad[tok]
        hb = jax.nn.silu(xb @ w1[e]) * (xb @ w3[e])
        return (hb @ w2[e]) * wb[:, None].astype(x2d.dtype)

    rows = lax.map(expert_block, (row_tok.reshape(nb, blk), row_w.reshape(nb, blk), block_e))
    routed = jax.ops.segment_sum(rows.reshape(P, D), row_tok, num_segments=N + 1)[:N]
    shared = (jax.nn.silu(x2d @ ws1) * (x2d @ ws3)) @ ws2
    return routed + shared


def setup_inputs(seed: int = 0) -> dict:
    key = jax.random.key(seed)
    ks = iter(jax.random.split(key, 40))
    L, D = DEPTH, D_MODEL
    bs = D_RNN // LRU_BLOCKS

    def nrm(shape, scale):
        return jax.random.normal(next(ks), shape, F32) * scale

    x = nrm((BATCH, SEQ, D), 1.0)
    emb_ln_g = 1.0 + nrm((D,), 0.05)
    emb_ln_b = nrm((D,), 0.02)
    w_in = nrm((L, D, D_IN), D ** -0.5)
    b_gate = nrm((L, N_BRANCH * D), 0.1)
    lru_conv_w = nrm((L, LRU_CONV, D_RNN), LRU_CONV ** -0.5)
    lru_conv_b = nrm((L, D_RNN), 0.02)
    lru_wr = nrm((L, LRU_BLOCKS, bs, bs), bs ** -0.5)
    lru_br = nrm((L, D_RNN), 0.1)
    lru_wi = nrm((L, LRU_BLOCKS, bs, bs), bs ** -0.5)
    lru_bi = nrm((L, D_RNN), 0.1)
    a0 = jax.random.uniform(next(ks), (L, D_RNN), F32, 0.9, 0.999) ** (1.0 / LRU_C)
    lru_lambda = jnp.log(a0) - jnp.log1p(-a0)
    ssm_conv_w = nrm((L, SSM_CONV, SSM_XBC), SSM_CONV ** -0.5)
    ssm_conv_b = nrm((L, SSM_XBC), 0.02)
    dt0 = jnp.exp(jax.random.uniform(next(ks), (L, SSM_HEADS), F32, math.log(1e-3), math.log(1e-1)))
    ssm_dt_bias = dt0 + jnp.log(-jnp.expm1(-dt0))
    ssm_a_log = jnp.log(jax.random.uniform(next(ks), (L, SSM_HEADS), F32, 1.0, 16.0))
    ssm_d = 1.0 + nrm((L, SSM_HEADS), 0.1)
    ssm_norm_g = 1.0 + nrm((L, SSM_D_INNER), 0.05)
    w_proj_lru = nrm((L, D_RNN, D), D_RNN ** -0.5)
    w_proj_ssm = nrm((L, SSM_D_INNER, D), SSM_D_INNER ** -0.5)
    w_proj_att = nrm((L, ATT_D_OUT, D), ATT_D_OUT ** -0.5)
    w_out = nrm((L, D, D), D ** -0.5 * DEEPNORM_BETA)
    ln1_g = 1.0 + nrm((L, D), 0.05)
    ln1_b = nrm((L, D), 0.02)
    router_w = nrm((L, D, N_EXPERTS), D ** -0.5)
    router_bias = nrm((L, N_EXPERTS), 0.01)
    w1 = nrm((L, N_EXPERTS, D, EXPERT_DIM), D ** -0.5)
    w3 = nrm((L, N_EXPERTS, D, EXPERT_DIM), D ** -0.5)
    w2 = nrm((L, N_EXPERTS, EXPERT_DIM, D), EXPERT_DIM ** -0.5 * DEEPNORM_BETA)
    ws1 = nrm((L, D, EXPERT_DIM), D ** -0.5)
    ws3 = nrm((L, D, EXPERT_DIM), D ** -0.5)
    ws2 = nrm((L, EXPERT_DIM, D), EXPERT_DIM ** -0.5 * DEEPNORM_BETA)
    ln2_g = 1.0 + nrm((L, D), 0.05)
    ln2_b = nrm((L, D), 0.02)
    return {"x": x, "emb_ln_g": emb_ln_g, "emb_ln_b": emb_ln_b, "w_in": w_in, "b_gate": b_gate,
            "lru_conv_w": lru_conv_w, "lru_conv_b": lru_conv_b, "lru_wr": lru_wr, "lru_br": lru_br,
            "lru_wi": lru_wi, "lru_bi": lru_bi, "lru_lambda": lru_lambda,
            "ssm_conv_w": ssm_conv_w, "ssm_conv_b": ssm_conv_b, "ssm_dt_bias": ssm_dt_bias,
            "ssm_a_log": ssm_a_log, "ssm_d": ssm_d, "ssm_norm_g": ssm_norm_g,
            "w_proj_lru": w_proj_lru, "w_proj_ssm": w_proj_ssm, "w_proj_att": w_proj_att, "w_out": w_out,
            "ln1_g": ln1_g, "ln1_b": ln1_b, "router_w": router_w, "router_bias": router_bias,
            "w1": w1, "w3": w3, "w2": w2, "ws1": ws1, "ws3": ws3, "ws2": ws2,
            "ln2_g": ln2_g, "ln2_b": ln2_b}


def reference(x, emb_ln_g, emb_ln_b, w_in, b_gate, lru_conv_w, lru_conv_b, lru_wr, lru_br,
              lru_wi, lru_bi, lru_lambda, ssm_conv_w, ssm_conv_b, ssm_dt_bias, ssm_a_log, ssm_d,
              ssm_norm_g, w_proj_lru, w_proj_ssm, w_proj_att, w_out, ln1_g, ln1_b, router_w,
              router_bias, w1, w3, w2, ws1, ws3, ws2, ln2_g, ln2_b):
    B, T, D = x.shape
    h = layer_norm(x, emb_ln_g, emb_ln_b)
    for l in range(DEPTH):
        mix = hybrid_mixer(h, w_in[l], b_gate[l], lru_conv_w[l], lru_conv_b[l], lru_wr[l], lru_br[l],
                           lru_wi[l], lru_bi[l], lru_lambda[l], ssm_conv_w[l], ssm_conv_b[l],
                           ssm_dt_bias[l], ssm_a_log[l], ssm_d[l], ssm_norm_g[l],
                           w_proj_lru[l], w_proj_ssm[l], w_proj_att[l], w_out[l])
        h = layer_norm(DEEPNORM_ALPHA * h + mix, ln1_g[l], ln1_b[l])
        ffn = moe_ffn(h.reshape(B * T, D), router_w[l], router_bias[l], w1[l], w3[l], w2[l],
                      ws1[l], ws3[l], ws2[l]).reshape(B, T, D)
        h = layer_norm(DEEPNORM_ALPHA * h + ffn, ln2_g[l], ln2_b[l])
    return h
```

```cpp
#include <hip/hip_runtime.h>
#include <cstdio>
#include <cstdint>

#ifndef MK_ONE
#define MK_ONE 1
#endif

#define LAS __attribute__((address_space(3)))
typedef unsigned short bf16;
typedef short bf16x8 __attribute__((ext_vector_type(8)));
typedef float f32x4 __attribute__((ext_vector_type(4)));
typedef float f32x2 __attribute__((ext_vector_type(2)));
typedef unsigned u32x4 __attribute__((ext_vector_type(4)));
typedef unsigned u32x2 __attribute__((ext_vector_type(2)));

constexpr int D = 2048, NBATCH = 8, T = 2048, M = NBATCH * T, DEPTH = 2;
constexpr int D_IN = 15888;
constexpr int LD = 16128;
constexpr int COL_G = 0, COL_LX = 6144, COL_LG = 7168, COL_Z = 8192, COL_XBC = 9216, COL_Q = 10752, COL_K = 13824, COL_V = 14848, COL_DT = 15872;
constexpr int NE = 64, EDIM = 512, TOPK = 8;
constexpr float LN_EPS = 1e-5f, RMS_EPS = 1e-6f, ALPHA = 1.41421356237f;
constexpr int NPH = 11;

constexpr size_t MiB = 1u << 20;
constexpr size_t WS_CTL = 0, CTL_BYTES = 1 * MiB;
constexpr size_t WS_LTS = 2 * MiB, WS_LW = 6 * MiB;
constexpr size_t WS_ALAST = 10 * MiB;
constexpr size_t WS_LSE = 11 * MiB;
constexpr size_t WS_W = 16 * MiB;
constexpr size_t W_IN = 0, W_PL = 63 * MiB, W_PS = 67 * MiB, W_PA = 71 * MiB, W_OUT = 75 * MiB, W_LR = 83 * MiB, W_LI = W_LR + 262144, W_UP = 84 * MiB, W_DN = 344 * MiB;
constexpr size_t WS_H = 490 * MiB, WS_HB = 618 * MiB, WS_H1 = 682 * MiB, WS_H1B = 810 * MiB;
constexpr size_t WS_PROJ = 874 * MiB;
constexpr size_t WS_PRE = WS_PROJ, WS_Y = WS_PROJ;
constexpr size_t WS_YL = 1450 * MiB, WS_YS = 1482 * MiB, WS_YA = 1514 * MiB, WS_OG = 1546 * MiB;
constexpr size_t WS_HID = WS_YL;
constexpr size_t WS_SST = 1644 * MiB;
constexpr size_t WS_MF = 1708 * MiB, WS_MB = 1836 * MiB, WS_END = 1900 * MiB;
constexpr int CW_BAR = 4096;
constexpr int CW_CNT = 16384;

constexpr int LDS_BYTES = 147456;
constexpr int MISC_OFF = 147456 - 64;

#define LDS_WAIT() asm volatile("s_waitcnt lgkmcnt(0)" ::: "memory")
#define VM_WAIT() asm volatile("s_waitcnt vmcnt(0)" ::: "memory")
__device__ __forceinline__ float bf2f(unsigned v) { return __uint_as_float(v << 16); }
__device__ __forceinline__ float bflo(unsigned w) { return __uint_as_float(w << 16); }
__device__ __forceinline__ float bfhi(unsigned w) { return __uint_as_float(w & 0xffff0000u); }
__device__ __forceinline__ unsigned pk2(float lo, float hi) { unsigned r; asm volatile("v_cvt_pk_bf16_f32 %0, %1, %2" : "=v"(r) : "v"(lo), "v"(hi)); return r; }
__device__ __forceinline__ float sigmoidf_(float x) { return __builtin_amdgcn_rcpf(1.0f + __expf(-x)); }
__device__ __forceinline__ float siluf_(float x) { return x * sigmoidf_(x); }
__device__ __forceinline__ float softplusf_(float x) { return x > 20.f ? x : log1pf(__expf(x)); }
__device__ __forceinline__ float gelu_tanh(float x) { const float u = 0.7978845608f * (x + 0.044715f * x * x * x); const float t = 1.0f - 2.0f * __builtin_amdgcn_rcpf(1.0f + __expf(2.0f * u)); return 0.5f * x * (1.0f + t); }
__device__ __forceinline__ float wave_sum(float v) {
#pragma unroll
    for (int o = 1; o < 64; o <<= 1) v += __shfl_xor(v, o);
    return v;
}
__device__ __forceinline__ bf16x8 as_bf16x8(u32x4 v) { return __builtin_bit_cast(bf16x8, v); }
__device__ __forceinline__ void tr_read2(unsigned a0, unsigned a1, u32x2& r0, u32x2& r1) {
    asm volatile("ds_read_b64_tr_b16 %0, %2\n\tds_read_b64_tr_b16 %1, %3\n\ts_waitcnt lgkmcnt(0)" : "=&v"(r0), "=&v"(r1) : "v"(a0), "v"(a1) : "memory");
}

namespace pg8 {
constexpr int BM = 256, BK = 64, HALF = 128, HTB = HALF * BK * 2, STAGE_BYTES = 8 * HTB;
__device__ __forceinline__ int lds_byte(int r, int c) { const int st = (r >> 4) * 2 + (c >> 5), rr = r & 15, cc = c & 31, ob = rr * 64 + cc * 2; return st * 1024 + (ob ^ (((ob >> 9) & 1) << 5)); }
__device__ __forceinline__ void stage_rc(int b, int& R, int& C) { const int st = b / 1024, sb = b % 1024, swz = sb ^ (((sb >> 9) & 1) << 5); R = (st >> 1) * 16 + swz / 64; C = (st & 1) * 32 + (swz % 64) / 2; }
__device__ __forceinline__ int perm32(int rho) { const int n = rho >> 4, i = rho & 15; return 8 * (i >> 2) + 4 * n + (i & 3); }

template <class Epi, class Sched>
__device__ __forceinline__ void gemm_phase(LAS unsigned char* lds, const char* Abase, const int K, const Sched& S, const Epi& E, const int tid) {
    const int wid = __builtin_amdgcn_readfirstlane(tid >> 6), lane = tid & 63, wr = wid >> 2, wc = wid & 3, fr = lane & 15, fq = lane >> 4;
    const int nt = K / BK;
    unsigned voffB[2];
#pragma unroll
    for (int i = 0; i < 2; ++i) { int R, C; stage_rc(tid * 16 + i * 8192, R, C); const int Rb = Epi::PERM ? ((R & ~31) + perm32(R & 31)) : R; voffB[i] = (unsigned)(Rb * K + C) * 2u; }
    const size_t kstep = (size_t)(BK * 2);
    const size_t hstep = (size_t)HALF * K * 2;
    const unsigned ldsw = (unsigned)wid * 1024u;
    const int aoff = lds_byte(wr * 64 + fr, fq * 8), boff = lds_byte(wc * 32 + fr, fq * 8);
#define PG8_SA(b, h) (((b) * 2 + (h)) * HTB)
#define PG8_SB(b, h) ((4 + (b) * 2 + (h)) * HTB)
#define PG8_STAGE(bufoff, gbase, voff) do { _Pragma("unroll") for (int _i = 0; _i < 2; ++_i) \
        __builtin_amdgcn_global_load_lds((const unsigned*)((const char*)(gbase) + (voff)[_i]), (LAS unsigned*)(lds + (bufoff) + ldsw + _i * 8192), 16, 0, 0); } while (0)
#define PG8_LDA(dst, b, h) do { _Pragma("unroll") for (int m = 0; m < 4; ++m) _Pragma("unroll") for (int k = 0; k < 2; ++k) dst[m][k] = *(const LAS bf16x8*)(lds + PG8_SA(b, h) + aoff + m * 2048 + k * 1024); } while (0)
#define PG8_LDB(dst, b, h) do { _Pragma("unroll") for (int n = 0; n < 2; ++n) _Pragma("unroll") for (int k = 0; k < 2; ++k) dst[n][k] = *(const LAS bf16x8*)(lds + PG8_SB(b, h) + boff + n * 2048 + k * 1024); } while (0)
#define PG8_MMA(ai, bj, At, Bt) do { __builtin_amdgcn_s_setprio(1); _Pragma("unroll") for (int m = 0; m < 4; ++m) _Pragma("unroll") for (int n = 0; n < 2; ++n) _Pragma("unroll") for (int k = 0; k < 2; ++k) \
        acc[ai][bj][m][n] = __builtin_amdgcn_mfma_f32_16x16x32_bf16(Bt[n][k], At[m][k], acc[ai][bj][m][n], 0, 0, 0); __builtin_amdgcn_s_setprio(0); } while (0)
#define PG8_WAIT_V(n) asm volatile("s_waitcnt vmcnt(" #n ")" ::: "memory")
#define PG8_WAIT_L(n) asm volatile("s_waitcnt lgkmcnt(" #n ")" ::: "memory")
#define PG8_BAR __builtin_amdgcn_s_barrier()
#define PG8_SCHED __builtin_amdgcn_sched_barrier(0)
    typename Sched::Unit cur, nxt; int ui = 0;
    if (!S.next(0, cur)) return;
    f32x4 acc[2][2][4][2];
#pragma unroll
    for (int a = 0; a < 2; ++a)
#pragma unroll
        for (int b = 0; b < 2; ++b)
#pragma unroll
            for (int m = 0; m < 4; ++m)
#pragma unroll
                for (int n = 0; n < 2; ++n) acc[a][b][m][n] = (f32x4){0.f, 0.f, 0.f, 0.f};
    bf16x8 At[4][2], B0[2][2], B1[2][2];
    unsigned oc[2][2];
    S.aoffs(cur, tid, oc);
    const char* cB = S.bptr(cur);
    PG8_STAGE(PG8_SB(0, 0), cB, voffB); PG8_STAGE(PG8_SA(0, 0), Abase, oc[0]); PG8_STAGE(PG8_SB(0, 1), cB + hstep, voffB); PG8_STAGE(PG8_SA(0, 1), Abase, oc[1]);
    if (wr == 1) PG8_BAR;
    PG8_WAIT_V(4); PG8_BAR;
    PG8_STAGE(PG8_SB(1, 0), cB + kstep, voffB); PG8_STAGE(PG8_SA(1, 0), Abase + kstep, oc[0]); PG8_STAGE(PG8_SB(1, 1), cB + hstep + kstep, voffB);
    PG8_WAIT_V(6); PG8_BAR;
    for (;;) {
        const bool has_next = S.next(ui + 1, nxt);
        const char* nB = has_next ? S.bptr(nxt) : cB;
        for (int t = 0; t < nt; t += 2) {
            const bool last = (t == nt - 2);
            const char* a1 = Abase + (size_t)(t + 1) * kstep;
            const char* a2 = last ? Abase : Abase + (size_t)(t + 2) * kstep; const char* b2 = last ? nB : cB + (size_t)(t + 2) * kstep;
            const char* a3 = a2 + kstep; const char* b3 = b2 + kstep;
            PG8_LDB(B0, 0, 0); PG8_SCHED; PG8_LDA(At, 0, 0); PG8_STAGE(PG8_SA(1, 1), a1, oc[1]);
            PG8_WAIT_L(8); PG8_BAR; PG8_WAIT_L(0); PG8_MMA(0, 0, At, B0); PG8_BAR; PG8_SCHED;
            if (last && has_next) S.aoffs(nxt, tid, oc);
            PG8_LDB(B1, 0, 1); PG8_STAGE(PG8_SB(0, 0), b2, voffB);
            PG8_BAR; PG8_WAIT_L(0); PG8_MMA(0, 1, At, B1); PG8_BAR;
            PG8_LDA(At, 0, 1); PG8_STAGE(PG8_SA(0, 0), a2, oc[0]);
            PG8_BAR; PG8_WAIT_L(0); PG8_MMA(1, 0, At, B0); PG8_BAR; PG8_SCHED;
            PG8_STAGE(PG8_SB(0, 1), b2 + hstep, voffB);
            PG8_WAIT_V(6); PG8_BAR; PG8_MMA(1, 1, At, B1); PG8_BAR;
            PG8_LDB(B0, 1, 0); PG8_SCHED; PG8_LDA(At, 1, 0); PG8_STAGE(PG8_SA(0, 1), a2, oc[1]);
            PG8_WAIT_L(8); PG8_BAR; PG8_WAIT_L(0); PG8_MMA(0, 0, At, B0); PG8_BAR; PG8_SCHED;
            PG8_LDB(B1, 1, 1); PG8_STAGE(PG8_SB(1, 0), b3, voffB);
            PG8_BAR; PG8_WAIT_L(0); PG8_MMA(0, 1, At, B1); PG8_BAR;
            PG8_LDA(At, 1, 1); PG8_STAGE(PG8_SA(1, 0), a3, oc[0]);
            PG8_BAR; PG8_WAIT_L(0); PG8_MMA(1, 0, At, B0); PG8_BAR; PG8_SCHED;
            PG8_STAGE(PG8_SB(1, 1), b3 + hstep, voffB);
            PG8_WAIT_V(6); PG8_BAR; PG8_MMA(1, 1, At, B1); PG8_BAR;
        }
        if (wr == 0) PG8_BAR;
        E(acc, cur, wr, wc, fr, fq);
        if (!has_next) break;
#pragma unroll
        for (int a = 0; a < 2; ++a)
#pragma unroll
            for (int b = 0; b < 2; ++b)
#pragma unroll
                for (int m = 0; m < 4; ++m)
#pragma unroll
                    for (int n = 0; n < 2; ++n) acc[a][b][m][n] = (f32x4){0.f, 0.f, 0.f, 0.f};
        cur = nxt; cB = nB; ++ui;
        if (wr == 1) PG8_BAR;
    }
    PG8_WAIT_V(0);
    PG8_BAR;
#undef PG8_SA
#undef PG8_SB
#undef PG8_STAGE
#undef PG8_LDA
#undef PG8_LDB
#undef PG8_MMA
#undef PG8_WAIT_V
#undef PG8_WAIT_L
#undef PG8_BAR
#undef PG8_SCHED
}
}

struct DenseUnit { int pm, pn; };
struct DenseSched {
    typedef DenseUnit Unit;
    int nM, nN, nwg, G, c, K; const char* Bt;
    __device__ __forceinline__ void init(int M_, int N_, int K_, int G_, int c_, const void* Bt_) { nM = M_ / 256; nN = N_ / 256; nwg = nM * nN; G = G_; c = c_; K = K_; Bt = (const char*)Bt_; }
    __device__ __forceinline__ bool next(int i, Unit& u) const {
        const long L = (long)i * G + c; if (L >= nwg) return false;
        int wgid = (int)L; { const int q = nwg / 8, r = nwg % 8, xcd = wgid % 8, off = wgid / 8; wgid = (xcd < r ? xcd * (q + 1) : r * (q + 1) + (xcd - r) * q) + off; }
        const int nig = 8 * nN, gid = wgid / nig, fm = gid * 8, gsz = (nM - fm) < 8 ? (nM - fm) : 8;
        u.pm = fm + ((wgid % nig) % gsz); u.pn = (wgid % nig) / gsz; return true;
    }
    __device__ __forceinline__ const char* bptr(const Unit& u) const { return Bt + (size_t)u.pn * 256 * K * 2; }
    __device__ __forceinline__ void aoffs(const Unit& u, int tid, unsigned (&o)[2][2]) const {
#pragma unroll
        for (int i = 0; i < 2; ++i) { int R, C; pg8::stage_rc(tid * 16 + i * 8192, R, C);
#pragma unroll
            for (int h = 0; h < 2; ++h) o[h][i] = (unsigned)((u.pm * 256 + 128 * h + R) * K + C) * 2u; }
    }
};
struct MoeUnit { int e, rb, pn, nvalid, blk; };
template <bool UP> struct MoeSched {
    typedef MoeUnit Unit;
    int G, c, NBr, nunits; int pend, cntl;
    const int* lts; const char* W;
    static constexpr int NPN = UP ? 4 : 8;
    __device__ __forceinline__ void init(int G_, int c_, const unsigned* cnt, const int* lts_, const void* W_, int lane) {
        G = G_; c = c_; lts = lts_; W = (const char*)W_;
        cntl = (int)cnt[lane * 16]; int nb = (cntl + 255) >> 8; int s = nb;
#pragma unroll
        for (int o = 1; o < 64; o <<= 1) { const int t = __shfl_up(s, o); if (lane >= o) s += t; }
        pend = s; NBr = __builtin_amdgcn_readlane(s, 63); nunits = (NBr + 64) * NPN;
    }
    __device__ __forceinline__ bool next(int i, Unit& u) const {
        const long L = (long)i * G + c; if (L >= nunits) return false;
        const int blk = (int)L / NPN; u.pn = (int)L % NPN; u.blk = blk;
        if (blk < NBr) {
            const int e = __builtin_amdgcn_readfirstlane(__popcll(__ballot(pend <= blk)));
            const int st = e ? __builtin_amdgcn_readlane(pend, e - 1) : 0;
            const int ce = __builtin_amdgcn_readlane(cntl, e);
            u.e = e; u.rb = blk - st; const int rem = ce - u.rb * 256; u.nvalid = rem < 256 ? rem : 256;
        } else { u.e = 64; u.rb = blk - NBr; u.nvalid = 256; }
        return true;
    }
    __device__ __forceinline__ const char* bptr(const Unit& u) const {
        return UP ? W + ((size_t)u.e * 1024 + (size_t)u.pn * 256) * 2048 * 2 : W + ((size_t)u.e * 2048 + (size_t)u.pn * 256) * 512 * 2;
    }
    __device__ __forceinline__ void aoffs(const Unit& u, int tid, unsigned (&o)[2][2]) const {
#pragma unroll
        for (int i = 0; i < 2; ++i) { int R, C; pg8::stage_rc(tid * 16 + i * 8192, R, C);
#pragma unroll
            for (int h = 0; h < 2; ++h) {
                const int r = 128 * h + R;
                if (UP) {
                    int tok;
                    if (u.e < 64) { tok = 0; if (r < u.nvalid) tok = lts[u.e * 16384 + u.rb * 256 + r] >> 4; }
                    else tok = u.rb * 256 + r;
                    o[h][i] = (unsigned)(tok * 2048 + C) * 2u;
                } else o[h][i] = (unsigned)((u.blk * 256 + r) * 512 + C) * 2u;
            } }
    }
};

struct EpiStoreBf16 {
    static constexpr bool PERM = true;
    bf16* O; int ldc;
    __device__ __forceinline__ void operator()(const f32x4 (&acc)[2][2][4][2], const DenseUnit& u, int wr, int wc, int fr, int fq) const {
        const int row0 = u.pm * 256 + wr * 64 + fr, col0 = u.pn * 256 + wc * 32 + 8 * fq;
#pragma unroll
        for (int ai = 0; ai < 2; ++ai)
#pragma unroll
            for (int m = 0; m < 4; ++m) { bf16* rowp = O + (size_t)(row0 + ai * 128 + m * 16) * ldc + col0;
#pragma unroll
                for (int bj = 0; bj < 2; ++bj) { const f32x4 v0 = acc[ai][bj][m][0], v1 = acc[ai][bj][m][1];
                    u32x4 w; w.x = pk2(v0[0], v0[1]); w.y = pk2(v0[2], v0[3]); w.z = pk2(v1[0], v1[1]); w.w = pk2(v1[2], v1[3]);
                    *(u32x4*)(rowp + bj * 128) = w; } }
    }
};
template <int MODE> struct EpiGate {
    static constexpr bool PERM = true;
    const bf16* proj; const float* bg; float* mf; bf16* mb; int gcol;
    __device__ __forceinline__ void operator()(const f32x4 (&acc)[2][2][4][2], const DenseUnit& u, int wr, int wc, int fr, int fq) const {
        const int row0 = u.pm * 256 + wr * 64 + fr, col0 = u.pn * 256 + wc * 32 + 8 * fq;
        f32x4 bv[2][2];
#pragma unroll
        for (int bj = 0; bj < 2; ++bj) { bv[bj][0] = *(const f32x4*)(bg + gcol + col0 + bj * 128); bv[bj][1] = *(const f32x4*)(bg + gcol + col0 + bj * 128 + 4); }
#pragma unroll
        for (int ai = 0; ai < 2; ++ai)
#pragma unroll
            for (int m = 0; m < 4; ++m) { const size_t row = (size_t)(row0 + ai * 128 + m * 16);
#pragma unroll
                for (int bj = 0; bj < 2; ++bj) {
                    const u32x4 gr = *(const u32x4*)(proj + row * LD + COL_G + gcol + col0 + bj * 128);
                    f32x4 g0, g1;
                    g0[0] = sigmoidf_(bflo(gr.x) + bv[bj][0][0]); g0[1] = sigmoidf_(bfhi(gr.x) + bv[bj][0][1]); g0[2] = sigmoidf_(bflo(gr.y) + bv[bj][0][2]); g0[3] = sigmoidf_(bfhi(gr.y) + bv[bj][0][3]);
                    g1[0] = sigmoidf_(bflo(gr.z) + bv[bj][1][0]); g1[1] = sigmoidf_(bfhi(gr.z) + bv[bj][1][1]); g1[2] = sigmoidf_(bflo(gr.w) + bv[bj][1][2]); g1[3] = sigmoidf_(bfhi(gr.w) + bv[bj][1][3]);
                    f32x4 v0 = acc[ai][bj][m][0] * g0, v1 = acc[ai][bj][m][1] * g1;
                    float* mp = mf + row * D + col0 + bj * 128;
                    if (MODE >= 1) { v0 += *(const f32x4*)mp; v1 += *(const f32x4*)(mp + 4); }
                    if (MODE <= 1) { *(f32x4*)mp = v0; *(f32x4*)(mp + 4) = v1; }
                    else { u32x4 w; w.x = pk2(v0[0], v0[1]); w.y = pk2(v0[2], v0[3]); w.z = pk2(v1[0], v1[1]); w.w = pk2(v1[2], v1[3]); *(u32x4*)(mb + row * D + col0 + bj * 128) = w; }
                }
                asm volatile("" ::: "memory"); }
    }
};
struct EpiResid {
    static constexpr bool PERM = false;
    const float* h; float* pre;
    __device__ __forceinline__ void operator()(const f32x4 (&acc)[2][2][4][2], const DenseUnit& u, int wr, int wc, int fr, int fq) const {
        const int row0 = u.pm * 256 + wr * 64 + fr, col0 = u.pn * 256 + wc * 32 + 4 * fq;
#pragma unroll
        for (int ai = 0; ai < 2; ++ai)
#pragma unroll
            for (int m = 0; m < 4; ++m) { const size_t off = (size_t)(row0 + ai * 128 + m * 16) * D + col0;
#pragma unroll
                for (int bj = 0; bj < 2; ++bj)
#pragma unroll
                    for (int n = 0; n < 2; ++n) { const f32x4 hv = *(const f32x4*)(h + off + bj * 128 + n * 16); *(f32x4*)(pre + off + bj * 128 + n * 16) = hv * ALPHA + acc[ai][bj][m][n]; }
                asm volatile("" ::: "memory"); }
    }
};
struct EpiMoeUp {
    static constexpr bool PERM = true;
    bf16* H;
    __device__ __forceinline__ void operator()(const f32x4 (&acc)[2][2][4][2], const MoeUnit& u, int wr, int wc, int fr, int fq) const {
        const int row0 = u.blk * 256 + wr * 64 + fr, col0 = u.pn * 128 + wc * 32 + 8 * fq;
#pragma unroll
        for (int ai = 0; ai < 2; ++ai)
#pragma unroll
            for (int m = 0; m < 4; ++m) {
                const f32x4 g0 = acc[ai][0][m][0], g1 = acc[ai][0][m][1], u0 = acc[ai][1][m][0], u1 = acc[ai][1][m][1];
                u32x4 w; w.x = pk2(siluf_(g0[0]) * u0[0], siluf_(g0[1]) * u0[1]); w.y = pk2(siluf_(g0[2]) * u0[2], siluf_(g0[3]) * u0[3]);
                w.z = pk2(siluf_(g1[0]) * u1[0], siluf_(g1[1]) * u1[1]); w.w = pk2(siluf_(g1[2]) * u1[2], siluf_(g1[3]) * u1[3]);
                *(u32x4*)(H + (size_t)(row0 + ai * 128 + m * 16) * 512 + col0) = w; }
    }
};
struct EpiMoeDown {
    static constexpr bool PERM = true;
    const int* lts; const float* lw; bf16* Y;
    __device__ __forceinline__ void operator()(const f32x4 (&acc)[2][2][4][2], const MoeUnit& u, int wr, int wc, int fr, int fq) const {
        const int col0 = u.pn * 256 + wc * 32 + 8 * fq;
#pragma unroll
        for (int ai = 0; ai < 2; ++ai)
#pragma unroll
            for (int m = 0; m < 4; ++m) { const int r = ai * 128 + wr * 64 + m * 16 + fr;
                if (r < u.nvalid) {
                    int dest; float w;
                    if (u.e < 64) { const int p = u.e * 16384 + u.rb * 256 + r; const int ts = lts[p]; w = lw[p]; dest = (ts >> 4) * 9 + (ts & 15); }
                    else { dest = (u.rb * 256 + r) * 9 + 8; w = 1.0f; }
                    bf16* rowp = Y + (size_t)dest * D + col0;
#pragma unroll
                    for (int bj = 0; bj < 2; ++bj) { const f32x4 v0 = acc[ai][bj][m][0] * w, v1 = acc[ai][bj][m][1] * w;
                        u32x4 o; o.x = pk2(v0[0], v0[1]); o.y = pk2(v0[2], v0[3]); o.z = pk2(v1[0], v1[1]); o.w = pk2(v1[2], v1[3]);
                        *(u32x4*)(rowp + bj * 128) = o; }
                }
                asm volatile("" ::: "memory"); }
    }
};

#define XB_TMO      128
#define XB_XCNT(j)  (256  + 64 * (j))
#define XB_XSUB(j)  (1280 + 64 * (j))
#define XB_XGEN(j)  (2304 + 64 * (j))
#define XB_TOP      3328
#define XB_TOPGEN   3392
#define XCD_BAR_WORDS 3456
#define XB_SPIN_CAP (1u << 18)
__device__ __forceinline__ unsigned xb_ld(unsigned* p)              { return __hip_atomic_load(p, __ATOMIC_RELAXED, __HIP_MEMORY_SCOPE_AGENT); }
__device__ __forceinline__ unsigned xb_add(unsigned* p, unsigned v) { return __hip_atomic_fetch_add(p, v, __ATOMIC_RELAXED, __HIP_MEMORY_SCOPE_AGENT); }
__device__ __forceinline__ unsigned xb_xcc_id() { return (unsigned)__builtin_amdgcn_s_getreg((3 << 11) | 20) & 0xFu; }
#define XB_SPIN(cond, bar) do { unsigned _sp = 0; while (cond) { __builtin_amdgcn_s_sleep(1); \
    if ((++_sp & 255u) == 0u) { if (xb_ld(&(bar)[XB_TMO])) break; if (_sp > XB_SPIN_CAP) { atomicAdd(&(bar)[XB_TMO], 1u); break; } } } } while (0)
struct XcdBarrier { unsigned* bar; unsigned x; volatile LAS unsigned* st; };
__device__ __forceinline__ XcdBarrier xcd_barrier_post(unsigned* bar, volatile LAS unsigned* st) {
    XcdBarrier b; b.bar = bar; b.x = xb_xcc_id(); b.st = st;
    if (threadIdx.x == 0) (void)xb_add(&bar[XB_XCNT(b.x)], 1u);
    return b;
}
__device__ __forceinline__ void xcd_barrier_complete(unsigned* bar, unsigned x, unsigned& nloc, unsigned& nx) {
    const unsigned G = gridDim.x * gridDim.y * gridDim.z;
    unsigned sum, cnt, mine, sp = 0u;
    for (;;) {
        sum = 0u; cnt = 0u; mine = 0u;
#pragma unroll
        for (unsigned j = 0; j < 16; ++j) { const unsigned c = xb_ld(&bar[XB_XCNT(j)]); sum += c; cnt += (c > 0u) ? 1u : 0u; mine = (j == x) ? c : mine; }
        if (sum == G) break;
        __builtin_amdgcn_s_sleep(1);
        if ((++sp & 255u) == 0u) { if (xb_ld(&bar[XB_TMO])) break; if (sp > XB_SPIN_CAP) { atomicAdd(&bar[XB_TMO], 1u); break; } }
    }
    nloc = mine > 0u ? mine : 1u; nx = cnt > 0u ? cnt : 1u;
}
__device__ __forceinline__ void xcd_barrier(const XcdBarrier& b) {
    asm volatile("s_waitcnt vmcnt(0)" ::: "memory");
    __syncthreads();
    if (threadIdx.x == 0) {
        unsigned* bar = b.bar;
        __builtin_amdgcn_s_waitcnt(0);
        unsigned nloc = b.st[0], nx = b.st[1];
        if (nloc == 0u) { xcd_barrier_complete(bar, b.x, nloc, nx); b.st[0] = nloc; b.st[1] = nx; }
        const unsigned old = xb_add(&bar[XB_XSUB(b.x)], 1u);
        const unsigned gen = old / nloc;
        if (old + 1u == (gen + 1u) * nloc) {
            __builtin_amdgcn_fence(__ATOMIC_RELEASE, "agent");
            asm volatile("s_waitcnt vmcnt(0)" ::: "memory");
            const unsigned og = xb_add(&bar[XB_TOP], 1u);
            const unsigned tg = og / nx;
            if (og + 1u == (tg + 1u) * nx) xb_add(&bar[XB_TOPGEN], 1u);
            else XB_SPIN(xb_ld(&bar[XB_TOPGEN]) == tg, bar);
            __builtin_amdgcn_fence(__ATOMIC_ACQUIRE, "agent");
            xb_add(&bar[XB_XGEN(b.x)], 1u);
            asm volatile("s_waitcnt vmcnt(0)" ::: "memory");
        } else {
            XB_SPIN(xb_ld(&bar[XB_XGEN(b.x)]) == gen, bar);
            __builtin_amdgcn_fence(__ATOMIC_ACQUIRE, "agent");
            asm volatile("s_waitcnt vmcnt(0)" ::: "memory");
        }
    }
    __syncthreads();
}

typedef const float* cfp_t;
typedef const cfp_t __attribute__((address_space(4)))* InTab;
__device__ __forceinline__ void cvt_item(const float* W, int ld, int Kd, bf16* WT, LAS float* scr, int k0, int nsrc, int drow, int nvalid, int lane) {
    const int nn = lane & 31;
#pragma unroll 8
    for (int i = 0; i < 32; ++i) { const int kk = 2 * i + (lane >> 5); scr[kk * 33 + nn] = (nn < nvalid) ? W[(size_t)(k0 + kk) * ld + nsrc + nn] : 0.f; }
    LDS_WAIT(); asm volatile("" ::: "memory");
    const int c = lane & 7;
#pragma unroll
    for (int j = 0; j < 4; ++j) { const int n = (lane >> 3) + 8 * j; const LAS float* s = scr + (8 * c) * 33 + n;
        u32x4 o; o.x = pk2(s[0 * 33], s[1 * 33]); o.y = pk2(s[2 * 33], s[3 * 33]); o.z = pk2(s[4 * 33], s[5 * 33]); o.w = pk2(s[6 * 33], s[7 * 33]);
        if (n < nvalid) *(u32x4*)(WT + (size_t)(drow + n) * Kd + k0 + 8 * c) = o; }
    LDS_WAIT(); asm volatile("" ::: "memory");
}
__device__ __forceinline__ void ln_store(float (&v)[4][8], const float* g, const float* b, int lane, float* of, bf16* ob) {
    float s = 0.f;
#pragma unroll
    for (int j = 0; j < 4; ++j)
#pragma unroll
        for (int e = 0; e < 8; ++e) s += v[j][e];
    const float mean = wave_sum(s) * (1.f / D); float s2 = 0.f;
#pragma unroll
    for (int j = 0; j < 4; ++j)
#pragma unroll
        for (int e = 0; e < 8; ++e) { v[j][e] -= mean; s2 += v[j][e] * v[j][e]; }
    const float rstd = 1.f / sqrtf(wave_sum(s2) * (1.f / D) + LN_EPS);
#pragma unroll
    for (int j = 0; j < 4; ++j) { const int c0 = 512 * j + 8 * lane;
        const f32x4 g0 = *(const f32x4*)(g + c0), g1 = *(const f32x4*)(g + c0 + 4), b0 = *(const f32x4*)(b + c0), b1 = *(const f32x4*)(b + c0 + 4);
        f32x4 y0, y1;
#pragma unroll
        for (int e = 0; e < 4; ++e) { y0[e] = v[j][e] * rstd * g0[e] + b0[e]; y1[e] = v[j][4 + e] * rstd * g1[e] + b1[e]; }
        if (of) { *(f32x4*)(of + c0) = y0; *(f32x4*)(of + c0 + 4) = y1; }
        if (ob) { u32x4 w; w.x = pk2(y0[0], y0[1]); w.y = pk2(y0[2], y0[3]); w.z = pk2(y1[0], y1[1]); w.w = pk2(y1[2], y1[3]); *(u32x4*)(ob + c0) = w; } }
}
__device__ __forceinline__ void p0_convert(LAS unsigned char* lds, InTab in, int l, unsigned char* wbase, int gw, int NGW, int wave, int lane) {
    LAS float* scr = (LAS float*)(lds + wave * 16384);
    constexpr int I_IN = 32 * 497, I_PR = 1024, I_OUT = 2048, I_LR = 128, I_UP = 65 * 2 * 512, I_DN = 65 * 512;
    constexpr int NITEMS = I_IN + 3 * I_PR + I_OUT + I_LR + I_UP + I_DN;
    bf16* Win = (bf16*)(wbase + W_IN);
    for (int it = gw; it < NITEMS; it += NGW) {
        int r = it;
        if (r < I_IN) { const int kb = r / 497, nb = r % 497;
            int nsrc, drow, nv = 32;
            if (nb < 336) { nsrc = nb * 32; drow = nb * 32; } else if (nb < 496) { nsrc = 10768 + (nb - 336) * 32; drow = 10752 + (nb - 336) * 32; } else { nsrc = 10752; drow = COL_DT; nv = 16; }
            cvt_item(in[3] + (size_t)l * D * D_IN, D_IN, 2048, Win, scr, kb * 64, nsrc, drow, nv, lane); continue; }
        r -= I_IN;
        if (r < 3 * I_PR) { const int w = r / I_PR, q = r % I_PR, kb = q / 64, nb = q % 64;
            const float* src = in[18 + w] + (size_t)l * 1024 * D; bf16* dst = (bf16*)(wbase + W_PL + (size_t)w * 4 * MiB);
            cvt_item(src, 2048, 1024, dst, scr, kb * 64, nb * 32, nb * 32, 32, lane); continue; }
        r -= 3 * I_PR;
        if (r < I_OUT) { const int kb = r / 64, nb = r % 64; cvt_item(in[21] + (size_t)l * D * D, 2048, 2048, (bf16*)(wbase + W_OUT), scr, kb * 64, nb * 32, nb * 32, 32, lane); continue; }
        r -= I_OUT;
        if (r < I_LR) { const int w = r / 64, q = r % 64, blk = q / 8, kb = (q % 8) / 4, nb = q % 4;
            cvt_item(in[7 + 2 * w] + (size_t)l * 8 * 16384 + blk * 16384, 128, 128, (bf16*)(wbase + W_LR + (size_t)w * 262144) + blk * 16384, scr, kb * 64, nb * 32, nb * 32, 32, lane); continue; }
        r -= I_LR;
        if (r < I_UP) { const int e = r / 1024, q = r % 1024, w = q / 512, kb = (q % 512) / 16, nb = q % 16;
            const float* src = e < 64 ? in[26 + w] + ((size_t)l * NE + e) * 2048 * 512 : in[29 + w] + (size_t)l * 2048 * 512;
            const int j0 = nb * 32; const int drow = (j0 / 128) * 256 + w * 128 + (j0 % 128);
            cvt_item(src, 512, 2048, (bf16*)(wbase + W_UP) + (size_t)e * 1024 * 2048, scr, kb * 64, j0, drow, 32, lane); continue; }
        r -= I_UP;
        { const int e = r / 512, q = r % 512, kb = q / 64, nb = q % 64;
            const float* src = e < 64 ? in[28] + ((size_t)l * NE + e) * 512 * 2048 : in[31] + (size_t)l * 512 * 2048;
            cvt_item(src, 2048, 512, (bf16*)(wbase + W_DN) + (size_t)e * 2048 * 512, scr, kb * 64, nb * 32, nb * 32, 32, lane); }
    }
    { u32x4* z = (u32x4*)(Win + (size_t)(COL_DT + 16) * 2048); const int n16 = 240 * 2048 * 2 / 16;
      for (int i = gw * 64 + lane; i < n16; i += NGW * 64) z[i] = (u32x4){0u, 0u, 0u, 0u}; }
}

template <int TPT> __device__ __forceinline__ void conv8(const bf16* src, int l0g, const float* cw, int cstride, const float* cb, float (&out)[TPT][8]) {
    u32x4 rows[TPT + 3];
#pragma unroll
    for (int j = 0; j < TPT + 3; ++j) { rows[j] = (u32x4){0u, 0u, 0u, 0u}; if (l0g + j - 3 >= 0) rows[j] = *(const u32x4*)(src + (ptrdiff_t)(j - 3) * LD); }
    float w[4][8], bb[8];
#pragma unroll
    for (int k = 0; k < 4; ++k) { const f32x4 a = *(const f32x4*)(cw + k * cstride), b = *(const f32x4*)(cw + k * cstride + 4);
#pragma unroll
        for (int e = 0; e < 4; ++e) { w[k][e] = a[e]; w[k][4 + e] = b[e]; } }
    { const f32x4 a = *(const f32x4*)cb, b = *(const f32x4*)(cb + 4);
#pragma unroll
      for (int e = 0; e < 4; ++e) { bb[e] = a[e]; bb[4 + e] = b[e]; } }
#pragma unroll
    for (int j = 0; j < TPT; ++j) {
#pragma unroll
        for (int e = 0; e < 8; ++e) out[j][e] = bb[e];
#pragma unroll
        for (int k = 0; k < 4; ++k) { const u32x4 x = rows[j + k];
            out[j][0] += w[k][0] * bflo(x.x); out[j][1] += w[k][1] * bfhi(x.x); out[j][2] += w[k][2] * bflo(x.y); out[j][3] += w[k][3] * bfhi(x.y);
            out[j][4] += w[k][4] * bflo(x.z); out[j][5] += w[k][5] * bfhi(x.z); out[j][6] += w[k][6] * bflo(x.w); out[j][7] += w[k][7] * bfhi(x.w); }
    }
}
__device__ __forceinline__ u32x4 pack8(const float (&v)[8]) { u32x4 o; o.x = pk2(v[0], v[1]); o.y = pk2(v[2], v[3]); o.z = pk2(v[4], v[5]); o.w = pk2(v[6], v[7]); return o; }

constexpr int KS = 272;
__device__ __forceinline__ void attn_phase(LAS unsigned char* lds, const bf16* __restrict__ proj, bf16* __restrict__ og, float* __restrict__ lse, int G, int bid, int tid) {
    const int lane = tid & 63, wave = __builtin_amdgcn_readfirstlane(tid >> 6);
    const int lr = lane & 15, lg = lane >> 4, lq = (lane & 15) >> 2, lp = lane & 3;
    LAS unsigned char* Kl = lds; LAS unsigned char* Vl = lds + 256 * KS;
    const unsigned vbase = (unsigned)(uintptr_t)Vl;
    for (int task = bid; task < 3072; task += G) {
        const int grp = task >> 10, rem = task & 1023, bh = rem >> 4, ti = rem & 15, b = bh >> 3, h = bh & 7;
        int dil, r, tb;
        if (grp == 0) { dil = 1; r = 0; tb = ti; } else if (grp == 1) { dil = 4; r = ti >> 2; tb = ti & 3; } else { dil = 16; r = ti; tb = 0; }
        const int ub = tb * 128;
        __syncthreads();
        for (int idx = tid + (tb == 0 ? 2048 : 0); idx < 4096; idx += 512) {
            const int row = idx >> 4, ch = idx & 15;
            const int tk = (ub - 128 + row) * dil + r;
            const bf16* src = proj + (size_t)(b * T + tk) * LD + h * 128 + ch * 8;
            const u32x4 kv = *(const u32x4*)(src + COL_K), vv = *(const u32x4*)(src + COL_V);
            *(LAS u32x4*)(Kl + row * KS + ch * 16) = kv; *(LAS u32x4*)(Vl + row * KS + ch * 16) = vv;
        }
        const int iq = 16 * wave + lr; const int tq = (ub + iq) * dil + r;
        const bf16* qp = proj + (size_t)(b * T + tq) * LD + COL_Q + grp * 1024 + h * 128 + 8 * lg;
        bf16x8 qf[4];
#pragma unroll
        for (int ks = 0; ks < 4; ++ks) qf[ks] = *(const bf16x8*)(qp + 32 * ks);
        __syncthreads();
        const float slope = exp2f(-8.0f * (float)(grp * 8 + h + 1) / 24.0f) * (float)dil;
        const float scale = 0.08838834764831845f;
        int kb_lo = wave >> 1; const int kb_hi = (16 * wave + 143) >> 5; if (tb == 0 && kb_lo < 4) kb_lo = 4;
        float m_run = -1e30f, l_run = 0.f;
        f32x4 accO[8];
#pragma unroll
        for (int c = 0; c < 8; ++c) accO[c] = (f32x4){0.f, 0.f, 0.f, 0.f};
        for (int kb = kb_lo; kb <= kb_hi; ++kb) {
            f32x4 sacc[2];
#pragma unroll
            for (int sb = 0; sb < 2; ++sb) { sacc[sb] = (f32x4){0.f, 0.f, 0.f, 0.f};
#pragma unroll
                for (int ks = 0; ks < 4; ++ks) { const bf16x8 kf = *(const LAS bf16x8*)(Kl + (32 * kb + 16 * sb + lr) * KS + 64 * ks + 16 * lg);
                    sacc[sb] = __builtin_amdgcn_mfma_f32_16x16x32_bf16(kf, qf[ks], sacc[sb], 0, 0, 0); } }
            float sv[2][4]; bool ok[2][4]; float mx = -1e30f;
#pragma unroll
            for (int sb = 0; sb < 2; ++sb)
#pragma unroll
                for (int e = 0; e < 4; ++e) { const int j = 32 * kb + 16 * sb + 4 * lg + e; const int dist = iq + 128 - j;
                    ok[sb][e] = (dist >= 0) && (dist <= 128);
                    sv[sb][e] = sacc[sb][e] * scale - slope * (float)dist;
                    if (ok[sb][e]) mx = fmaxf(mx, sv[sb][e]); }
            mx = fmaxf(mx, __shfl_xor(mx, 16)); mx = fmaxf(mx, __shfl_xor(mx, 32));
            const float m_new = fmaxf(m_run, mx);
            const float alpha = __expf(m_run - m_new);
            float p[2][4]; float ps = 0.f;
#pragma unroll
            for (int sb = 0; sb < 2; ++sb)
#pragma unroll
                for (int e = 0; e < 4; ++e) { p[sb][e] = ok[sb][e] ? __expf(sv[sb][e] - m_new) : 0.f; ps += p[sb][e]; }
            l_run = l_run * alpha + ps; m_run = m_new;
#pragma unroll
            for (int c = 0; c < 8; ++c) accO[c] *= alpha;
            u32x4 pw; pw.x = pk2(p[0][0], p[0][1]); pw.y = pk2(p[0][2], p[0][3]); pw.z = pk2(p[1][0], p[1][1]); pw.w = pk2(p[1][2], p[1][3]);
            const bf16x8 pf = as_bf16x8(pw);
            const unsigned va = vbase + (unsigned)((32 * kb + 4 * lg + lq) * KS + 8 * lp);
#pragma unroll
            for (int c = 0; c < 8; ++c) { u32x2 lo, hi; tr_read2(va + 32 * c, va + 32 * c + 16 * KS, lo, hi);
                u32x4 vw; vw.x = lo.x; vw.y = lo.y; vw.z = hi.x; vw.w = hi.y;
                accO[c] = __builtin_amdgcn_mfma_f32_16x16x32_bf16(as_bf16x8(vw), pf, accO[c], 0, 0, 0); }
        }
        float lt = l_run; lt += __shfl_xor(lt, 16); lt += __shfl_xor(lt, 32);
        const float inv = 1.0f / lt;
        bf16* op = og + ((size_t)grp * M + (size_t)(b * T + tq)) * 1024 + h * 128 + 4 * lg;
#pragma unroll
        for (int c = 0; c < 8; ++c) { u32x2 w; w.x = pk2(accO[c][0] * inv, accO[c][1] * inv); w.y = pk2(accO[c][2] * inv, accO[c][3] * inv); *(u32x2*)(op + 16 * c) = w; }
        if (lg == 0) lse[((size_t)grp * M + (size_t)(b * T + tq)) * 8 + h] = m_run + __logf(lt);
    }
}
__device__ __forceinline__ void attn_merge(const bf16* __restrict__ og, const float* __restrict__ lse, bf16* __restrict__ ya, int gw, int NGW, int lane) {
    for (int row = gw; row < M; row += NGW) {
#pragma unroll
        for (int j = 0; j < 2; ++j) { const int cb = lane + 64 * j, h = cb >> 4;
            const float l0 = lse[(size_t)row * 8 + h], l1 = lse[((size_t)M + row) * 8 + h], l2 = lse[((size_t)2 * M + row) * 8 + h];
            const float mx = fmaxf(l0, fmaxf(l1, l2)); float w0 = __expf(l0 - mx), w1 = __expf(l1 - mx), w2 = __expf(l2 - mx); const float inv = 1.0f / (w0 + w1 + w2); w0 *= inv; w1 *= inv; w2 *= inv;
            const u32x4 a = *(const u32x4*)(og + (size_t)row * 1024 + cb * 8), b = *(const u32x4*)(og + ((size_t)M + row) * 1024 + cb * 8), c = *(const u32x4*)(og + ((size_t)2 * M + row) * 1024 + cb * 8);
            u32x4 o;
            o.x = pk2(w0 * bflo(a.x) + w1 * bflo(b.x) + w2 * bflo(c.x), w0 * bfhi(a.x) + w1 * bfhi(b.x) + w2 * bfhi(c.x));
            o.y = pk2(w0 * bflo(a.y) + w1 * bflo(b.y) + w2 * bflo(c.y), w0 * bfhi(a.y) + w1 * bfhi(b.y) + w2 * bfhi(c.y));
            o.z = pk2(w0 * bflo(a.z) + w1 * bflo(b.z) + w2 * bflo(c.z), w0 * bfhi(a.z) + w1 * bfhi(b.z) + w2 * bfhi(c.z));
            o.w = pk2(w0 * bflo(a.w) + w1 * bflo(b.w) + w2 * bflo(c.w), w0 * bfhi(a.w) + w1 * bfhi(b.w) + w2 * bfhi(c.w));
            *(u32x4*)(ya + (size_t)row * 1024 + cb * 8) = o; }
    }
}

__device__ __forceinline__ float ssd_dt_acum(LAS float* DT, LAS float* AC, const bf16* __restrict__ proj, const float* dt_bias, const float* a_log, int b, int c, int g, int wave, int lane) {
    const int h = 8 * g + wave; const float bias = dt_bias[h], a = -__expf(a_log[h]);
    const size_t rowb = (size_t)(b * T + c * 128 + 2 * lane) * LD + COL_DT + h;
    const float d0 = softplusf_(bf2f(proj[rowb]) + bias), d1 = softplusf_(bf2f(proj[rowb + LD]) + bias);
    const float v0 = d0 * a, v1 = d1 * a; float s = v0 + v1;
#pragma unroll
    for (int o = 1; o < 64; o <<= 1) { const float t = __shfl_up(s, o); if (lane >= o) s += t; }
    DT[(2 * lane) * 8 + wave] = d0; DT[(2 * lane + 1) * 8 + wave] = d1;
    AC[(2 * lane) * 8 + wave] = s - v1; AC[(2 * lane + 1) * 8 + wave] = s;
    return __shfl(s, 63);
}
__device__ __forceinline__ void ssd_stage_bc(LAS unsigned char* img, const bf16* __restrict__ proj, const float* cw, const float* cb, int b, int c, int chan0, int tid) {
    const int ch = tid & 15, tg = tid >> 4;
    const int l0 = tg * 4, col = chan0 + ch * 8;
    float o[4][8];
    conv8<4>(proj + (size_t)(b * T + c * 128 + l0) * LD + COL_XBC + col, c * 128 + l0, cw + col, 1536, cb + col, o);
#pragma unroll
    for (int j = 0; j < 4; ++j) { float v[8];
#pragma unroll
        for (int e = 0; e < 8; ++e) v[e] = siluf_(o[j][e]);
        *(LAS u32x4*)(img + (l0 + j) * KS + ch * 16) = pack8(v); }
}
constexpr int XS = 528;
template <bool SCALE> __device__ __forceinline__ void ssd_stage_x(LAS unsigned char* img, const bf16* __restrict__ proj, const float* cw, const float* cb, int b, int c, int chan0, LAS const float* WL, int hb, int tid) {
    const int ch = tid & 31, tg = tid >> 5;
    const int col = chan0 + ch * 8;
#pragma unroll 1
    for (int sub = 0; sub < 2; ++sub) {
        const int l0 = tg * 8 + sub * 4;
        float o[4][8];
        conv8<4>(proj + (size_t)(b * T + c * 128 + l0) * LD + COL_XBC + col, c * 128 + l0, cw + col, 1536, cb + col, o);
#pragma unroll
        for (int j = 0; j < 4; ++j) { float v[8]; const float sc = SCALE ? WL[(l0 + j) * 8 + hb + (ch >> 3)] : 1.0f;
#pragma unroll
            for (int e = 0; e < 8; ++e) v[e] = siluf_(o[j][e]) * sc;
            *(LAS u32x4*)(img + (l0 + j) * XS + ch * 16) = pack8(v); }
    }
}
__device__ __forceinline__ void ssd_states_phase(LAS unsigned char* lds, const bf16* __restrict__ proj, const float* cw, const float* cb, const float* dt_bias, const float* a_log,
                                                 float* __restrict__ sst, float* __restrict__ alast, int G, int bid, int tid) {
    const int lane = tid & 63, wave = __builtin_amdgcn_readfirstlane(tid >> 6);
    LAS float* DT = (LAS float*)lds; LAS float* AC = DT + 1024; LAS float* WL = AC + 1024;
    LAS unsigned char* BMi = lds + 12288; LAS unsigned char* Xi = BMi + 128 * KS;
    const unsigned bbase = (unsigned)(uintptr_t)BMi, xbase = (unsigned)(uintptr_t)Xi;
    for (int unit = bid; unit < 256; unit += G) {
        const int b = unit >> 5, c = (unit >> 1) & 15, g = unit & 1;
        __syncthreads();
        const float al = ssd_dt_acum(DT, AC, proj, dt_bias, a_log, b, c, g, wave, lane);
        if (lane == 0) alast[(b * 16 + c) * 16 + 8 * g + wave] = al;
        LDS_WAIT();
        WL[(2 * lane) * 8 + wave] = DT[(2 * lane) * 8 + wave] * __expf(al - AC[(2 * lane) * 8 + wave]);
        WL[(2 * lane + 1) * 8 + wave] = DT[(2 * lane + 1) * 8 + wave] * __expf(al - AC[(2 * lane + 1) * 8 + wave]);
        ssd_stage_bc(BMi, proj, cw, cb, b, c, 1024 + 128 * g, tid);
        __syncthreads();
#pragma unroll 1
        for (int pass = 0; pass < 2; ++pass) {
            if (pass) __syncthreads();
            ssd_stage_x<true>(Xi, proj, cw, cb, b, c, 512 * g + 256 * pass, WL, 4 * pass, tid);
            __syncthreads();
            int ln = lane; asm volatile("" : "+v"(ln));
            const int lr = ln & 15, lg = ln >> 4, lq = (ln & 15) >> 2, lp = ln & 3;
            const int hl = wave >> 1, ph = wave & 1;
            f32x4 acc[2][8];
#pragma unroll
            for (int mt = 0; mt < 2; ++mt)
#pragma unroll
                for (int nt = 0; nt < 8; ++nt) acc[mt][nt] = (f32x4){0.f, 0.f, 0.f, 0.f};
            const unsigned xa = xbase + (unsigned)((8 * lg + lq) * XS + (64 * hl + 32 * ph + 4 * lp) * 2);
            const unsigned ba = bbase + (unsigned)((8 * lg + lq) * KS + (4 * lp) * 2);
#pragma unroll
            for (int ks = 0; ks < 4; ++ks) {
                bf16x8 af[2];
#pragma unroll
                for (int mt = 0; mt < 2; ++mt) { const unsigned a0 = xa + (unsigned)(32 * ks * XS + 32 * mt);
                    u32x2 lo, hi; tr_read2(a0, a0 + 4 * XS, lo, hi); u32x4 w; w.x = lo.x; w.y = lo.y; w.z = hi.x; w.w = hi.y; af[mt] = as_bf16x8(w); }
#pragma unroll
                for (int nt = 0; nt < 8; ++nt) { const unsigned b0 = ba + (unsigned)(32 * ks * KS + 32 * nt);
                    u32x2 lo, hi; tr_read2(b0, b0 + 4 * KS, lo, hi); u32x4 w; w.x = lo.x; w.y = lo.y; w.z = hi.x; w.w = hi.y; const bf16x8 bfr = as_bf16x8(w);
#pragma unroll
                    for (int mt = 0; mt < 2; ++mt) acc[mt][nt] = __builtin_amdgcn_mfma_f32_16x16x32_bf16(af[mt], bfr, acc[mt][nt], 0, 0, 0); }
            }
            const int h = 8 * g + 4 * pass + hl;
#pragma unroll
            for (int mt = 0; mt < 2; ++mt) {
                float* sp = sst + ((size_t)((b * 16 + c) * 16 + h) * 64 + 32 * ph + 16 * mt + 4 * lg) * 128 + lr;
                asm volatile("" : "+v"(sp));
#pragma unroll
                for (int nt = 0; nt < 8; ++nt)
#pragma unroll
                    for (int e = 0; e < 4; ++e) sp[e * 128 + 16 * nt] = acc[mt][nt][e];
            }
        }
    }
}
__device__ __forceinline__ void ssd_pass_phase(float* __restrict__ sst, const float* __restrict__ alast, int G, int bid, int tid) {
    for (int i = bid * 512 + tid; i < 262144; i += G * 512) {
        const int b = i >> 15, q = i & 32767, h = q >> 11;
        f32x4* base = (f32x4*)sst + (size_t)b * 16 * 32768 + q;
        f32x4 v[16];
#pragma unroll
        for (int c = 0; c < 16; ++c) v[c] = base[(size_t)c * 32768];
        f32x4 e = (f32x4){0.f, 0.f, 0.f, 0.f};
#pragma unroll
        for (int c = 0; c < 16; ++c) { base[(size_t)c * 32768] = e; const float dec = __expf(alast[(b * 16 + c) * 16 + h]); e = e * dec + v[c]; }
    }
}
__device__ __forceinline__ void ssd_out_phase(LAS unsigned char* lds, const bf16* __restrict__ proj, const float* cw, const float* cb, const float* dt_bias, const float* a_log,
                                              const float* dskip, const float* norm_g, const float* __restrict__ sst, bf16* ys, int G, int bid, int tid) {
    const int lane = tid & 63, wave = __builtin_amdgcn_readfirstlane(tid >> 6);
    LAS float* DT = (LAS float*)lds; LAS float* AC = DT + 1024;
    LAS unsigned char* BMi = lds + 8192; LAS unsigned char* CMi = BMi + 128 * KS; LAS unsigned char* Xi = CMi + 128 * KS;
    const unsigned xbase = (unsigned)(uintptr_t)Xi;
    for (int unit = bid; unit < 256; unit += G) {
        const int b = unit >> 5, c = (unit >> 1) & 15, g = unit & 1;
        __syncthreads();
        (void)ssd_dt_acum(DT, AC, proj, dt_bias, a_log, b, c, g, wave, lane);
        ssd_stage_bc(BMi, proj, cw, cb, b, c, 1024 + 128 * g, tid);
        ssd_stage_bc(CMi, proj, cw, cb, b, c, 1280 + 128 * g, tid);
        ssd_stage_x<false>(Xi, proj, cw, cb, b, c, 512 * g, nullptr, 0, tid);
        __syncthreads();
        int ln0 = lane; asm volatile("" : "+v"(ln0));
        const int l = 16 * wave + (ln0 & 15);
        bf16x8 cf[4];
#pragma unroll
        for (int ks = 0; ks < 4; ++ks) cf[ks] = *(const LAS bf16x8*)(CMi + l * KS + 64 * ks + 16 * (ln0 >> 4));
        f32x4 cbT[8];
#pragma unroll
        for (int sb = 0; sb < 8; ++sb) { cbT[sb] = (f32x4){0.f, 0.f, 0.f, 0.f};
            if (sb <= wave) {
#pragma unroll
                for (int ks = 0; ks < 4; ++ks) { const bf16x8 bfr = *(const LAS bf16x8*)(BMi + (16 * sb + (ln0 & 15)) * KS + 64 * ks + 16 * (ln0 >> 4));
                    cbT[sb] = __builtin_amdgcn_mfma_f32_16x16x32_bf16(bfr, cf[ks], cbT[sb], 0, 0, 0); } } }
        float ssq = 0.f;
        const size_t tokrow = (size_t)(b * T + c * 128 + l);
#pragma unroll 1
        for (int pass = 0; pass < 2; ++pass) {
            if (pass) { __syncthreads(); ssd_stage_x<false>(Xi, proj, cw, cb, b, c, 512 * g + 256, nullptr, 0, tid); __syncthreads(); }
#pragma unroll 1
            for (int hl = 0; hl < 4; ++hl) {
                int ln = lane; asm volatile("" : "+v"(ln));
                const int lr = ln & 15, lg = ln >> 4, lq = (ln & 15) >> 2, lp = ln & 3;
                const int hh = 4 * pass + hl, h = 8 * g + hh;
                const float acl = AC[l * 8 + hh];
                f32x4 acc[4];
#pragma unroll
                for (int mt = 0; mt < 4; ++mt) acc[mt] = (f32x4){0.f, 0.f, 0.f, 0.f};
                const float* ep = sst + ((size_t)((b * 16 + c) * 16 + h) * 64 + lr) * 128 + 8 * lg;
#pragma unroll
                for (int mt = 0; mt < 4; ++mt)
#pragma unroll
                    for (int ks = 0; ks < 4; ++ks) { const float* q = ep + (size_t)(16 * mt) * 128 + 32 * ks; const f32x4 e0 = *(const f32x4*)q, e1 = *(const f32x4*)(q + 4);
                        u32x4 w; w.x = pk2(e0[0], e0[1]); w.y = pk2(e0[2], e0[3]); w.z = pk2(e1[0], e1[1]); w.w = pk2(e1[2], e1[3]);
                        acc[mt] = __builtin_amdgcn_mfma_f32_16x16x32_bf16(as_bf16x8(w), cf[ks], acc[mt], 0, 0, 0); }
                const float eal = __expf(acl);
#pragma unroll
                for (int mt = 0; mt < 4; ++mt) acc[mt] *= eal;
#pragma unroll
                for (int kk = 0; kk < 4; ++kk) {
                    if (2 * kk <= wave) {
                        float pv[8];
#pragma unroll
                        for (int e = 0; e < 8; ++e) { const int sb = 2 * kk + (e >> 2); const int s = 16 * sb + 4 * lg + (e & 3);
                            const float w = (s <= l) ? __expf(acl - AC[s * 8 + hh]) * DT[s * 8 + hh] : 0.f; pv[e] = cbT[sb][e & 3] * w; }
                        const bf16x8 pf = as_bf16x8(pack8(pv));
                        const unsigned va = xbase + (unsigned)((32 * kk + 4 * lg + lq) * XS + (64 * hl + 4 * lp) * 2);
#pragma unroll
                        for (int mt = 0; mt < 4; ++mt) { u32x2 lo, hi; tr_read2(va + 32 * mt, va + 32 * mt + 16 * XS, lo, hi); u32x4 vw; vw.x = lo.x; vw.y = lo.y; vw.z = hi.x; vw.w = hi.y;
                            acc[mt] = __builtin_amdgcn_mfma_f32_16x16x32_bf16(as_bf16x8(vw), pf, acc[mt], 0, 0, 0); }
                    } }
                const float dsk = dskip[h];
#pragma unroll
                for (int mt = 0; mt < 4; ++mt) { const int chl = 64 * hl + 16 * mt + 4 * lg;
                    const u32x2 xv = *(const LAS u32x2*)(Xi + l * XS + chl * 2);
                    const u32x2 zv = *(const u32x2*)(proj + tokrow * LD + COL_Z + 512 * g + 256 * pass + chl);
                    float y0 = (acc[mt][0] + dsk * bflo(xv.x)) * siluf_(bflo(zv.x)), y1 = (acc[mt][1] + dsk * bfhi(xv.x)) * siluf_(bfhi(zv.x));
                    float y2 = (acc[mt][2] + dsk * bflo(xv.y)) * siluf_(bflo(zv.y)), y3 = (acc[mt][3] + dsk * bfhi(xv.y)) * siluf_(bfhi(zv.y));
                    ssq += y0 * y0 + y1 * y1 + y2 * y2 + y3 * y3;
                    u32x2 o; o.x = pk2(y0, y1); o.y = pk2(y2, y3);
                    *(u32x2*)(ys + tokrow * 1024 + 512 * g + 256 * pass + chl) = o; }
            }
        }
        VM_WAIT();
        ssq += __shfl_xor(ssq, 16); ssq += __shfl_xor(ssq, 32);
        const float rstd = 1.0f / sqrtf(ssq * (1.0f / 512.0f) + RMS_EPS);
#pragma unroll 1
        for (int hh = 0; hh < 8; ++hh) {
            int ln = lane; asm volatile("" : "+v"(ln));
            const int lg = ln >> 4;
#pragma unroll
            for (int mt = 0; mt < 4; ++mt) { const int ch = 512 * g + 64 * hh + 16 * mt + 4 * lg; const f32x4 ng = *(const f32x4*)(norm_g + ch);
                const u32x2 yv = *(const u32x2*)(ys + tokrow * 1024 + ch);
                u32x2 o; o.x = pk2(bflo(yv.x) * rstd * ng[0], bfhi(yv.x) * rstd * ng[1]); o.y = pk2(bflo(yv.y) * rstd * ng[2], bfhi(yv.y) * rstd * ng[3]);
                *(u32x2*)(ys + tokrow * 1024 + ch) = o; }
        }
    }
}

__device__ __forceinline__ void lru_phase(LAS unsigned char* lds, const bf16* __restrict__ proj, const float* cw, const float* cb, const bf16* __restrict__ wrt, const bf16* __restrict__ wit,
                                          const float* br, const float* bi, const float* lam, bf16* __restrict__ yl, int G, int bid, int tid) {
    const int wave = __builtin_amdgcn_readfirstlane(tid >> 6);
    LAS unsigned char* XC = lds;
    LAS float* Aa = (LAS float*)(lds + 128 * KS);
    LAS float* Uu = Aa + 4096;
    LAS float* SA = Uu + 4096;
    LAS float* SH = SA + 512;
    LAS float* CAR = SH + 512;
    for (int unit = bid; unit < 256; unit += G) {
        const int b = unit >> 5, n = (unit >> 2) & 7, dq = unit & 3;
        const int dch = 128 * n + 32 * dq;
        __syncthreads();
        if (tid < 32) CAR[tid] = 0.f;
#pragma unroll 1
        for (int c = 0; c < 16; ++c) {
            int t2 = tid; asm volatile("" : "+v"(t2));
            const int lane = t2 & 63, lr = lane & 15, lg = lane >> 4;
            { const int ch = t2 & 15, tg = t2 >> 4, l0 = tg * 4, col = 128 * n + ch * 8;
              float o[4][8];
              conv8<4>(proj + (size_t)(b * T + c * 128 + l0) * LD + COL_LX + col, c * 128 + l0, cw + col, 1024, cb + col, o);
#pragma unroll
              for (int j = 0; j < 4; ++j) *(LAS u32x4*)(XC + (l0 + j) * KS + ch * 16) = pack8(o[j]); }
            __syncthreads();
            { bf16x8 af[4];
#pragma unroll
              for (int ks = 0; ks < 4; ++ks) af[ks] = *(const LAS bf16x8*)(XC + (16 * wave + lr) * KS + 64 * ks + 16 * lg);
#pragma unroll
              for (int nt = 0; nt < 2; ++nt) { f32x4 ar = (f32x4){0.f, 0.f, 0.f, 0.f}, ai = ar;
                  const size_t wo = (size_t)n * 16384 + (size_t)(32 * dq + 16 * nt + lr) * 128 + 8 * lg;
#pragma unroll
                  for (int ks = 0; ks < 4; ++ks) { const bf16x8 wrf = *(const bf16x8*)(wrt + wo + 32 * ks), wif = *(const bf16x8*)(wit + wo + 32 * ks);
                      ar = __builtin_amdgcn_mfma_f32_16x16x32_bf16(af[ks], wrf, ar, 0, 0, 0); ai = __builtin_amdgcn_mfma_f32_16x16x32_bf16(af[ks], wif, ai, 0, 0, 0); }
                  const int dl = 16 * nt + lr; const float brv = br[dch + dl], biv = bi[dch + dl], spl = -8.0f * softplusf_(-lam[dch + dl]);
#pragma unroll
                  for (int e = 0; e < 4; ++e) { const int tok = 16 * wave + 4 * lg + e;
                      const float rg = sigmoidf_(ar[e] + brv), ig = sigmoidf_(ai[e] + biv);
                      const float la = rg * spl; const float a = __expf(la);
                      const float xc = bf2f(*(const LAS bf16*)(XC + tok * KS + (32 * dq + dl) * 2));
                      Aa[tok * 32 + dl] = a; Uu[tok * 32 + dl] = sqrtf(-expm1f(2.0f * la)) * ig * xc; } } }
            __syncthreads();
            const int d = t2 & 31, seg = t2 >> 5;
            float hl[8], ac[8];
            { float hh = 0.f, aa = 1.f;
#pragma unroll
              for (int k = 0; k < 8; ++k) { const float a = Aa[(8 * seg + k) * 32 + d], u = Uu[(8 * seg + k) * 32 + d]; hh = a * hh + u; aa *= a; hl[k] = hh; ac[k] = aa; }
              SA[seg * 32 + d] = aa; SH[seg * 32 + d] = hh; }
            __syncthreads();
            float carry = CAR[(c & 1) * 32 + d];
            for (int s = 0; s < seg; ++s) carry = SA[s * 32 + d] * carry + SH[s * 32 + d];
            if (seg == 15) CAR[((c + 1) & 1) * 32 + d] = ac[7] * carry + hl[7];
#pragma unroll
            for (int k = 0; k < 8; ++k) { const int tok = 8 * seg + k; const size_t row = (size_t)(b * T + c * 128 + tok);
                const float hv = hl[k] + ac[k] * carry; const float gt = bf2f(proj[row * LD + COL_LG + dch + d]);
                yl[row * 1024 + dch + d] = (bf16)(pk2(hv * gelu_tanh(gt), 0.f) & 0xffffu); }
            __syncthreads();
        }
    }
}

__device__ __forceinline__ void router_phase(LAS unsigned char* lds, const float* __restrict__ pre, const float* lg_, const float* lb_, const float* __restrict__ rw, const float* rbias,
                                             float* __restrict__ h1, bf16* __restrict__ h1b, unsigned* gcnt, int* __restrict__ lts, float* __restrict__ lw, int G, int bid, int tid) {
    const int lane = tid & 63, wave = __builtin_amdgcn_readfirstlane(tid >> 6);
    LAS float* XT = (LAS float*)lds;
    LAS float* PART = XT + 16 * 2048;
    LAS int* SELT = (LAS int*)(PART + 2048);
    LAS float* SELW = (LAS float*)(SELT + 512);
    LAS int* LCNT = (LAS int*)(SELW + 512);
    LAS int* LBASE = LCNT + 64;
    LAS int* LPOS = LBASE + 64;
    if (tid < 64) LCNT[tid] = 0;
    const int ntiles = M / 16;
    int nflush = 0;
    for (int tile = bid; ; tile += G) {
        const bool have = tile < ntiles;
        if (have) {
            __syncthreads();
#pragma unroll 1
            for (int rr = 0; rr < 2; ++rr) { const int rl = 2 * wave + rr; const size_t row = (size_t)tile * 16 + rl;
                float v[4][8];
#pragma unroll
                for (int j = 0; j < 4; ++j) { const f32x4 a = *(const f32x4*)(pre + row * D + 512 * j + 8 * lane), bq = *(const f32x4*)(pre + row * D + 512 * j + 8 * lane + 4);
#pragma unroll
                    for (int e = 0; e < 4; ++e) { v[j][e] = a[e]; v[j][4 + e] = bq[e]; } }
                float s = 0.f;
#pragma unroll
                for (int j = 0; j < 4; ++j)
#pragma unroll
                    for (int e = 0; e < 8; ++e) s += v[j][e];
                const float mean = wave_sum(s) * (1.f / D); float s2 = 0.f;
#pragma unroll
                for (int j = 0; j < 4; ++j)
#pragma unroll
                    for (int e = 0; e < 8; ++e) { v[j][e] -= mean; s2 += v[j][e] * v[j][e]; }
                const float rstd = 1.f / sqrtf(wave_sum(s2) * (1.f / D) + LN_EPS);
#pragma unroll
                for (int j = 0; j < 4; ++j) { const int c0 = 512 * j + 8 * lane;
                    const f32x4 g0 = *(const f32x4*)(lg_ + c0), g1 = *(const f32x4*)(lg_ + c0 + 4), b0 = *(const f32x4*)(lb_ + c0), b1 = *(const f32x4*)(lb_ + c0 + 4);
                    f32x4 y0, y1;
#pragma unroll
                    for (int e = 0; e < 4; ++e) { y0[e] = v[j][e] * rstd * g0[e] + b0[e]; y1[e] = v[j][4 + e] * rstd * g1[e] + b1[e]; }
                    *(f32x4*)(h1 + row * D + c0) = y0; *(f32x4*)(h1 + row * D + c0 + 4) = y1;
                    u32x4 w; w.x = pk2(y0[0], y0[1]); w.y = pk2(y0[2], y0[3]); w.z = pk2(y1[0], y1[1]); w.w = pk2(y1[2], y1[3]); *(u32x4*)(h1b + row * D + c0) = w;
                    const int sw = (4 * rl) & 63;
                    *(LAS f32x4*)(XT + rl * 2048 + (c0 ^ sw)) = y0; *(LAS f32x4*)(XT + rl * 2048 + ((c0 + 4) ^ sw)) = y1; }
            }
            __syncthreads();
            { const int nt = wave & 3, kh = wave >> 2, r = lane & 15, kq = lane >> 4; const int sw = (4 * r) & 63;
              f32x4 acc = (f32x4){0.f, 0.f, 0.f, 0.f};
              const float* wp = rw + (size_t)(1024 * kh + kq) * 64 + 16 * nt + r;
              const LAS float* xp = XT + r * 2048;
#pragma unroll 8
              for (int ks = 0; ks < 256; ++ks) { const int k = 1024 * kh + 4 * ks + kq; const float a = xp[k ^ sw]; const float bq = wp[(size_t)ks * 256];
                  acc = __builtin_amdgcn_mfma_f32_16x16x4f32(a, bq, acc, 0, 0, 0); }
#pragma unroll
              for (int e = 0; e < 4; ++e) PART[(kh * 16 + 4 * kq + e) * 64 + 16 * nt + r] = acc[e]; }
            __syncthreads();
#pragma unroll 1
            for (int rr = 0; rr < 2; ++rr) { const int rl = 2 * wave + rr; const int tok = tile * 16 + rl;
                const float logit = PART[rl * 64 + lane] + PART[(16 + rl) * 64 + lane];
                const float score = 1.0f / (1.0f + __expf(-logit)); const float choice = score + rbias[lane];
                const int grp = lane >> 3;
                float m1 = choice; m1 = fmaxf(m1, __shfl_xor(m1, 1)); m1 = fmaxf(m1, __shfl_xor(m1, 2)); m1 = fmaxf(m1, __shfl_xor(m1, 4));
                const unsigned long long bm = __ballot(choice == m1); const unsigned gm = (unsigned)(bm >> (8 * grp)) & 0xffu; const int first = __builtin_ctz(gm) + 8 * grp;
                float m2 = (lane == first) ? -INFINITY : choice; m2 = fmaxf(m2, __shfl_xor(m2, 1)); m2 = fmaxf(m2, __shfl_xor(m2, 2)); m2 = fmaxf(m2, __shfl_xor(m2, 4));
                const float gs = m1 + m2;
                int grank = 0;
#pragma unroll
                for (int j = 0; j < 8; ++j) { const float o = __shfl(gs, 8 * j); grank += (o > gs || (o == gs && j < grp)) ? 1 : 0; }
                const bool keep = grank < 4;
                const float masked = keep ? choice : -INFINITY;
                int rank = 0;
#pragma unroll
                for (int j = 0; j < 64; ++j) { const float o = __shfl(masked, j); rank += (o > masked || (o == masked && j < lane)) ? 1 : 0; }
                const bool sel = keep && rank < 8;
                const float wsum = wave_sum(sel ? score : 0.f);
                if (sel) { const int idx = (nflush * 16 + rl) * 8 + rank; SELT[idx] = (tok * 16 + rank) | (lane << 24); SELW[idx] = score / wsum * 2.5f; }
            }
            ++nflush;
        }
        const bool more = (tile + G) < ntiles;
        if (nflush == 4 || (!more && nflush > 0)) {
            __syncthreads();
            const int nent = nflush * 128; int e = 0, lp = 0;
            if (tid < nent) { e = (SELT[tid] >> 24) & 63; lp = atomicAdd((int*)&LCNT[e], 1); LPOS[tid] = lp; }
            __syncthreads();
            if (tid < 64) { const int n = LCNT[tid]; LBASE[tid] = n ? (int)__hip_atomic_fetch_add(gcnt + tid * 16, (unsigned)n, __ATOMIC_RELAXED, __HIP_MEMORY_SCOPE_AGENT) : 0; LCNT[tid] = 0; }
            __syncthreads();
            if (tid < nent) { const int pos = LBASE[e] + lp; lts[e * 16384 + pos] = SELT[tid] & 0xffffff; lw[e * 16384 + pos] = SELW[tid]; }
            nflush = 0;
        }
        if (!more) break;
    }
}

__device__ __forceinline__ void combine_phase(const bf16* __restrict__ Y, const float* __restrict__ h1, const float* g, const float* b, float* of, bf16* ob, int gw, int NGW, int lane) {
    for (int row = gw; row < M; row += NGW) {
        float v[4][8];
#pragma unroll
        for (int j = 0; j < 4; ++j) { const int c0 = 512 * j + 8 * lane; const f32x4 a = *(const f32x4*)(h1 + (size_t)row * D + c0), bq = *(const f32x4*)(h1 + (size_t)row * D + c0 + 4);
#pragma unroll
            for (int e = 0; e < 4; ++e) { v[j][e] = ALPHA * a[e]; v[j][4 + e] = ALPHA * bq[e]; } }
#pragma unroll
        for (int s = 0; s < 9; ++s)
#pragma unroll
            for (int j = 0; j < 4; ++j) { const u32x4 y = *(const u32x4*)(Y + ((size_t)row * 9 + s) * D + 512 * j + 8 * lane);
                v[j][0] += bflo(y.x); v[j][1] += bfhi(y.x); v[j][2] += bflo(y.y); v[j][3] += bfhi(y.y); v[j][4] += bflo(y.z); v[j][5] += bfhi(y.z); v[j][6] += bflo(y.w); v[j][7] += bfhi(y.w); }
        ln_store(v, g, b, lane, of ? of + (size_t)row * D : nullptr, ob ? ob + (size_t)row * D : nullptr);
    }
}

struct Args { const float* in[34]; float* out; unsigned char* ws; int ph_lo, ph_hi; };
typedef const Args __attribute__((address_space(4)))* ArgP;
#ifndef PH_MASK
#define PH_MASK 0x7ff
#endif
#if MK_ONE
#define GRID_BAR() do { XcdBarrier b2_ = bar; asm volatile("" : "+s"(b2_.bar)); xcd_barrier(b2_); } while (0)
#else
#define GRID_BAR() do { } while (0)
#endif
#define IN(k) (((PH_MASK >> (((k)) % NPH)) & 1) && lo <= (k) && (k) < hi)
#define SEAM(k) do { if (IN(k) && IN((k) + 1)) GRID_BAR(); } while (0)
template <int L> __device__ __forceinline__ void layer_body(LAS unsigned char* lds, const int tid0, const int bid0, const int G, const int NGW, ArgP ap0, const XcdBarrier& bar, const int lo, const int hi) {
    {
        constexpr int l = L; constexpr int P = l * NPH;
        int tid = tid0, bid = bid0; asm volatile("" : "+v"(tid)); asm volatile("" : "+s"(bid));
        const int lane = tid & 63, wave = __builtin_amdgcn_readfirstlane(tid >> 6), gw = bid * 8 + wave;
#define PHASE_ENV() ArgP ap = ap0; asm volatile("" : "+s"(ap)); InTab in = ap->in; unsigned char* ws = ap->ws; unsigned* ctl = (unsigned*)(ws + WS_CTL); bf16* projb = (bf16*)(ws + WS_PROJ); \
        float* hbuf = (float*)(ws + WS_H); bf16* hb = (bf16*)(ws + WS_HB); float* h1 = (float*)(ws + WS_H1); bf16* h1b = (bf16*)(ws + WS_H1B); unsigned char* wbase = ws + WS_W; \
        (void)in; (void)ctl; (void)projb; (void)hbuf; (void)hb; (void)h1; (void)h1b; (void)wbase
        if (IN(P + 0)) {
            PHASE_ENV();
            p0_convert(lds, in, l, wbase, gw, NGW, wave, lane);
            if (l == 0) {
                for (int row = gw; row < M; row += NGW) { float v[4][8];
#pragma unroll
                    for (int j = 0; j < 4; ++j) { const f32x4 x0 = *(const f32x4*)(in[0] + (size_t)row * D + 512 * j + 8 * lane), x1 = *(const f32x4*)(in[0] + (size_t)row * D + 512 * j + 8 * lane + 4);
#pragma unroll
                        for (int e = 0; e < 4; ++e) { v[j][e] = x0[e]; v[j][4 + e] = x1[e]; } }
                    ln_store(v, in[1], in[2], lane, hbuf + (size_t)row * D, hb + (size_t)row * D); }
            }
        }
        SEAM(P + 0);
        if (IN(P + 1)) {
            PHASE_ENV();
            DenseSched S; S.init(M, LD, D, G, bid, wbase + W_IN);
            EpiStoreBf16 E{projb, LD};
            pg8::gemm_phase(lds, (const char*)hb, D, S, E, tid);
        }
        SEAM(P + 1);
        if (IN(P + 2)) {
            PHASE_ENV();
#ifndef NO_SSD1
            ssd_states_phase(lds, projb, in[12] + (size_t)l * 4 * 1536, in[13] + (size_t)l * 1536, in[14] + l * 16, in[15] + l * 16,
                             (float*)(ws + WS_SST), (float*)(ws + WS_ALAST), G, bid, tid);
#endif
#ifndef NO_ATTN
            attn_phase(lds, projb, (bf16*)(ws + WS_OG), (float*)(ws + WS_LSE), G, bid, tid);
#endif
        }
        SEAM(P + 2);
        if (IN(P + 3)) {
            PHASE_ENV();
            ssd_pass_phase((float*)(ws + WS_SST), (const float*)(ws + WS_ALAST), G, bid, tid);
            attn_merge((const bf16*)(ws + WS_OG), (const float*)(ws + WS_LSE), (bf16*)(ws + WS_YA), gw, NGW, lane);
            lru_phase(lds, projb, in[5] + (size_t)l * 4 * 1024, in[6] + (size_t)l * 1024, (const bf16*)(wbase + W_LR), (const bf16*)(wbase + W_LI),
                      in[8] + l * 1024, in[10] + l * 1024, in[11] + l * 1024, (bf16*)(ws + WS_YL), G, bid, tid);
        }
        SEAM(P + 3);
        if (IN(P + 4)) {
            PHASE_ENV();
            ssd_out_phase(lds, projb, in[12] + (size_t)l * 4 * 1536, in[13] + (size_t)l * 1536, in[14] + l * 16, in[15] + l * 16,
                          in[16] + l * 16, in[17] + l * 1024, (const float*)(ws + WS_SST), (bf16*)(ws + WS_YS), G, bid, tid);
        }
        SEAM(P + 4);
        if (IN(P + 5)) {
            PHASE_ENV();
            const float* bg = in[4] + (size_t)l * 3 * D;
            { DenseSched S; S.init(M, D, 1024, G, bid, wbase + W_PL); EpiGate<0> E{projb, bg, (float*)(ws + WS_MF), (bf16*)(ws + WS_MB), 0};
              pg8::gemm_phase(lds, (const char*)(ws + WS_YL), 1024, S, E, tid); }
            { DenseSched S; S.init(M, D, 1024, G, bid, wbase + W_PS); EpiGate<1> E{projb, bg, (float*)(ws + WS_MF), (bf16*)(ws + WS_MB), 2048};
              pg8::gemm_phase(lds, (const char*)(ws + WS_YS), 1024, S, E, tid); }
            { DenseSched S; S.init(M, D, 1024, G, bid, wbase + W_PA); EpiGate<2> E{projb, bg, (float*)(ws + WS_MF), (bf16*)(ws + WS_MB), 4096};
              pg8::gemm_phase(lds, (const char*)(ws + WS_YA), 1024, S, E, tid); }
        }
        SEAM(P + 5);
        if (IN(P + 6)) {
            PHASE_ENV();
            DenseSched S; S.init(M, D, D, G, bid, wbase + W_OUT); EpiResid E{hbuf, (float*)(ws + WS_PRE)};
            pg8::gemm_phase(lds, (const char*)(ws + WS_MB), D, S, E, tid);
        }
        SEAM(P + 6);
        if (IN(P + 7)) {
            PHASE_ENV();
            router_phase(lds, (const float*)(ws + WS_PRE), in[22] + (size_t)l * D, in[23] + (size_t)l * D, in[24] + (size_t)l * D * NE, in[25] + l * NE,
                         h1, h1b, ctl + CW_CNT + l * 64 * 16, (int*)(ws + WS_LTS), (float*)(ws + WS_LW), G, bid, tid);
        }
        SEAM(P + 7);
        if (IN(P + 8)) {
            PHASE_ENV();
            MoeSched<true> S; S.init(G, bid, ctl + CW_CNT + l * 64 * 16, (const int*)(ws + WS_LTS), wbase + W_UP, lane);
            EpiMoeUp E{(bf16*)(ws + WS_HID)};
            pg8::gemm_phase(lds, (const char*)h1b, D, S, E, tid);
        }
        SEAM(P + 8);
        if (IN(P + 9)) {
            PHASE_ENV();
            MoeSched<false> S; S.init(G, bid, ctl + CW_CNT + l * 64 * 16, (const int*)(ws + WS_LTS), wbase + W_DN, lane);
            EpiMoeDown E{(const int*)(ws + WS_LTS), (const float*)(ws + WS_LW), (bf16*)(ws + WS_Y)};
            pg8::gemm_phase(lds, (const char*)(ws + WS_HID), EDIM, S, E, tid);
        }
        SEAM(P + 9);
        if (IN(P + 10)) {
            PHASE_ENV();
            const bool lastl = (l == DEPTH - 1);
            combine_phase((const bf16*)(ws + WS_Y), h1, in[32] + (size_t)l * D, in[33] + (size_t)l * D, lastl ? ap->out : hbuf, lastl ? nullptr : hb, gw, NGW, lane);
        }
        if (l + 1 < DEPTH) SEAM(P + 10);
    }
}
#undef IN
#undef SEAM
__global__ void __launch_bounds__(512, 2) fwd_kernel(Args args) {
    extern __shared__ __attribute__((aligned(16))) unsigned char lds_raw[];
    LAS unsigned char* lds = (LAS unsigned char*)lds_raw;
    const int tid0 = threadIdx.x;
    const int G = gridDim.x, bid0 = blockIdx.x, NGW = G * 8;
    ArgP ap0 = (ArgP)__builtin_amdgcn_kernarg_segment_ptr();
    volatile LAS unsigned* MISC = (volatile LAS unsigned*)(lds + MISC_OFF);
    if (tid0 < 16) MISC[tid0] = 0u;
    __syncthreads();
    XcdBarrier bar; bar.bar = (unsigned*)(ap0->ws + WS_CTL) + CW_BAR; bar.x = 0; bar.st = MISC;
#if MK_ONE
    bar = xcd_barrier_post((unsigned*)(ap0->ws + WS_CTL) + CW_BAR, MISC);
#endif
    const int lo = ap0->ph_lo, hi = ap0->ph_hi;
    layer_body<0>(lds, tid0, bid0, G, NGW, ap0, bar, lo, hi);
    layer_body<1>(lds, tid0, bid0, G, NGW, ap0, bar, lo, hi);
}


extern "C" void kernel_launch(void* const* d_in, const int* in_sizes, int n_in, void* d_out, int out_size, void* d_ws, size_t ws_size, hipStream_t stream) {
    static int grid = 0;
    if (grid == 0) {
        if (n_in != 34 || out_size != M * D || ws_size < WS_END) { fprintf(stderr, "kernel_launch: unexpected shapes (n_in %d out %d ws %zu)\n", n_in, out_size, ws_size); grid = -1; return; }
        int dev = 0, cus = 0, per_cu = 0;
        if (hipGetDevice(&dev) != hipSuccess || hipDeviceGetAttribute(&cus, hipDeviceAttributeMultiprocessorCount, dev) != hipSuccess) { grid = -1; return; }
        if (hipFuncSetAttribute((const void*)fwd_kernel, hipFuncAttributeMaxDynamicSharedMemorySize, LDS_BYTES) != hipSuccess) { fprintf(stderr, "kernel_launch: hipFuncSetAttribute failed\n"); grid = -1; return; }
        if (hipOccupancyMaxActiveBlocksPerMultiprocessor(&per_cu, (const void*)fwd_kernel, 512, LDS_BYTES) != hipSuccess || per_cu < 1)
            fprintf(stderr, "kernel_launch: occupancy query reports %d\n", per_cu);
        (void)hipGetLastError();
        grid = cus;
    }
    if (grid < 0) return;
    (void)hipMemsetAsync((char*)d_ws + WS_CTL, 0, CTL_BYTES, stream);
    Args a{};
    for (int i = 0; i < 34; ++i) a.in[i] = (const float*)d_in[i];
    a.out = (float*)d_out; a.ws = (unsigned char*)d_ws;
#if MK_ONE
    a.ph_lo = 0; a.ph_hi = DEPTH * NPH;
    hipLaunchKernelGGL(fwd_kernel, dim3(grid), dim3(512), LDS_BYTES, stream, a);
#else
    for (int p = 0; p < DEPTH * NPH; ++p) { a.ph_lo = p; a.ph_hi = p + 1; hipLaunchKernelGGL(fwd_kernel, dim3(grid), dim3(512), LDS_BYTES, stream, a); }
#endif
}
```

```cpp
#include <hip/hip_runtime.h>
#include <cstdio>
#include <cstdint>

#ifndef MK_ONE
#define MK_ONE 1
#endif

#define LAS __attribute__((address_space(3)))
typedef unsigned short bf16;
typedef short bf16x8 __attribute__((ext_vector_type(8)));
typedef float f32x4 __attribute__((ext_vector_type(4)));
typedef float f32x2 __attribute__((ext_vector_type(2)));
typedef unsigned u32x4 __attribute__((ext_vector_type(4)));
typedef unsigned u32x2 __attribute__((ext_vector_type(2)));
typedef int i32x8 __attribute__((ext_vector_type(8)));

constexpr int D = 2048, NBATCH = 8, T = 2048, M = NBATCH * T, DEPTH = 2;
constexpr int D_IN = 15888;
constexpr int LD = 16128;
constexpr int COL_G = 0, COL_LG = 6144, COL_Z = 7168, COL_Q = 8192, COL_K = 11264, COL_V = 12288, COL_LX = 13312, COL_XBC = 14336, COL_DT = 15872;
constexpr int N8 = 14336;
constexpr int NE = 64, EDIM = 512, TOPK = 8;
constexpr float LN_EPS = 1e-5f, RMS_EPS = 1e-6f, ALPHA = 1.41421356237f;
constexpr int YLD = 3072;
constexpr int NPH = 11;

constexpr size_t MiB = 1u << 20;
constexpr size_t WS_CTL = 0, CTL_BYTES = 1 * MiB;
constexpr size_t WS_LTS = 2 * MiB, WS_LW = 6 * MiB;
constexpr size_t WS_ALAST = 10 * MiB;
constexpr size_t WS_LSE = 11 * MiB;
constexpr size_t WS_W = 16 * MiB;
constexpr size_t W_IN = 0, W_PL = 63 * MiB, W_PS = 67 * MiB, W_PA = 71 * MiB, W_OUT = 75 * MiB, W_LR = 83 * MiB, W_LI = W_LR + 262144, W_RH = W_LR + 524288, W_RL = W_RH + 262144, W_UP = 84 * MiB, W_IN8 = 216 * MiB, W_DN = 344 * MiB;
constexpr size_t WS_H = 490 * MiB, WS_HB = 618 * MiB, WS_H1 = 682 * MiB, WS_H1B = 810 * MiB;
constexpr size_t WS_PROJ = 874 * MiB;
constexpr size_t WS_PRE = WS_PROJ, WS_Y = WS_H1B;
constexpr size_t WS_TMAP = 13 * MiB;
constexpr size_t WS_WGCNT = 14 * MiB;
constexpr size_t WS_YL = 1450 * MiB, WS_YS = 1482 * MiB, WS_YA = 1514 * MiB, WS_OG = 1546 * MiB;
constexpr size_t WS_HID = WS_YL;
constexpr size_t WS_SST = 1644 * MiB;
constexpr size_t WS_G8 = 1708 * MiB;
constexpr size_t WS_MF = 1708 * MiB, WS_MB = 1836 * MiB, WS_HQ = 1900 * MiB, WS_END = 1932 * MiB;
constexpr int CW_BAR = 4096;
constexpr int CW_CNT = 16384;

constexpr int LDS_BYTES = 147456;
constexpr int MISC_OFF = 147456 - 64;

#define LDS_WAIT() asm volatile("s_waitcnt lgkmcnt(0)" ::: "memory")
#define VM_WAIT() asm volatile("s_waitcnt vmcnt(0)" ::: "memory")
__device__ __forceinline__ float bf2f(unsigned v) { return __uint_as_float(v << 16); }
__device__ __forceinline__ float bflo(unsigned w) { return __uint_as_float(w << 16); }
__device__ __forceinline__ float bfhi(unsigned w) { return __uint_as_float(w & 0xffff0000u); }
__device__ __forceinline__ unsigned pk2(float lo, float hi) { unsigned r; asm volatile("v_cvt_pk_bf16_f32 %0, %1, %2" : "=v"(r) : "v"(lo), "v"(hi)); return r; }
__device__ __forceinline__ unsigned pk4_fp8(float a, float b, float c, float d) { int r = __builtin_amdgcn_cvt_pk_fp8_f32(a, b, 0, false); r = __builtin_amdgcn_cvt_pk_fp8_f32(c, d, r, true); return (unsigned)r; }
__device__ __forceinline__ u32x4 pack8(const float (&v)[8]) { u32x4 o; o.x = pk2(v[0], v[1]); o.y = pk2(v[2], v[3]); o.z = pk2(v[4], v[5]); o.w = pk2(v[6], v[7]); return o; }
template <int N> __device__ __forceinline__ float row_shr(float old, float v) {
    return __int_as_float(__builtin_amdgcn_update_dpp(__float_as_int(old), __float_as_int(v), 0x110 + N, 0xf, 0xf, false)); }
__device__ __forceinline__ void st16_wt(void* p, u32x4 v) { asm volatile("global_store_dwordx4 %0, %1, off sc0 sc1\n\ts_nop 1" :: "v"(p), "v"(v) : "memory"); }
__device__ __forceinline__ void st8_wt(void* p, u32x2 v) { asm volatile("global_store_dwordx2 %0, %1, off sc0 sc1" :: "v"(p), "v"(v) : "memory"); }
__device__ __forceinline__ float sigmoidf_(float x) { return __builtin_amdgcn_rcpf(1.0f + __expf(-x)); }
__device__ __forceinline__ float siluf_(float x) { return x * sigmoidf_(x); }
__device__ __forceinline__ float softplusf_(float x) { return x > 20.f ? x : log1pf(__expf(x)); }
__device__ __forceinline__ float gelu_tanh(float x) { const float u = 0.7978845608f * (x + 0.044715f * x * x * x); const float t = 1.0f - 2.0f * __builtin_amdgcn_rcpf(1.0f + __expf(2.0f * u)); return 0.5f * x * (1.0f + t); }
__device__ __forceinline__ float wave_sum(float v) {
#pragma unroll
    for (int o = 1; o < 64; o <<= 1) v += __shfl_xor(v, o);
    return v;
}
__device__ __forceinline__ bf16x8 as_bf16x8(u32x4 v) { return __builtin_bit_cast(bf16x8, v); }
__device__ __forceinline__ void tr_read2(unsigned a0, unsigned a1, u32x2& r0, u32x2& r1) {
    asm volatile("ds_read_b64_tr_b16 %0, %2\n\tds_read_b64_tr_b16 %1, %3\n\ts_waitcnt lgkmcnt(0)" : "=&v"(r0), "=&v"(r1) : "v"(a0), "v"(a1) : "memory");
}

__device__ __forceinline__ void tr_issue16(unsigned a0, unsigned a1, u32x2 (&lo)[8], u32x2 (&hi)[8]) {
    asm volatile("ds_read_b64_tr_b16 %0, %16\n\tds_read_b64_tr_b16 %8, %17\n\t"
                 "ds_read_b64_tr_b16 %1, %16 offset:32\n\tds_read_b64_tr_b16 %9, %17 offset:32\n\t"
                 "ds_read_b64_tr_b16 %2, %16 offset:64\n\tds_read_b64_tr_b16 %10, %17 offset:64\n\t"
                 "ds_read_b64_tr_b16 %3, %16 offset:96\n\tds_read_b64_tr_b16 %11, %17 offset:96\n\t"
                 "ds_read_b64_tr_b16 %4, %16 offset:128\n\tds_read_b64_tr_b16 %12, %17 offset:128\n\t"
                 "ds_read_b64_tr_b16 %5, %16 offset:160\n\tds_read_b64_tr_b16 %13, %17 offset:160\n\t"
                 "ds_read_b64_tr_b16 %6, %16 offset:192\n\tds_read_b64_tr_b16 %14, %17 offset:192\n\t"
                 "ds_read_b64_tr_b16 %7, %16 offset:224\n\tds_read_b64_tr_b16 %15, %17 offset:224"
                 : "=&v"(lo[0]), "=&v"(lo[1]), "=&v"(lo[2]), "=&v"(lo[3]), "=&v"(lo[4]), "=&v"(lo[5]), "=&v"(lo[6]), "=&v"(lo[7]),
                   "=&v"(hi[0]), "=&v"(hi[1]), "=&v"(hi[2]), "=&v"(hi[3]), "=&v"(hi[4]), "=&v"(hi[5]), "=&v"(hi[6]), "=&v"(hi[7])
                 : "v"(a0), "v"(a1) : "memory");
}
__device__ __forceinline__ void tr_wait16(u32x2 (&lo)[8], u32x2 (&hi)[8]) {
    asm volatile("s_waitcnt lgkmcnt(0)" : "+v"(lo[0]), "+v"(lo[1]), "+v"(lo[2]), "+v"(lo[3]), "+v"(lo[4]), "+v"(lo[5]), "+v"(lo[6]), "+v"(lo[7]),
                   "+v"(hi[0]), "+v"(hi[1]), "+v"(hi[2]), "+v"(hi[3]), "+v"(hi[4]), "+v"(hi[5]), "+v"(hi[6]), "+v"(hi[7]) :: "memory");
}
__device__ __forceinline__ void tr_read16(unsigned a0, unsigned a1, u32x2 (&lo)[8], u32x2 (&hi)[8]) {
    asm volatile("ds_read_b64_tr_b16 %0, %16\n\tds_read_b64_tr_b16 %8, %17\n\t"
                 "ds_read_b64_tr_b16 %1, %16 offset:32\n\tds_read_b64_tr_b16 %9, %17 offset:32\n\t"
                 "ds_read_b64_tr_b16 %2, %16 offset:64\n\tds_read_b64_tr_b16 %10, %17 offset:64\n\t"
                 "ds_read_b64_tr_b16 %3, %16 offset:96\n\tds_read_b64_tr_b16 %11, %17 offset:96\n\t"
                 "ds_read_b64_tr_b16 %4, %16 offset:128\n\tds_read_b64_tr_b16 %12, %17 offset:128\n\t"
                 "ds_read_b64_tr_b16 %5, %16 offset:160\n\tds_read_b64_tr_b16 %13, %17 offset:160\n\t"
                 "ds_read_b64_tr_b16 %6, %16 offset:192\n\tds_read_b64_tr_b16 %14, %17 offset:192\n\t"
                 "ds_read_b64_tr_b16 %7, %16 offset:224\n\tds_read_b64_tr_b16 %15, %17 offset:224\n\t"
                 "s_waitcnt lgkmcnt(0)"
                 : "=&v"(lo[0]), "=&v"(lo[1]), "=&v"(lo[2]), "=&v"(lo[3]), "=&v"(lo[4]), "=&v"(lo[5]), "=&v"(lo[6]), "=&v"(lo[7]),
                   "=&v"(hi[0]), "=&v"(hi[1]), "=&v"(hi[2]), "=&v"(hi[3]), "=&v"(hi[4]), "=&v"(hi[5]), "=&v"(hi[6]), "=&v"(hi[7])
                 : "v"(a0), "v"(a1) : "memory");
}
namespace pg8 {
struct Pair8 { bf16x8 a, b; };
__device__ __forceinline__ i32x8 cat8(bf16x8 lo, bf16x8 hi) { return __builtin_bit_cast(i32x8, Pair8{lo, hi}); }
constexpr int BM = 256, BK = 64, HALF = 128, HTB = HALF * BK * 2, STAGE_BYTES = 8 * HTB;
__device__ __forceinline__ int lds_byte(int r, int c) { const int st = (r >> 4) * 2 + (c >> 5), rr = r & 15, cc = c & 31, ob = rr * 64 + cc * 2; return st * 1024 + (ob ^ (((ob >> 9) & 1) << 5)); }
__device__ __forceinline__ void stage_rc(int b, int& R, int& C) { const int st = b / 1024, sb = b % 1024, swz = sb ^ (((sb >> 9) & 1) << 5); R = (st >> 1) * 16 + swz / 64; C = (st & 1) * 32 + (swz % 64) / 2; }
__device__ __forceinline__ int perm32(int rho) { const int n = rho >> 4, i = rho & 15; return 8 * (i >> 2) + 4 * n + (i & 3); }

template <class Epi, class Sched, bool FP8 = false>
__device__ __forceinline__ void gemm_phase(LAS unsigned char* lds, const char* Abase, const int K, const Sched& S, const Epi& E, const int tid) {
    const int wid = __builtin_amdgcn_readfirstlane(tid >> 6), lane = tid & 63, wr = wid >> 2, wc = wid & 3, fr = lane & 15, fq = lane >> 4;
    const int rowb = FP8 ? K : 2 * K, nt = rowb / 128;
    unsigned voffB[2];
#pragma unroll
    for (int i = 0; i < 2; ++i) { int R, C; stage_rc(tid * 16 + i * 8192, R, C); const int Rb = Epi::PERM == 2 ? (64 * (R >> 5) + 16 * ((R & 15) >> 2) + 4 * ((R >> 4) & 1) + (R & 3)) : Epi::PERM == 1 ? ((R & ~31) + perm32(R & 31)) : R; voffB[i] = (unsigned)(Rb * rowb + C * 2); }
    const size_t kstep = (size_t)(BK * 2);
    const size_t hstep = (size_t)(Epi::PERM == 2 ? 8 : HALF) * rowb;
    const unsigned ldsw = (unsigned)wid * 1024u;
    const int aoff = lds_byte(wr * 64 + fr, fq * 8), boff = lds_byte(wc * 32 + fr, fq * 8);
#define PG8_SA(b, h) (((b) * 2 + (h)) * HTB)
#define PG8_SB(b, h) ((4 + (b) * 2 + (h)) * HTB)
#define PG8_STAGE(bufoff, gbase, voff) do { _Pragma("unroll") for (int _i = 0; _i < 2; ++_i) \
        __builtin_amdgcn_global_load_lds((const unsigned*)((const char*)(gbase) + (voff)[_i]), (LAS unsigned*)(lds + (bufoff) + ldsw + _i * 8192), 16, 0, 0); } while (0)
#define PG8_LDA(dst, b, h) do { _Pragma("unroll") for (int m = 0; m < 4; ++m) _Pragma("unroll") for (int k = 0; k < 2; ++k) dst[m][k] = *(const LAS bf16x8*)(lds + PG8_SA(b, h) + aoff + m * 2048 + k * 1024); } while (0)
#define PG8_LDB(dst, b, h) do { _Pragma("unroll") for (int n = 0; n < 2; ++n) _Pragma("unroll") for (int k = 0; k < 2; ++k) dst[n][k] = *(const LAS bf16x8*)(lds + PG8_SB(b, h) + boff + n * 2048 + k * 1024); } while (0)
#define PG8_MMA(ai, bj, At, Bt) do { __builtin_amdgcn_s_setprio(1); _Pragma("unroll") for (int m = 0; m < 4; ++m) _Pragma("unroll") for (int n = 0; n < 2; ++n) { \
        if constexpr (FP8) acc[ai][bj][m][n] = __builtin_amdgcn_mfma_scale_f32_16x16x128_f8f6f4(cat8(Bt[n][0], Bt[n][1]), cat8(At[m][0], At[m][1]), acc[ai][bj][m][n], 0, 0, 0, 0, 0, 0); \
        else { _Pragma("unroll") for (int k = 0; k < 2; ++k) acc[ai][bj][m][n] = __builtin_amdgcn_mfma_f32_16x16x32_bf16(Bt[n][k], At[m][k], acc[ai][bj][m][n], 0, 0, 0); } } __builtin_amdgcn_s_setprio(0); } while (0)
#define PG8_WAIT_V(n) asm volatile("s_waitcnt vmcnt(" #n ")" ::: "memory")
#define PG8_WAIT_L(n) asm volatile("s_waitcnt lgkmcnt(" #n ")" ::: "memory")
#define PG8_BAR __builtin_amdgcn_s_barrier()
#define PG8_SCHED __builtin_amdgcn_sched_barrier(0)
    typename Sched::Unit cur, nxt; int ui = 0;
    if (!S.next(0, cur)) return;
    f32x4 acc[2][2][4][2];
#pragma unroll
    for (int a = 0; a < 2; ++a)
#pragma unroll
        for (int b = 0; b < 2; ++b)
#pragma unroll
            for (int m = 0; m < 4; ++m)
#pragma unroll
                for (int n = 0; n < 2; ++n) acc[a][b][m][n] = (f32x4){0.f, 0.f, 0.f, 0.f};
    bf16x8 At[4][2], B0[2][2], B1[2][2];
    unsigned oc[2][2];
    S.aoffs(cur, tid, oc);
    const char* cB = S.bptr(cur);
    PG8_STAGE(PG8_SB(0, 0), cB, voffB); PG8_STAGE(PG8_SA(0, 0), Abase, oc[0]); PG8_STAGE(PG8_SB(0, 1), cB + hstep, voffB); PG8_STAGE(PG8_SA(0, 1), Abase, oc[1]);
    if (wr == 1) PG8_BAR;
    PG8_WAIT_V(4); PG8_BAR;
    PG8_STAGE(PG8_SB(1, 0), cB + kstep, voffB); PG8_STAGE(PG8_SA(1, 0), Abase + kstep, oc[0]); PG8_STAGE(PG8_SB(1, 1), cB + hstep + kstep, voffB);
    PG8_WAIT_V(6); PG8_BAR;
    for (;;) {
        const bool has_next = S.next(ui + 1, nxt);
        const char* nB = has_next ? S.bptr(nxt) : cB;
#pragma unroll 1
        for (int t = 0; t < nt; t += 2) {
            const bool last = (t == nt - 2);
            if constexpr (Epi::MID > 0) { if (t > 0 && (t % Epi::MID) == 0) E.mid(acc, cur, t / Epi::MID, wr, wc, fr, fq); }
            const char* a1 = Abase + (size_t)(t + 1) * kstep;
            const char* a2 = last ? Abase : Abase + (size_t)(t + 2) * kstep; const char* b2 = last ? nB : cB + (size_t)(t + 2) * kstep;
            const char* a3 = a2 + kstep; const char* b3 = b2 + kstep;
            PG8_LDB(B0, 0, 0); PG8_SCHED; PG8_LDA(At, 0, 0); PG8_STAGE(PG8_SA(1, 1), a1, oc[1]);
            PG8_WAIT_L(8); PG8_BAR; PG8_WAIT_L(0); PG8_MMA(0, 0, At, B0); PG8_BAR; PG8_SCHED;
            if (last && has_next) S.aoffs(nxt, tid, oc);
            PG8_LDB(B1, 0, 1); PG8_STAGE(PG8_SB(0, 0), b2, voffB);
            PG8_BAR; PG8_WAIT_L(0); PG8_MMA(0, 1, At, B1); PG8_BAR;
            PG8_LDA(At, 0, 1); PG8_STAGE(PG8_SA(0, 0), a2, oc[0]);
            PG8_BAR; PG8_WAIT_L(0); PG8_MMA(1, 0, At, B0); PG8_BAR; PG8_SCHED;
            PG8_STAGE(PG8_SB(0, 1), b2 + hstep, voffB);
            PG8_WAIT_V(6); PG8_BAR; PG8_MMA(1, 1, At, B1); PG8_BAR;
            PG8_LDB(B0, 1, 0); PG8_SCHED; PG8_LDA(At, 1, 0); PG8_STAGE(PG8_SA(0, 1), a2, oc[1]);
            PG8_WAIT_L(8); PG8_BAR; PG8_WAIT_L(0); PG8_MMA(0, 0, At, B0); PG8_BAR; PG8_SCHED;
            PG8_LDB(B1, 1, 1); PG8_STAGE(PG8_SB(1, 0), b3, voffB);
            PG8_BAR; PG8_WAIT_L(0); PG8_MMA(0, 1, At, B1); PG8_BAR;
            PG8_LDA(At, 1, 1); PG8_STAGE(PG8_SA(1, 0), a3, oc[0]);
            PG8_BAR; PG8_WAIT_L(0); PG8_MMA(1, 0, At, B0); PG8_BAR; PG8_SCHED;
            PG8_STAGE(PG8_SB(1, 1), b3 + hstep, voffB);
            PG8_WAIT_V(6); PG8_BAR; PG8_MMA(1, 1, At, B1); PG8_BAR;
        }
        if (wr == 0) PG8_BAR;
        if constexpr (FP8) {
#pragma unroll
            for (int a = 0; a < 2; ++a)
#pragma unroll
                for (int b = 0; b < 2; ++b)
#pragma unroll
                    for (int m = 0; m < 4; ++m)
#pragma unroll
                        for (int n = 0; n < 2; ++n) acc[a][b][m][n] *= 0.03125f;
        }
        E(acc, cur, wr, wc, fr, fq);
        if (!has_next) break;
#pragma unroll
        for (int a = 0; a < 2; ++a)
#pragma unroll
            for (int b = 0; b < 2; ++b)
#pragma unroll
                for (int m = 0; m < 4; ++m)
#pragma unroll
                    for (int n = 0; n < 2; ++n) acc[a][b][m][n] = (f32x4){0.f, 0.f, 0.f, 0.f};
        cur = nxt; cB = nB; ++ui;
        if (wr == 1) PG8_BAR;
    }
    PG8_WAIT_V(0);
    PG8_BAR;
#undef PG8_SA
#undef PG8_SB
#undef PG8_STAGE
#undef PG8_LDA
#undef PG8_LDB
#undef PG8_MMA
#undef PG8_WAIT_V
#undef PG8_WAIT_L
#undef PG8_BAR
#undef PG8_SCHED
}
}

struct DenseUnit { int pm, pn; };
template <bool F8 = false> struct DenseSchedT {
    typedef DenseUnit Unit;
    int nM, nN, nwg, G, c, K; const char* Bt;
    __device__ __forceinline__ void init(int M_, int N_, int K_, int G_, int c_, const void* Bt_) { nM = M_ / 256; nN = N_ / 256; nwg = nM * nN; G = G_; c = c_; K = K_; Bt = (const char*)Bt_; }
    __device__ __forceinline__ bool next(int i, Unit& u) const {
        const long L = (long)i * G + c; if (L >= nwg) return false;
        int wgid = (int)L; { const int q = nwg / 8, r = nwg % 8, xcd = wgid % 8, off = wgid / 8; wgid = (xcd < r ? xcd * (q + 1) : r * (q + 1) + (xcd - r) * q) + off; }
        const int nig = 8 * nN, gid = wgid / nig, fm = gid * 8, gsz = (nM - fm) < 8 ? (nM - fm) : 8;
        u.pm = fm + ((wgid % nig) % gsz); u.pn = (wgid % nig) / gsz; return true;
    }
    __device__ __forceinline__ const char* bptr(const Unit& u) const { return Bt + (size_t)u.pn * 256 * K * (F8 ? 1 : 2); }
    __device__ __forceinline__ void aoffs(const Unit& u, int tid, unsigned (&o)[2][2]) const {
#pragma unroll
        for (int i = 0; i < 2; ++i) { int R, C; pg8::stage_rc(tid * 16 + i * 8192, R, C);
#pragma unroll
            for (int h = 0; h < 2; ++h) o[h][i] = F8 ? (unsigned)((u.pm * 256 + 128 * h + R) * K + C * 2) : (unsigned)((u.pm * 256 + 128 * h + R) * K + C) * 2u; }
    }
};
typedef DenseSchedT<false> DenseSched;
struct MoeUnit { int e, rb, pn, nvalid, blk; };
template <bool UP> struct MoeSched {
    typedef MoeUnit Unit;
    int x, w, W, nunits, NBr; int pe[9]; int pend, cntl;
    const int* lts; const char* Wt;
    static constexpr int NPN = UP ? 4 : 8, BPG = 32 / NPN;
    __device__ __forceinline__ void init(int G_, int bid, const unsigned* cnt, const int* lts_, const void* W_, int lane) {
        x = bid & 7; w = bid >> 3; W = (G_ - x + 7) >> 3; lts = lts_; Wt = (const char*)W_;
        cntl = (int)cnt[lane * 16]; const int nb = (cntl + 255) >> 8; int s = nb;
#pragma unroll
        for (int o = 1; o < 64; o <<= 1) { const int t = __shfl_up(s, o); if (lane >= o) s += t; }
        pend = s; NBr = __builtin_amdgcn_readlane(s, 63);
        pe[0] = 0;
#pragma unroll
        for (int k = 0; k < 8; ++k) pe[k + 1] = pe[k] + __builtin_amdgcn_readlane(nb, x + 8 * k);
        nunits = (pe[8] + 8) * NPN;
    }
    __device__ __forceinline__ bool next(int i, Unit& u) const {
        const int j = i * W + w; if (j >= nunits) return false;
        const int Bx = pe[8] + 8, FG = Bx / BPG; int bi;
        if (j < FG * 32) { bi = (j >> 5) * BPG + (j & 31) / NPN; u.pn = j % NPN; }
        else { const int j2 = j - FG * 32; bi = FG * BPG + j2 / NPN; u.pn = j2 % NPN; }
        if (bi < pe[8]) {
            int k = 0, st = 0;
#pragma unroll
            for (int q = 1; q < 8; ++q) if (bi >= pe[q]) { k = q; st = pe[q]; }
            const int e = x + 8 * k;
            const int base = e ? __builtin_amdgcn_readlane(pend, e - 1) : 0;
            const int ce = __builtin_amdgcn_readlane(cntl, e);
            u.e = e; u.rb = bi - st; u.blk = base + u.rb; const int rem = ce - u.rb * 256; u.nvalid = rem < 256 ? rem : 256;
        } else { u.e = 64; u.rb = x + 8 * (bi - pe[8]); u.blk = NBr + u.rb; u.nvalid = 256; }
        return true;
    }
    __device__ __forceinline__ const char* bptr(const Unit& u) const {
        return UP ? Wt + ((size_t)u.e * 1024 + (size_t)u.pn * 256) * 2048 : Wt + ((size_t)u.e * 2048 + (size_t)u.pn * 256) * 512;
    }
    __device__ __forceinline__ void aoffs(const Unit& u, int tid, unsigned (&o)[2][2]) const {
#pragma unroll
        for (int i = 0; i < 2; ++i) { int R, C; pg8::stage_rc(tid * 16 + i * 8192, R, C);
#pragma unroll
            for (int h = 0; h < 2; ++h) {
                const int r = 128 * h + R;
                if (UP) {
                    int tok;
                    if (u.e < 64) { tok = 0; if (r < u.nvalid) tok = lts[u.e * 16384 + u.rb * 256 + r] >> 4; }
                    else tok = u.rb * 256 + r;
                    o[h][i] = (unsigned)(tok * 2048 + C * 2);
                } else o[h][i] = (unsigned)((u.blk * 256 + r) * 512 + C * 2);
            } }
    }
};

struct EpiStoreBf16 {
    static constexpr int PERM = 1, MID = 0;
    bf16* O; int ldc; int coff;
    __device__ __forceinline__ void operator()(const f32x4 (&acc)[2][2][4][2], const DenseUnit& u, int wr, int wc, int fr, int fq) const {
        const int row0 = u.pm * 256 + wr * 64 + fr, col0 = coff + u.pn * 256 + wc * 32 + 8 * fq;
#pragma unroll
        for (int ai = 0; ai < 2; ++ai)
#pragma unroll
            for (int m = 0; m < 4; ++m) { bf16* rowp = O + (size_t)(row0 + ai * 128 + m * 16) * ldc + col0;
#pragma unroll
                for (int bj = 0; bj < 2; ++bj) { const f32x4 v0 = acc[ai][bj][m][0], v1 = acc[ai][bj][m][1];
                    u32x4 w; w.x = pk2(v0[0], v0[1]); w.y = pk2(v0[2], v0[3]); w.z = pk2(v1[0], v1[1]); w.w = pk2(v1[2], v1[3]);
                    st16_wt(rowp + bj * 128, w); } }
    }
};
struct EpiStoreF8 {
    static constexpr int PERM = 2, MID = 0;
    unsigned char* O; int ldc;
    __device__ __forceinline__ void operator()(const f32x4 (&acc)[2][2][4][2], const DenseUnit& u, int wr, int wc, int fr, int fq) const {
        const int row0 = u.pm * 256 + wr * 64 + fr, col0 = u.pn * 256 + wc * 64 + 16 * fq;
#pragma unroll
        for (int ai = 0; ai < 2; ++ai)
#pragma unroll
            for (int m = 0; m < 4; ++m) { const f32x4 v0 = acc[ai][0][m][0], v1 = acc[ai][0][m][1], v2 = acc[ai][1][m][0], v3 = acc[ai][1][m][1];
                u32x4 o; o.x = pk4_fp8(v0[0], v0[1], v0[2], v0[3]); o.y = pk4_fp8(v1[0], v1[1], v1[2], v1[3]); o.z = pk4_fp8(v2[0], v2[1], v2[2], v2[3]); o.w = pk4_fp8(v3[0], v3[1], v3[2], v3[3]);
                st16_wt(O + (size_t)(row0 + ai * 128 + m * 16) * ldc + col0, o); }
    }
};
template <int MODE> struct EpiGate {
    static constexpr int PERM = 1, MID = 0;
    const bf16* proj; const float* bg; bf16* mb; int gcol;
    __device__ __forceinline__ void operator()(const f32x4 (&acc)[2][2][4][2], const DenseUnit& u, int wr, int wc, int fr, int fq) const {
        const int row0 = u.pm * 256 + wr * 64 + fr, col0 = u.pn * 256 + wc * 32 + 8 * fq;
        f32x4 bv[2][2];
#pragma unroll
        for (int bj = 0; bj < 2; ++bj) { bv[bj][0] = *(const f32x4*)(bg + gcol + col0 + bj * 128); bv[bj][1] = *(const f32x4*)(bg + gcol + col0 + bj * 128 + 4); }
#pragma unroll
        for (int ai = 0; ai < 2; ++ai)
#pragma unroll
            for (int mh = 0; mh < 2; ++mh) {
                u32x4 gr[2][2], pm[2][2];
#pragma unroll
                for (int mm = 0; mm < 2; ++mm) { const size_t row = (size_t)(row0 + ai * 128 + (2 * mh + mm) * 16);
#pragma unroll
                    for (int bj = 0; bj < 2; ++bj) { gr[mm][bj] = *(const u32x4*)(proj + row * LD + COL_G + gcol + col0 + bj * 128);
                        if (MODE >= 1) pm[mm][bj] = *(const u32x4*)(mb + row * D + col0 + bj * 128); } }
#pragma unroll
                for (int mm = 0; mm < 2; ++mm) { const int m = 2 * mh + mm; const size_t row = (size_t)(row0 + ai * 128 + m * 16);
#pragma unroll
                    for (int bj = 0; bj < 2; ++bj) { const u32x4 g = gr[mm][bj];
                        f32x4 g0, g1;
                        g0[0] = sigmoidf_(bflo(g.x) + bv[bj][0][0]); g0[1] = sigmoidf_(bfhi(g.x) + bv[bj][0][1]); g0[2] = sigmoidf_(bflo(g.y) + bv[bj][0][2]); g0[3] = sigmoidf_(bfhi(g.y) + bv[bj][0][3]);
                        g1[0] = sigmoidf_(bflo(g.z) + bv[bj][1][0]); g1[1] = sigmoidf_(bfhi(g.z) + bv[bj][1][1]); g1[2] = sigmoidf_(bflo(g.w) + bv[bj][1][2]); g1[3] = sigmoidf_(bfhi(g.w) + bv[bj][1][3]);
                        f32x4 v0 = acc[ai][bj][m][0] * g0, v1 = acc[ai][bj][m][1] * g1;
                        if (MODE >= 1) { const u32x4 p = pm[mm][bj]; v0[0] += bflo(p.x); v0[1] += bfhi(p.x); v0[2] += bflo(p.y); v0[3] += bfhi(p.y); v1[0] += bflo(p.z); v1[1] += bfhi(p.z); v1[2] += bflo(p.w); v1[3] += bfhi(p.w); }
                        u32x4 w; w.x = pk2(v0[0], v0[1]); w.y = pk2(v0[2], v0[3]); w.z = pk2(v1[0], v1[1]); w.w = pk2(v1[2], v1[3]); *(u32x4*)(mb + row * D + col0 + bj * 128) = w;
                    } }
                asm volatile("" ::: "memory"); }
    }
};
struct EpiGate3 {
    static constexpr int PERM = 2, MID = 16;
    const unsigned char* g8; const float* bg; bf16* mb;
    static __device__ __forceinline__ float rat(float a, float b) { return (1.0f + __builtin_amdgcn_exp2f(b * -1.44269504f)) * __builtin_amdgcn_rcpf(1.0f + __builtin_amdgcn_exp2f(a * -1.44269504f)); }
    __device__ __forceinline__ void mid(f32x4 (&acc)[2][2][4][2], const DenseUnit& u, int s, int wr, int wc, int fr, int fq) const {
        const int row0 = u.pm * 256 + wr * 64 + fr, col0 = u.pn * 256 + wc * 64 + 16 * fq;
        const unsigned char* pa = g8 + (s - 1) * 2048 + col0; const float* ba = bg + (s - 1) * 2048 + col0;
#pragma unroll
        for (int ai = 0; ai < 2; ++ai) {
            u32x4 ga[4], gb[4];
#pragma unroll
            for (int m = 0; m < 4; ++m) { const size_t row = (size_t)(row0 + ai * 128 + m * 16); ga[m] = *(const u32x4*)(pa + row * 6144); gb[m] = *(const u32x4*)(pa + row * 6144 + 2048); }
#pragma unroll
            for (int q = 0; q < 4; ++q) {
                const f32x4 a = *(const f32x4*)(ba + 4 * q), b = *(const f32x4*)(ba + 2048 + 4 * q);
#pragma unroll
                for (int m = 0; m < 4; ++m) { const int pw = (int)ga[m][q], qw = (int)gb[m][q];
                    const f32x2 p0 = __builtin_amdgcn_cvt_pk_f32_fp8(pw, false), p1 = __builtin_amdgcn_cvt_pk_f32_fp8(pw, true), q0 = __builtin_amdgcn_cvt_pk_f32_fp8(qw, false), q1 = __builtin_amdgcn_cvt_pk_f32_fp8(qw, true);
                    f32x4 r; r[0] = rat(p0[0] + a[0], q0[0] + b[0]); r[1] = rat(p0[1] + a[1], q0[1] + b[1]); r[2] = rat(p1[0] + a[2], q1[0] + b[2]); r[3] = rat(p1[1] + a[3], q1[1] + b[3]);
                    acc[ai][q >> 1][m][q & 1] *= r; } }
            asm volatile("" ::: "memory"); }
    }
    __device__ __forceinline__ void operator()(const f32x4 (&acc)[2][2][4][2], const DenseUnit& u, int wr, int wc, int fr, int fq) const {
        const int row0 = u.pm * 256 + wr * 64 + fr, col0 = u.pn * 256 + wc * 64 + 16 * fq;
        const unsigned char* pa = g8 + 4096 + col0; const float* ba = bg + 4096 + col0;
#pragma unroll
        for (int ai = 0; ai < 2; ++ai) {
            u32x4 ga[4];
#pragma unroll
            for (int m = 0; m < 4; ++m) ga[m] = *(const u32x4*)(pa + (size_t)(row0 + ai * 128 + m * 16) * 6144);
#pragma unroll
            for (int m = 0; m < 4; ++m) { u32x4 w[2];
#pragma unroll
                for (int q = 0; q < 4; ++q) { const f32x4 a = *(const f32x4*)(ba + 4 * q); const int pw = (int)ga[m][q];
                    const f32x2 p0 = __builtin_amdgcn_cvt_pk_f32_fp8(pw, false), p1 = __builtin_amdgcn_cvt_pk_f32_fp8(pw, true); const f32x4 v = acc[ai][q >> 1][m][q & 1];
                    w[q >> 1][2 * (q & 1)] = pk2(v[0] * sigmoidf_(p0[0] + a[0]), v[1] * sigmoidf_(p0[1] + a[1])); w[q >> 1][2 * (q & 1) + 1] = pk2(v[2] * sigmoidf_(p1[0] + a[2]), v[3] * sigmoidf_(p1[1] + a[3])); }
                bf16* op = mb + (size_t)(row0 + ai * 128 + m * 16) * D + col0; *(u32x4*)op = w[0]; *(u32x4*)(op + 8) = w[1]; }
            asm volatile("" ::: "memory"); }
    }
};
struct EpiResid {
    static constexpr int PERM = 0, MID = 0;
    const float* h; float* pre;
    __device__ __forceinline__ void operator()(const f32x4 (&acc)[2][2][4][2], const DenseUnit& u, int wr, int wc, int fr, int fq) const {
        const int row0 = u.pm * 256 + wr * 64 + fr, col0 = u.pn * 256 + wc * 32 + 4 * fq;
#pragma unroll
        for (int ai = 0; ai < 2; ++ai)
#pragma unroll
            for (int mh = 0; mh < 2; ++mh) { f32x4 hv[2][2][2];
#pragma unroll
                for (int mm = 0; mm < 2; ++mm) { const size_t off = (size_t)(row0 + ai * 128 + (2 * mh + mm) * 16) * D + col0;
#pragma unroll
                    for (int bj = 0; bj < 2; ++bj)
#pragma unroll
                        for (int n = 0; n < 2; ++n) hv[mm][bj][n] = *(const f32x4*)(h + off + bj * 128 + n * 16); }
#pragma unroll
                for (int mm = 0; mm < 2; ++mm) { const int m = 2 * mh + mm; const size_t off = (size_t)(row0 + ai * 128 + m * 16) * D + col0;
#pragma unroll
                    for (int bj = 0; bj < 2; ++bj)
#pragma unroll
                        for (int n = 0; n < 2; ++n) { const f32x4 o = hv[mm][bj][n] * ALPHA + acc[ai][bj][m][n]; st16_wt(pre + off + bj * 128 + n * 16, __builtin_bit_cast(u32x4, o)); } }
                asm volatile("" ::: "memory"); }
    }
};
struct EpiMoeUp {
    static constexpr int PERM = 1, MID = 0;
    unsigned char* H;
    __device__ __forceinline__ void operator()(const f32x4 (&acc)[2][2][4][2], const MoeUnit& u, int wr, int wc, int fr, int fq) const {
        const int row0 = u.blk * 256 + wr * 64 + fr, col0 = u.pn * 128 + wc * 32 + 8 * fq;
#pragma unroll
        for (int ai = 0; ai < 2; ++ai)
#pragma unroll
            for (int m = 0; m < 4; ++m) {
                const f32x4 g0 = acc[ai][0][m][0], g1 = acc[ai][0][m][1], u0 = acc[ai][1][m][0], u1 = acc[ai][1][m][1];
                u32x2 w; w.x = pk4_fp8(siluf_(g0[0]) * u0[0], siluf_(g0[1]) * u0[1], siluf_(g0[2]) * u0[2], siluf_(g0[3]) * u0[3]);
                w.y = pk4_fp8(siluf_(g1[0]) * u1[0], siluf_(g1[1]) * u1[1], siluf_(g1[2]) * u1[2], siluf_(g1[3]) * u1[3]);
                *(u32x2*)(H + (size_t)(row0 + ai * 128 + m * 16) * 512 + col0) = w; }
    }
};
struct EpiMoeDown {
    static constexpr int PERM = 2, MID = 0;
    bf16* Y;
    __device__ __forceinline__ void operator()(const f32x4 (&acc)[2][2][4][2], const MoeUnit& u, int wr, int wc, int fr, int fq) const {
        const int col0 = u.pn * 256 + wc * 64 + 16 * fq;
#pragma unroll
        for (int ai = 0; ai < 2; ++ai)
#pragma unroll
            for (int m = 0; m < 4; ++m) { const int r = ai * 128 + wr * 64 + m * 16 + fr;
                if (r < u.nvalid) {
                    unsigned char* rowp = (unsigned char*)Y + (size_t)(u.blk * 256 + r) * D + col0;
                    const f32x4 v0 = acc[ai][0][m][0], v1 = acc[ai][0][m][1], v2 = acc[ai][1][m][0], v3 = acc[ai][1][m][1];
                    u32x4 o; o.x = pk4_fp8(v0[0], v0[1], v0[2], v0[3]); o.y = pk4_fp8(v1[0], v1[1], v1[2], v1[3]); o.z = pk4_fp8(v2[0], v2[1], v2[2], v2[3]); o.w = pk4_fp8(v3[0], v3[1], v3[2], v3[3]);
                    *(u32x4*)rowp = o;
                } }
    }
};

#define XB_TMO      128
#define XB_XCNT(j)  (256  + 64 * (j))
#define XB_XSUB(j)  (1280 + 64 * (j))
#define XB_XGEN(j)  (2304 + 64 * (j))
#define XB_TOP      3328
#define XB_TOPGEN   3392
#define XCD_BAR_WORDS 3456
#define XB_SPIN_CAP (1u << 18)
__device__ __forceinline__ unsigned xb_ld(unsigned* p)              { return __hip_atomic_load(p, __ATOMIC_RELAXED, __HIP_MEMORY_SCOPE_AGENT); }
__device__ __forceinline__ unsigned xb_add(unsigned* p, unsigned v) { return __hip_atomic_fetch_add(p, v, __ATOMIC_RELAXED, __HIP_MEMORY_SCOPE_AGENT); }
__device__ __forceinline__ unsigned xb_xcc_id() { return (unsigned)__builtin_amdgcn_s_getreg((3 << 11) | 20) & 0xFu; }
#define XB_SPIN(cond, bar) do { unsigned _sp = 0; while (cond) { __builtin_amdgcn_s_sleep(1); \
    if ((++_sp & 255u) == 0u) { if (xb_ld(&(bar)[XB_TMO])) break; if (_sp > XB_SPIN_CAP) { atomicAdd(&(bar)[XB_TMO], 1u); break; } } } } while (0)
struct XcdBarrier { unsigned* bar; unsigned x; volatile LAS unsigned* st; };
__device__ __forceinline__ XcdBarrier xcd_barrier_post(unsigned* bar, volatile LAS unsigned* st) {
    XcdBarrier b; b.bar = bar; b.x = xb_xcc_id(); b.st = st;
    if (threadIdx.x == 0) (void)xb_add(&bar[XB_XCNT(b.x)], 1u);
    return b;
}
__device__ __forceinline__ void xcd_barrier_complete(unsigned* bar, unsigned x, unsigned& nloc, unsigned& nx) {
    const unsigned G = gridDim.x * gridDim.y * gridDim.z;
    unsigned sum, cnt, mine, sp = 0u;
    for (;;) {
        sum = 0u; cnt = 0u; mine = 0u;
#pragma unroll
        for (unsigned j = 0; j < 16; ++j) { const unsigned c = xb_ld(&bar[XB_XCNT(j)]); sum += c; cnt += (c > 0u) ? 1u : 0u; mine = (j == x) ? c : mine; }
        if (sum == G) break;
        __builtin_amdgcn_s_sleep(1);
        if ((++sp & 255u) == 0u) { if (xb_ld(&bar[XB_TMO])) break; if (sp > XB_SPIN_CAP) { atomicAdd(&bar[XB_TMO], 1u); break; } }
    }
    nloc = mine > 0u ? mine : 1u; nx = cnt > 0u ? cnt : 1u;
}
__device__ __forceinline__ void xcd_barrier(const XcdBarrier& b) {
    asm volatile("s_waitcnt vmcnt(0)" ::: "memory");
    __syncthreads();
    if (threadIdx.x == 0) {
        unsigned* bar = b.bar;
        __builtin_amdgcn_s_waitcnt(0);
        unsigned nloc = b.st[0], nx = b.st[1];
        if (nloc == 0u) { xcd_barrier_complete(bar, b.x, nloc, nx); b.st[0] = nloc; b.st[1] = nx; }
        const unsigned old = xb_add(&bar[XB_XSUB(b.x)], 1u);
        const unsigned gen = old / nloc;
        if (old + 1u == (gen + 1u) * nloc) {
            __builtin_amdgcn_fence(__ATOMIC_RELEASE, "agent");
            asm volatile("s_waitcnt vmcnt(0)" ::: "memory");
            const unsigned og = xb_add(&bar[XB_TOP], 1u);
            const unsigned tg = og / nx;
            if (og + 1u == (tg + 1u) * nx) xb_add(&bar[XB_TOPGEN], 1u);
            else XB_SPIN(xb_ld(&bar[XB_TOPGEN]) == tg, bar);
            __builtin_amdgcn_fence(__ATOMIC_ACQUIRE, "agent");
            xb_add(&bar[XB_XGEN(b.x)], 1u);
            asm volatile("s_waitcnt vmcnt(0)" ::: "memory");
        } else {
            XB_SPIN(xb_ld(&bar[XB_XGEN(b.x)]) == gen, bar);
            __builtin_amdgcn_fence(__ATOMIC_ACQUIRE, "agent");
            asm volatile("s_waitcnt vmcnt(0)" ::: "memory");
        }
    }
    __syncthreads();
}

typedef const float* cfp_t;
typedef const cfp_t __attribute__((address_space(4)))* InTab;
__device__ __forceinline__ void stagger(int bid, unsigned step_10ns) {
    const unsigned cls = (unsigned)(bid >> 3) & 3u;
    if (cls) { const unsigned long long t0 = __builtin_amdgcn_s_memrealtime(); while (__builtin_amdgcn_s_memrealtime() - t0 < (unsigned long long)(cls * step_10ns)) __builtin_amdgcn_s_sleep(8); }
}
template <int F8 = 0> __device__ __forceinline__ void cvt_item(const float* W, int ld, int Kd, bf16* WT, LAS float* scr, int k0, int nsrc, int drow, int nvalid, int lane, size_t lo_off = 0) {
    const int nn = lane & 31;
    { float t[32]; const float* wp = W + (size_t)(k0 + (lane >> 5)) * ld + nsrc + nn;
#pragma unroll
      for (int i = 0; i < 32; ++i) t[i] = (nn < nvalid) ? __builtin_nontemporal_load(wp + (size_t)(2 * i) * ld) : 0.f;
#pragma unroll
      for (int i = 0; i < 32; ++i) scr[(2 * i + (lane >> 5)) * 33 + nn] = t[i]; }
    LDS_WAIT(); asm volatile("" ::: "memory");
    const int c = lane & 7;
#pragma unroll
    for (int j = 0; j < 4; ++j) { const int n = (lane >> 3) + 8 * j; const LAS float* s = scr + (8 * c) * 33 + n;
        if constexpr (F8 == 2) { float hi[8], lo[8];
#pragma unroll
            for (int e = 0; e < 8; ++e) { const float x = s[e * 33]; hi[e] = bf2f(pk2(x, 0.f) & 0xffffu); lo[e] = x - hi[e]; }
            const int kk = k0 + 8 * c, nn2 = drow + n; const size_t off = ((size_t)((kk >> 5) * 4 + (nn2 >> 4)) * 64 + ((kk & 31) >> 3) * 16 + (nn2 & 15)) * 8;
            if (n < nvalid) { *(u32x4*)(WT + off) = pack8(hi); *(u32x4*)(WT + lo_off + off) = pack8(lo); } }
        else if constexpr (F8 == 1) { u32x2 o; o.x = pk4_fp8(s[0 * 33] * 32.f, s[1 * 33] * 32.f, s[2 * 33] * 32.f, s[3 * 33] * 32.f); o.y = pk4_fp8(s[4 * 33] * 32.f, s[5 * 33] * 32.f, s[6 * 33] * 32.f, s[7 * 33] * 32.f);
            if (n < nvalid) *(u32x2*)((unsigned char*)WT + (size_t)(drow + n) * Kd + k0 + 8 * c) = o; }
        else { u32x4 o; o.x = pk2(s[0 * 33], s[1 * 33]); o.y = pk2(s[2 * 33], s[3 * 33]); o.z = pk2(s[4 * 33], s[5 * 33]); o.w = pk2(s[6 * 33], s[7 * 33]);
            if (n < nvalid) *(u32x4*)(WT + (size_t)(drow + n) * Kd + k0 + 8 * c) = o; } }
    LDS_WAIT(); asm volatile("" ::: "memory");
}
__device__ __forceinline__ void ln_store(float (&v)[4][8], const float* g, const float* b, int lane, float* of, bf16* ob, unsigned char* oq = nullptr) {
    float s = 0.f;
#pragma unroll
    for (int j = 0; j < 4; ++j)
#pragma unroll
        for (int e = 0; e < 8; ++e) s += v[j][e];
    const float mean = wave_sum(s) * (1.f / D); float s2 = 0.f;
#pragma unroll
    for (int j = 0; j < 4; ++j)
#pragma unroll
        for (int e = 0; e < 8; ++e) { v[j][e] -= mean; s2 += v[j][e] * v[j][e]; }
    const float rstd = 1.f / sqrtf(wave_sum(s2) * (1.f / D) + LN_EPS);
#pragma unroll
    for (int j = 0; j < 4; ++j) { const int c0 = 512 * j + 8 * lane;
        const f32x4 g0 = *(const f32x4*)(g + c0), g1 = *(const f32x4*)(g + c0 + 4), b0 = *(const f32x4*)(b + c0), b1 = *(const f32x4*)(b + c0 + 4);
        f32x4 y0, y1;
#pragma unroll
        for (int e = 0; e < 4; ++e) { y0[e] = v[j][e] * rstd * g0[e] + b0[e]; y1[e] = v[j][4 + e] * rstd * g1[e] + b1[e]; }
        if (of) { *(f32x4*)(of + c0) = y0; *(f32x4*)(of + c0 + 4) = y1; }
        if (ob) { u32x4 w; w.x = pk2(y0[0], y0[1]); w.y = pk2(y0[2], y0[3]); w.z = pk2(y1[0], y1[1]); w.w = pk2(y1[2], y1[3]); *(u32x4*)(ob + c0) = w; }
        if (oq) { u32x2 w; w.x = pk4_fp8(y0[0], y0[1], y0[2], y0[3]); w.y = pk4_fp8(y1[0], y1[1], y1[2], y1[3]); *(u32x2*)(oq + c0) = w; } }
}
struct XItem { const float* W; unsigned char* WT; int ld, Kd, k0, drow; };
template <bool UPF> __device__ __forceinline__ XItem x_decode(int r, InTab in, int l, unsigned char* wbase) {
    XItem q;
    if (UPF) { const int e = r / 512, p = r % 512, w = p / 256, kb = (p % 256) / 16, nb = p % 16, j0 = nb * 32;
        q.W = (e < 64 ? in[26 + w] + ((size_t)l * NE + e) * 2048 * 512 : in[29 + w] + (size_t)l * 2048 * 512) + j0;
        q.WT = wbase + W_UP + (size_t)e * 1024 * 2048; q.ld = 512; q.Kd = 2048; q.k0 = kb * 128; q.drow = (j0 / 128) * 256 + w * 128 + (j0 % 128); }
    else { const int e = r / 256, p = r % 256, kb = p / 64, nb = p % 64;
        q.W = (e < 64 ? in[28] + ((size_t)l * NE + e) * 512 * 2048 : in[31] + (size_t)l * 512 * 2048) + nb * 32;
        q.WT = wbase + W_DN + (size_t)e * 2048 * 512; q.ld = 2048; q.Kd = 512; q.k0 = kb * 128; q.drow = nb * 32; }
    return q;
}
template <bool UPF> __device__ __forceinline__ void x_family(LAS float* scr, InTab in, int l, unsigned char* wbase, int gw, int NGW, int lane) {
    constexpr int NI = UPF ? 65 * 2 * 256 : 65 * 256;
#pragma unroll 1
    for (int it = gw; it < NI; it += NGW) {
        const XItem q = x_decode<UPF>(it, in, l, wbase);
        float t[64]; const float* wp = q.W + (size_t)(q.k0 + (lane >> 5)) * q.ld + (lane & 31);
#pragma unroll
        for (int i = 0; i < 64; ++i) t[i] = __builtin_nontemporal_load(wp + (size_t)(2 * i) * q.ld);
#pragma unroll
        for (int hf = 0; hf < 2; ++hf) {
            const int nn = lane & 31;
#pragma unroll
            for (int i = 0; i < 32; ++i) scr[(2 * i + (lane >> 5)) * 33 + nn] = t[32 * hf + i];
            LDS_WAIT(); asm volatile("" ::: "memory");
            const int c = lane & 7;
#pragma unroll
            for (int j = 0; j < 4; ++j) { const int n = (lane >> 3) + 8 * j; const LAS float* s = scr + (8 * c) * 33 + n;
                u32x2 o; o.x = pk4_fp8(s[0 * 33] * 32.f, s[1 * 33] * 32.f, s[2 * 33] * 32.f, s[3 * 33] * 32.f); o.y = pk4_fp8(s[4 * 33] * 32.f, s[5 * 33] * 32.f, s[6 * 33] * 32.f, s[7 * 33] * 32.f);
                *(u32x2*)(q.WT + (size_t)(q.drow + n) * q.Kd + q.k0 + 64 * hf + 8 * c) = o; }
            LDS_WAIT(); asm volatile("" ::: "memory");
        }
    }
}
__device__ __forceinline__ void p0_convert(LAS unsigned char* lds, InTab in, int l, unsigned char* wbase, int gw, int NGW, int wave, int lane) {
    LAS float* scr = (LAS float*)(lds + wave * 16384);
    constexpr int I_IN = 32 * 497, I_PR = 1024, I_OUT = 2048, I_LR = 128, I_UP = 65 * 2 * 512, I_DN = 65 * 512;
    constexpr int I_RT = 64;
    constexpr int NITEMS = I_IN + 3 * I_PR + I_OUT + I_LR + I_RT;
    bf16* Win = (bf16*)(wbase + W_IN);
    for (int it = gw; it < NITEMS; it += NGW) {
        int r = it;
        if (r < I_IN) { const int kb = r / 497, nb = r % 497;
            int nsrc, drow, nv = 32;
            if (nb < 192) { nsrc = nb * 32; drow = nb * 32; }
            else if (nb < 224) { nsrc = nb * 32; drow = COL_LX + (nb - 192) * 32; }
            else if (nb < 256) { nsrc = nb * 32; drow = COL_LG + (nb - 224) * 32; }
            else if (nb < 288) { nsrc = nb * 32; drow = COL_Z + (nb - 256) * 32; }
            else if (nb < 336) { nsrc = nb * 32; drow = COL_XBC + (nb - 288) * 32; }
            else if (nb < 432) { nsrc = 10768 + (nb - 336) * 32; drow = COL_Q + (nb - 336) * 32; }
            else if (nb < 464) { nsrc = 10768 + (nb - 336) * 32; drow = COL_K + (nb - 432) * 32; }
            else if (nb < 496) { nsrc = 10768 + (nb - 336) * 32; drow = COL_V + (nb - 464) * 32; }
            else { nsrc = 10752; drow = COL_DT; nv = 16; }
            if (drow < N8) cvt_item<1>(in[3] + (size_t)l * D * D_IN, D_IN, 2048, (bf16*)(wbase + W_IN8), scr, kb * 64, nsrc, drow, nv, lane);
            else cvt_item(in[3] + (size_t)l * D * D_IN, D_IN, 2048, Win, scr, kb * 64, nsrc, drow, nv, lane);
            continue; }
        r -= I_IN;
        if (r < 3 * I_PR) { const int w = r / I_PR, q = r % I_PR, kb = q / 64, nb = q % 64;
            const float* src = in[18 + w] + (size_t)l * 1024 * D; bf16* dst = (bf16*)(wbase + W_PL) + w * 1024;
            cvt_item(src, 2048, YLD, dst, scr, kb * 64, nb * 32, nb * 32, 32, lane); continue; }
        r -= 3 * I_PR;
        if (r < I_OUT) { const int kb = r / 64, nb = r % 64; cvt_item(in[21] + (size_t)l * D * D, 2048, 2048, (bf16*)(wbase + W_OUT), scr, kb * 64, nb * 32, nb * 32, 32, lane); continue; }
        r -= I_OUT;
        if (r < I_LR) { const int w = r / 64, q = r % 64, blk = q / 8, kb = (q % 8) / 4, nb = q % 4;
            cvt_item(in[7 + 2 * w] + (size_t)l * 8 * 16384 + blk * 16384, 128, 128, (bf16*)(wbase + W_LR + (size_t)w * 262144) + blk * 16384, scr, kb * 64, nb * 32, nb * 32, 32, lane); continue; }
        r -= I_LR;
        { const int kb = r / 2, nb = r % 2;
            cvt_item<2>(in[24] + (size_t)l * D * NE, NE, 2048, (bf16*)(wbase + W_RH), scr, kb * 64, nb * 32, nb * 32, 32, lane, (W_RL - W_RH) / 2); }
    }
    x_family<true>(scr, in, l, wbase, gw, NGW, lane);
    x_family<false>(scr, in, l, wbase, gw, NGW, lane);
    { u32x4* z = (u32x4*)(Win + (size_t)(COL_DT + 16) * 2048); const int n16 = 240 * 2048 * 2 / 16;
      for (int i = gw * 64 + lane; i < n16; i += NGW * 64) z[i] = (u32x4){0u, 0u, 0u, 0u}; }
}

template <int TPT> __device__ __forceinline__ void conv8(const bf16* src, int l0g, const float* cw, int cstride, const float* cb, float (&out)[TPT][8]) {
    u32x4 rows[TPT + 3];
#pragma unroll
    for (int j = 0; j < TPT + 3; ++j) { rows[j] = (u32x4){0u, 0u, 0u, 0u}; if (l0g + j - 3 >= 0) rows[j] = *(const u32x4*)(src + (ptrdiff_t)(j - 3) * LD); }
    float w[4][8], bb[8];
#pragma unroll
    for (int k = 0; k < 4; ++k) { const f32x4 a = *(const f32x4*)(cw + k * cstride), b = *(const f32x4*)(cw + k * cstride + 4);
#pragma unroll
        for (int e = 0; e < 4; ++e) { w[k][e] = a[e]; w[k][4 + e] = b[e]; } }
    { const f32x4 a = *(const f32x4*)cb, b = *(const f32x4*)(cb + 4);
#pragma unroll
      for (int e = 0; e < 4; ++e) { bb[e] = a[e]; bb[4 + e] = b[e]; } }
#pragma unroll
    for (int j = 0; j < TPT; ++j) {
#pragma unroll
        for (int e = 0; e < 8; ++e) out[j][e] = bb[e];
#pragma unroll
        for (int k = 0; k < 4; ++k) { const u32x4 x = rows[j + k];
            out[j][0] += w[k][0] * bflo(x.x); out[j][1] += w[k][1] * bfhi(x.x); out[j][2] += w[k][2] * bflo(x.y); out[j][3] += w[k][3] * bfhi(x.y);
            out[j][4] += w[k][4] * bflo(x.z); out[j][5] += w[k][5] * bfhi(x.z); out[j][6] += w[k][6] * bflo(x.w); out[j][7] += w[k][7] * bfhi(x.w); }
    }
}

__device__ __forceinline__ int lru_idx(int tok, int d) { return tok * 32 + (d ^ (4 * ((tok >> 3) & 7))); }
#define LDS_BAR() do { asm volatile("s_waitcnt lgkmcnt(0)" ::: "memory"); __builtin_amdgcn_s_barrier(); asm volatile("" ::: "memory"); } while (0)
constexpr int KS = 272;
struct AttnTask { int grp, b, h, dil, r, tb; };
__device__ __forceinline__ AttnTask attn_decode(int run, int k) {
    AttnTask t; t.grp = run >> 8; const int bh = (run >> 2) & 63, ti = 4 * (run & 3) + k; t.b = bh >> 3; t.h = bh & 7;
    if (t.grp == 0) { t.dil = 1; t.r = 0; t.tb = ti; } else if (t.grp == 1) { t.dil = 4; t.r = ti >> 2; t.tb = ti & 3; } else { t.dil = 16; t.r = ti; t.tb = 0; }
    return t;
}
__device__ __forceinline__ void attn_prefetch(const bf16* __restrict__ proj, const AttnTask& t, bool prev, int tid, u32x4 (&kr)[8], u32x4 (&vr)[8]) {
#pragma unroll
    for (int j = 0; j < 8; ++j) { const int idx = tid + 512 * j, row = idx >> 4, ch = idx & 15;
        if (prev || j >= 4) { const int tk = (t.tb * 128 - 128 + row) * t.dil + t.r; const bf16* src = proj + (size_t)(t.b * T + tk) * LD + t.h * 128 + ch * 8;
            kr[j] = *(const u32x4*)(src + COL_K); vr[j] = *(const u32x4*)(src + COL_V); } }
}
__device__ __forceinline__ void attn_phase(LAS unsigned char* lds, const bf16* __restrict__ proj, bf16* __restrict__ og, float* __restrict__ lse, int G, int bid, int tid) {
    const int lane = tid & 63, wave = __builtin_amdgcn_readfirstlane(tid >> 6);
    const int lr = lane & 15, lg = lane >> 4, lq = (lane & 15) >> 2, lp = lane & 3;
    LAS unsigned char* Kl = lds; LAS unsigned char* Vl = lds + 256 * KS;
    const unsigned vbase = (unsigned)(uintptr_t)Vl;
    u32x4 kr[8], vr[8];
    constexpr int NRUN = 768;
    if (bid < NRUN) { const AttnTask t0 = attn_decode(bid, 0); attn_prefetch(proj, t0, t0.tb != 0, tid, kr, vr); }
    for (int it = 0; bid + (it >> 2) * G < NRUN; ++it) {
        const int run = bid + (it >> 2) * G, k = it & 3;
        const AttnTask t = attn_decode(run, k);
        const int grp = t.grp, b = t.b, h = t.h, dil = t.dil, r = t.r, tb = t.tb;
        const int ub = tb * 128;
        const int ph = (k & 1) * 128;
        const bool prev = (k == 0) && tb != 0;
        LDS_BAR();
#pragma unroll
        for (int j = 0; j < 8; ++j) { const int idx = tid + 512 * j, row = (idx >> 4) ^ ph, ch = idx & 15;
            if (prev || j >= 4) { *(LAS u32x4*)(Kl + row * KS + ch * 16) = kr[j]; *(LAS u32x4*)(Vl + row * KS + ch * 16) = vr[j]; } }
        const int iq = 16 * wave + lr; const int tq = (ub + iq) * dil + r;
        const bf16* qp = proj + (size_t)(b * T + tq) * LD + COL_Q + grp * 1024 + h * 128 + 8 * lg;
        bf16x8 qf[4];
#pragma unroll
        for (int ks = 0; ks < 4; ++ks) qf[ks] = *(const bf16x8*)(qp + 32 * ks);
        { const int itn = it + 1, runn = bid + (itn >> 2) * G;
          if (runn < NRUN) { const AttnTask tn = attn_decode(runn, itn & 3); attn_prefetch(proj, tn, ((itn & 3) == 0) && tn.tb != 0, tid, kr, vr); } }
        LDS_BAR();
        const float slope = exp2f(-8.0f * (float)(grp * 8 + h + 1) / 24.0f) * (float)dil;
        const float scale = 0.08838834764831845f;
        int kb_lo = wave >> 1; const int kb_hi = (16 * wave + 143) >> 5; if (tb == 0 && kb_lo < 4) kb_lo = 4;
        float sj[2][4];
#pragma unroll
        for (int sb = 0; sb < 2; ++sb)
#pragma unroll
            for (int e = 0; e < 4; ++e) sj[sb][e] = slope * (float)(16 * sb + 4 * lg + e);
        float m_run = -1e30f, l_run = 0.f;
        f32x4 accO[8];
#pragma unroll
        for (int c = 0; c < 8; ++c) accO[c] = (f32x4){0.f, 0.f, 0.f, 0.f};
        for (int kb = kb_lo; kb <= kb_hi; ++kb) {
            const unsigned va = vbase + (unsigned)(((32 * kb + 4 * lg + lq) ^ ph) * KS + 8 * lp);
            u32x2 vlo[8], vhi[8]; tr_issue16(va, va + 16 * KS, vlo, vhi);
            f32x4 sacc[2];
#pragma unroll
            for (int sb = 0; sb < 2; ++sb) { sacc[sb] = (f32x4){0.f, 0.f, 0.f, 0.f};
#pragma unroll
                for (int ks = 0; ks < 4; ++ks) { const bf16x8 kf = *(const LAS bf16x8*)(Kl + ((32 * kb + 16 * sb + lr) ^ ph) * KS + 64 * ks + 16 * lg);
                    sacc[sb] = __builtin_amdgcn_mfma_f32_16x16x32_bf16(kf, qf[ks], sacc[sb], 0, 0, 0); } }
            const float kbt = slope * (float)(32 * kb);
            float sv[2][4];
#pragma unroll
            for (int sb = 0; sb < 2; ++sb)
#pragma unroll
                for (int e = 0; e < 4; ++e) sv[sb][e] = sacc[sb][e] * scale + (sj[sb][e] + kbt);
            if (!((32 * kb >= 16 * wave + 15) && (32 * kb + 31 <= 16 * wave + 128))) {
#pragma unroll
                for (int sb = 0; sb < 2; ++sb)
#pragma unroll
                    for (int e = 0; e < 4; ++e) { const int dist = iq + 128 - (32 * kb + 16 * sb + 4 * lg + e); if (dist < 0 || dist > 128) sv[sb][e] = -1e30f; }
            }
            float mx = fmaxf(fmaxf(fmaxf(sv[0][0], sv[0][1]), fmaxf(sv[0][2], sv[0][3])), fmaxf(fmaxf(sv[1][0], sv[1][1]), fmaxf(sv[1][2], sv[1][3])));
            mx = fmaxf(mx, __shfl_xor(mx, 16)); mx = fmaxf(mx, __shfl_xor(mx, 32));
            if (__builtin_amdgcn_ballot_w64(mx > m_run + 8.0f) != 0ull) {
                const float m_new = fmaxf(m_run, mx); const float alpha = __expf(m_run - m_new);
                l_run *= alpha; m_run = m_new;
#pragma unroll
                for (int c = 0; c < 8; ++c) accO[c] *= alpha;
            }
            float p[2][4]; float ps = 0.f;
#pragma unroll
            for (int sb = 0; sb < 2; ++sb)
#pragma unroll
                for (int e = 0; e < 4; ++e) { p[sb][e] = __expf(sv[sb][e] - m_run); ps += p[sb][e]; }
            l_run += ps;
            u32x4 pw; pw.x = pk2(p[0][0], p[0][1]); pw.y = pk2(p[0][2], p[0][3]); pw.z = pk2(p[1][0], p[1][1]); pw.w = pk2(p[1][2], p[1][3]);
            const bf16x8 pf = as_bf16x8(pw);
            tr_wait16(vlo, vhi);
#pragma unroll
            for (int c = 0; c < 8; ++c) { u32x4 vw; vw.x = vlo[c].x; vw.y = vlo[c].y; vw.z = vhi[c].x; vw.w = vhi[c].y;
                accO[c] = __builtin_amdgcn_mfma_f32_16x16x32_bf16(as_bf16x8(vw), pf, accO[c], 0, 0, 0); }
        }
        float lt = l_run; lt += __shfl_xor(lt, 16); lt += __shfl_xor(lt, 32);
        const float inv = 1.0f / lt;
        bf16* op = og + ((size_t)grp * M + (size_t)(b * T + tq)) * 1024 + h * 128 + 4 * lg;
#pragma unroll
        for (int c = 0; c < 8; ++c) { u32x2 w; w.x = pk2(accO[c][0] * inv, accO[c][1] * inv); w.y = pk2(accO[c][2] * inv, accO[c][3] * inv); *(u32x2*)(op + 16 * c) = w; }
        if (lg == 0) lse[((size_t)grp * M + (size_t)(b * T + tq)) * 8 + h] = m_run + __logf(lt) - slope * (float)(iq + 128);
    }
}
__device__ __forceinline__ void attn_merge(const bf16* __restrict__ og, const float* __restrict__ lse, bf16* __restrict__ ya, int gw, int NGW, int lane) {
    for (int row = gw; row < M; row += NGW) {
#pragma unroll
        for (int j = 0; j < 2; ++j) { const int cb = lane + 64 * j, h = cb >> 4;
            const float l0 = lse[(size_t)row * 8 + h], l1 = lse[((size_t)M + row) * 8 + h], l2 = lse[((size_t)2 * M + row) * 8 + h];
            const float mx = fmaxf(l0, fmaxf(l1, l2)); float w0 = __expf(l0 - mx), w1 = __expf(l1 - mx), w2 = __expf(l2 - mx); const float inv = 1.0f / (w0 + w1 + w2); w0 *= inv; w1 *= inv; w2 *= inv;
            const u32x4 a = *(const u32x4*)(og + (size_t)row * 1024 + cb * 8), b = *(const u32x4*)(og + ((size_t)M + row) * 1024 + cb * 8), c = *(const u32x4*)(og + ((size_t)2 * M + row) * 1024 + cb * 8);
            u32x4 o;
            o.x = pk2(w0 * bflo(a.x) + w1 * bflo(b.x) + w2 * bflo(c.x), w0 * bfhi(a.x) + w1 * bfhi(b.x) + w2 * bfhi(c.x));
            o.y = pk2(w0 * bflo(a.y) + w1 * bflo(b.y) + w2 * bflo(c.y), w0 * bfhi(a.y) + w1 * bfhi(b.y) + w2 * bfhi(c.y));
            o.z = pk2(w0 * bflo(a.z) + w1 * bflo(b.z) + w2 * bflo(c.z), w0 * bfhi(a.z) + w1 * bfhi(b.z) + w2 * bfhi(c.z));
            o.w = pk2(w0 * bflo(a.w) + w1 * bflo(b.w) + w2 * bflo(c.w), w0 * bfhi(a.w) + w1 * bfhi(b.w) + w2 * bfhi(c.w));
            *(u32x4*)(ya + (size_t)row * YLD + cb * 8) = o; }
    }
}

__device__ __forceinline__ float ssd_dt_acum(LAS float* DT, LAS float* AC, const bf16* __restrict__ proj, const float* dt_bias, const float* a_log, int b, int c, int g, int wave, int lane) {
    const int h = 8 * g + wave; const float bias = dt_bias[h], a = -__expf(a_log[h]);
    const size_t rowb = (size_t)(b * T + c * 128 + 2 * lane) * LD + COL_DT + h;
    const float d0 = softplusf_(bf2f(proj[rowb]) + bias), d1 = softplusf_(bf2f(proj[rowb + LD]) + bias);
    const float v0 = d0 * a, v1 = d1 * a; float s = v0 + v1;
#pragma unroll
    for (int o = 1; o < 64; o <<= 1) { const float t = __shfl_up(s, o); if (lane >= o) s += t; }
    DT[wave * 128 + 2 * lane] = d0; DT[wave * 128 + 2 * lane + 1] = d1;
    AC[wave * 128 + 2 * lane] = s - v1; AC[wave * 128 + 2 * lane + 1] = s;
    return __shfl(s, 63);
}
__device__ __forceinline__ void ssd_stage_bc(LAS unsigned char* img, const bf16* __restrict__ proj, const float* cw, const float* cb, int b, int c, int chan0, int tid) {
    const int ch = tid & 15, tg = tid >> 4;
    const int l0 = tg * 4, col = chan0 + ch * 8;
    float o[4][8];
    conv8<4>(proj + (size_t)(b * T + c * 128 + l0) * LD + COL_XBC + col, c * 128 + l0, cw + col, 1536, cb + col, o);
#pragma unroll
    for (int j = 0; j < 4; ++j) { float v[8];
#pragma unroll
        for (int e = 0; e < 8; ++e) v[e] = siluf_(o[j][e]);
        *(LAS u32x4*)(img + (l0 + j) * KS + ch * 16) = pack8(v); }
}
constexpr int XS = 528;
template <bool SCALE> __device__ __forceinline__ void ssd_stage_x(LAS unsigned char* img, const bf16* __restrict__ proj, const float* cw, const float* cb, int b, int c, int chan0, LAS const float* WL, int hb, int tid) {
    const int ch = tid & 31, tg = tid >> 5;
    const int col = chan0 + ch * 8;
#pragma unroll 1
    for (int sub = 0; sub < 2; ++sub) {
        const int l0 = tg * 8 + sub * 4;
        float o[4][8];
        conv8<4>(proj + (size_t)(b * T + c * 128 + l0) * LD + COL_XBC + col, c * 128 + l0, cw + col, 1536, cb + col, o);
#pragma unroll
        for (int j = 0; j < 4; ++j) { float v[8]; const float sc = SCALE ? WL[(hb + (ch >> 3)) * 128 + l0 + j] : 1.0f;
#pragma unroll
            for (int e = 0; e < 8; ++e) v[e] = siluf_(o[j][e]) * sc;
            *(LAS u32x4*)(img + (l0 + j) * XS + ch * 16) = pack8(v); }
    }
}
__device__ __forceinline__ void ssd_states_phase(LAS unsigned char* lds, const bf16* __restrict__ proj, const float* cw, const float* cb, const float* dt_bias, const float* a_log,
                                                 float* __restrict__ sst, float* __restrict__ alast, int G, int bid, int tid) {
    const int lane = tid & 63, wave = __builtin_amdgcn_readfirstlane(tid >> 6);
    LAS float* DT = (LAS float*)lds; LAS float* AC = DT + 1024; LAS float* WL = AC + 1024;
    LAS unsigned char* BMi = lds + 12288; LAS unsigned char* Xi = BMi + 128 * KS;
    const unsigned bbase = (unsigned)(uintptr_t)BMi, xbase = (unsigned)(uintptr_t)Xi;
    for (int unit = bid; unit < 256; unit += G) {
        const int b = unit >> 5, c = (unit >> 1) & 15, g = unit & 1;
        __syncthreads();
        const float al = ssd_dt_acum(DT, AC, proj, dt_bias, a_log, b, c, g, wave, lane);
        if (lane == 0) alast[(b * 16 + c) * 16 + 8 * g + wave] = al;
        LDS_WAIT();
        WL[wave * 128 + 2 * lane] = DT[wave * 128 + 2 * lane] * __expf(al - AC[wave * 128 + 2 * lane]);
        WL[wave * 128 + 2 * lane + 1] = DT[wave * 128 + 2 * lane + 1] * __expf(al - AC[wave * 128 + 2 * lane + 1]);
        ssd_stage_bc(BMi, proj, cw, cb, b, c, 1024 + 128 * g, tid);
        __syncthreads();
#pragma unroll 1
        for (int pass = 0; pass < 2; ++pass) {
            if (pass) __syncthreads();
            ssd_stage_x<true>(Xi, proj, cw, cb, b, c, 512 * g + 256 * pass, WL, 4 * pass, tid);
            __syncthreads();
            int ln = lane; asm volatile("" : "+v"(ln));
            const int lr = ln & 15, lg = ln >> 4, lq = (ln & 15) >> 2, lp = ln & 3;
            const int hl = wave >> 1, ph = wave & 1;
            f32x4 acc[2][8];
#pragma unroll
            for (int mt = 0; mt < 2; ++mt)
#pragma unroll
                for (int nt = 0; nt < 8; ++nt) acc[mt][nt] = (f32x4){0.f, 0.f, 0.f, 0.f};
            const unsigned xa = xbase + (unsigned)((8 * lg + lq) * XS + (64 * hl + 32 * ph + 4 * lp) * 2);
            const unsigned ba = bbase + (unsigned)((8 * lg + lq) * KS + (4 * lp) * 2);
#pragma unroll
            for (int ks = 0; ks < 4; ++ks) {
                bf16x8 af[2];
#pragma unroll
                for (int mt = 0; mt < 2; ++mt) { const unsigned a0 = xa + (unsigned)(32 * ks * XS + 32 * mt);
                    u32x2 lo, hi; tr_read2(a0, a0 + 4 * XS, lo, hi); u32x4 w; w.x = lo.x; w.y = lo.y; w.z = hi.x; w.w = hi.y; af[mt] = as_bf16x8(w); }
#pragma unroll
                for (int nt = 0; nt < 8; ++nt) { const unsigned b0 = ba + (unsigned)(32 * ks * KS + 32 * nt);
                    u32x2 lo, hi; tr_read2(b0, b0 + 4 * KS, lo, hi); u32x4 w; w.x = lo.x; w.y = lo.y; w.z = hi.x; w.w = hi.y; const bf16x8 bfr = as_bf16x8(w);
#pragma unroll
                    for (int mt = 0; mt < 2; ++mt) acc[mt][nt] = __builtin_amdgcn_mfma_f32_16x16x32_bf16(af[mt], bfr, acc[mt][nt], 0, 0, 0); }
            }
            const int h = 8 * g + 4 * pass + hl;
#pragma unroll
            for (int mt = 0; mt < 2; ++mt) {
                float* sp = sst + ((size_t)((b * 16 + c) * 16 + h) * 64 + 32 * ph + 16 * mt + 4 * lg) * 128 + lr;
                asm volatile("" : "+v"(sp));
#pragma unroll
                for (int nt = 0; nt < 8; ++nt)
#pragma unroll
                    for (int e = 0; e < 4; ++e) sp[e * 128 + 16 * nt] = acc[mt][nt][e];
            }
        }
    }
}
__device__ __forceinline__ void ssd_pass_phase(float* __restrict__ sst, const float* __restrict__ alast, int G, int bid, int tid) {
    for (int i = bid * 512 + tid; i < 262144; i += G * 512) {
        const int b = i >> 15, q = i & 32767, h = q >> 11;
        f32x4* base = (f32x4*)sst + (size_t)b * 16 * 32768 + q;
        f32x4 v[16];
#pragma unroll
        for (int c = 0; c < 16; ++c) v[c] = base[(size_t)c * 32768];
        f32x4 e = (f32x4){0.f, 0.f, 0.f, 0.f};
#pragma unroll
        for (int c = 0; c < 16; ++c) { base[(size_t)c * 32768] = e; const float dec = __expf(alast[(b * 16 + c) * 16 + h]); e = e * dec + v[c]; }
    }
}
__device__ __forceinline__ void ssd_out_phase(LAS unsigned char* lds, const bf16* __restrict__ proj, const float* cw, const float* cb, const float* dt_bias, const float* a_log,
                                              const float* dskip, const float* norm_g, const float* __restrict__ sst, bf16* ys, int G, int bid, int tid) {
    const int lane = tid & 63, wave = __builtin_amdgcn_readfirstlane(tid >> 6);
    LAS float* DT = (LAS float*)lds; LAS float* AC = DT + 1024;
    LAS unsigned char* BMi = lds + 8192; LAS unsigned char* CMi = BMi + 128 * KS; LAS unsigned char* Xi = CMi + 128 * KS;
    const unsigned xbase = (unsigned)(uintptr_t)Xi;
    for (int unit = bid; unit < 256; unit += G) {
        const int b = unit >> 5, c = (unit >> 1) & 15, g = unit & 1;
        __syncthreads();
        (void)ssd_dt_acum(DT, AC, proj, dt_bias, a_log, b, c, g, wave, lane);
        ssd_stage_bc(BMi, proj, cw, cb, b, c, 1024 + 128 * g, tid);
        ssd_stage_bc(CMi, proj, cw, cb, b, c, 1280 + 128 * g, tid);
        ssd_stage_x<false>(Xi, proj, cw, cb, b, c, 512 * g, nullptr, 0, tid);
        __syncthreads();
        int ln0 = lane; asm volatile("" : "+v"(ln0));
        const int l = 16 * wave + (ln0 & 15);
        bf16x8 cf[4];
#pragma unroll
        for (int ks = 0; ks < 4; ++ks) cf[ks] = *(const LAS bf16x8*)(CMi + l * KS + 64 * ks + 16 * (ln0 >> 4));
        f32x4 cbT[8];
#pragma unroll
        for (int sb = 0; sb < 8; ++sb) { cbT[sb] = (f32x4){0.f, 0.f, 0.f, 0.f};
            if (sb <= wave) {
#pragma unroll
                for (int ks = 0; ks < 4; ++ks) { const bf16x8 bfr = *(const LAS bf16x8*)(BMi + (16 * sb + (ln0 & 15)) * KS + 64 * ks + 16 * (ln0 >> 4));
                    cbT[sb] = __builtin_amdgcn_mfma_f32_16x16x32_bf16(bfr, cf[ks], cbT[sb], 0, 0, 0); } } }
        float ssq = 0.f;
        const size_t tokrow = (size_t)(b * T + c * 128 + l);
        const int ep_p = tid >> 3, ep_n0 = (tid & 7) * 16;
        f32x4 er[4];
#define SSD_E_LOAD(hh_) do { const float* q_ = sst + ((size_t)((b * 16 + c) * 16 + 8 * g + (hh_)) * 64 + ep_p) * 128 + ep_n0; \
            _Pragma("unroll") for (int j_ = 0; j_ < 4; ++j_) er[j_] = *(const f32x4*)(q_ + 4 * j_); } while (0)
#define SSD_E_WRITE(buf_) do { u32x4 w0_, w1_; w0_.x = pk2(er[0][0], er[0][1]); w0_.y = pk2(er[0][2], er[0][3]); w0_.z = pk2(er[1][0], er[1][1]); w0_.w = pk2(er[1][2], er[1][3]); \
            w1_.x = pk2(er[2][0], er[2][1]); w1_.y = pk2(er[2][2], er[2][3]); w1_.z = pk2(er[3][0], er[3][1]); w1_.w = pk2(er[3][2], er[3][3]); \
            LAS unsigned char* d_ = BMi + (buf_) * 17408 + ep_p * KS + ep_n0 * 2; *(LAS u32x4*)d_ = w0_; *(LAS u32x4*)(d_ + 16) = w1_; } while (0)
        SSD_E_LOAD(0);
        __syncthreads();
        SSD_E_WRITE(0);
        __syncthreads();
#pragma unroll 1
        for (int hh = 0; hh < 8; ++hh) {
            const int pass = hh >> 2, hl = hh & 3;
            if (hh == 4) { ssd_stage_x<false>(Xi, proj, cw, cb, b, c, 512 * g + 256, nullptr, 0, tid); __syncthreads(); }
            {
                int ln = lane; asm volatile("" : "+v"(ln));
                const int lr = ln & 15, lg = ln >> 4, lq = (ln & 15) >> 2, lp = ln & 3;
                const int h = 8 * g + hh;
                const float acl = AC[hh * 128 + l];
                f32x4 acc[4];
#pragma unroll
                for (int mt = 0; mt < 4; ++mt) acc[mt] = (f32x4){0.f, 0.f, 0.f, 0.f};
                u32x2 zv[4];
#pragma unroll
                for (int mt = 0; mt < 4; ++mt) zv[mt] = *(const u32x2*)(proj + tokrow * LD + COL_Z + 512 * g + 256 * pass + 64 * hl + 16 * mt + 4 * lg);
                if (hh + 1 < 8) SSD_E_LOAD(hh + 1);
                const LAS unsigned char* eb = BMi + (hh & 1) * 17408 + lr * KS + 16 * lg;
#pragma unroll
                for (int mt = 0; mt < 4; ++mt)
#pragma unroll
                    for (int ks = 0; ks < 4; ++ks) { const bf16x8 ef = *(const LAS bf16x8*)(eb + 16 * mt * KS + 64 * ks);
                        acc[mt] = __builtin_amdgcn_mfma_f32_16x16x32_bf16(ef, cf[ks], acc[mt], 0, 0, 0); }
                const float eal = __expf(acl);
#pragma unroll
                for (int mt = 0; mt < 4; ++mt) acc[mt] *= eal;
#pragma unroll
                for (int kk = 0; kk < 4; ++kk) {
                    if (2 * kk <= wave) {
                        float pv[8];
#pragma unroll
                        for (int hb2 = 0; hb2 < 2; ++hb2) { const int sb = 2 * kk + hb2, s0 = 16 * sb + 4 * lg;
                            const f32x4 av = *(const LAS f32x4*)(AC + hh * 128 + s0), dv = *(const LAS f32x4*)(DT + hh * 128 + s0);
#pragma unroll
                            for (int e = 0; e < 4; ++e) { const float w = (s0 + e <= l) ? __expf(acl - av[e]) * dv[e] : 0.f; pv[4 * hb2 + e] = cbT[sb][e] * w; } }
                        const bf16x8 pf = as_bf16x8(pack8(pv));
                        const unsigned va = xbase + (unsigned)((32 * kk + 4 * lg + lq) * XS + (64 * hl + 4 * lp) * 2);
#pragma unroll
                        for (int mt = 0; mt < 4; ++mt) { u32x2 lo, hi; tr_read2(va + 32 * mt, va + 32 * mt + 16 * XS, lo, hi); u32x4 vw; vw.x = lo.x; vw.y = lo.y; vw.z = hi.x; vw.w = hi.y;
                            acc[mt] = __builtin_amdgcn_mfma_f32_16x16x32_bf16(as_bf16x8(vw), pf, acc[mt], 0, 0, 0); }
                    } }
                const float dsk = dskip[h];
#pragma unroll
                for (int mt = 0; mt < 4; ++mt) { const int chl = 64 * hl + 16 * mt + 4 * lg;
                    const u32x2 xv = *(const LAS u32x2*)(Xi + l * XS + chl * 2);
                    float y0 = (acc[mt][0] + dsk * bflo(xv.x)) * siluf_(bflo(zv[mt].x)), y1 = (acc[mt][1] + dsk * bfhi(xv.x)) * siluf_(bfhi(zv[mt].x));
                    float y2 = (acc[mt][2] + dsk * bflo(xv.y)) * siluf_(bflo(zv[mt].y)), y3 = (acc[mt][3] + dsk * bfhi(xv.y)) * siluf_(bfhi(zv[mt].y));
                    ssq += y0 * y0 + y1 * y1 + y2 * y2 + y3 * y3;
                    u32x2 o; o.x = pk2(y0, y1); o.y = pk2(y2, y3);
                    *(u32x2*)(ys + tokrow * YLD + 512 * g + 256 * pass + chl) = o; }
                if (hh + 1 < 8) SSD_E_WRITE((hh + 1) & 1);
            }
            __syncthreads();
        }
#undef SSD_E_LOAD
#undef SSD_E_WRITE
        VM_WAIT();
        ssq += __shfl_xor(ssq, 16); ssq += __shfl_xor(ssq, 32);
        const float rstd = 1.0f / sqrtf(ssq * (1.0f / 512.0f) + RMS_EPS);
        { int ln = lane; asm volatile("" : "+v"(ln));
          const int lg = ln >> 4;
          bf16* yp = ys + tokrow * YLD + 512 * g + 4 * lg;
          u32x2 yv[8][4];
#pragma unroll
          for (int hh = 0; hh < 8; ++hh)
#pragma unroll
              for (int mt = 0; mt < 4; ++mt) yv[hh][mt] = *(const u32x2*)(yp + 64 * hh + 16 * mt);
#pragma unroll
          for (int hh = 0; hh < 8; ++hh)
#pragma unroll
              for (int mt = 0; mt < 4; ++mt) { const f32x4 ng = *(const f32x4*)(norm_g + 512 * g + 64 * hh + 16 * mt + 4 * lg); const u32x2 y = yv[hh][mt];
                  u32x2 o; o.x = pk2(bflo(y.x) * rstd * ng[0], bfhi(y.x) * rstd * ng[1]); o.y = pk2(bflo(y.y) * rstd * ng[2], bfhi(y.y) * rstd * ng[3]);
                  *(u32x2*)(yp + 64 * hh + 16 * mt) = o; } }
    }
}

__device__ __forceinline__ void lru_phase(LAS unsigned char* lds, const bf16* __restrict__ proj, const float* cw, const float* cb, const bf16* __restrict__ wrt, const bf16* __restrict__ wit,
                                          const float* br, const float* bi, const float* lam, bf16* __restrict__ yl, int G, int bid, int tid) {
    const int wave = __builtin_amdgcn_readfirstlane(tid >> 6);
    LAS unsigned char* XC = lds;
    LAS float* Aa = (LAS float*)(lds + 128 * KS);
    LAS float* Uu = Aa + 4096;
    LAS float* CW = Uu + 4096;
    for (int unit = bid; unit < 256; unit += G) {
        const int b = unit >> 5, n = (unit >> 2) & 7, dq = unit & 3;
        const int dch = 128 * n + 32 * dq;
        __syncthreads();
        for (int i = tid; i < 640; i += 512) { const int k = i >> 7, c = i & 127; CW[i] = k < 4 ? cw[k * 1024 + 128 * n + c] : cb[128 * n + c]; }
        int t2 = tid; asm volatile("" : "+v"(t2));
        const int lane = t2 & 63, lr = lane & 15, lg = lane >> 4;
        bf16x8 wrf[2][4], wif[2][4]; float brv[2], biv[2], spl[2];
#pragma unroll
        for (int nt = 0; nt < 2; ++nt) { const size_t wo = (size_t)n * 16384 + (size_t)(32 * dq + 16 * nt + lr) * 128 + 8 * lg;
#pragma unroll
            for (int ks = 0; ks < 4; ++ks) { wrf[nt][ks] = *(const bf16x8*)(wrt + wo + 32 * ks); wif[nt][ks] = *(const bf16x8*)(wit + wo + 32 * ks); }
            const int dl = dch + 16 * nt + lr; brv[nt] = br[dl]; biv[nt] = bi[dl]; spl[nt] = -8.0f * softplusf_(-lam[dl]); }
        const int cch = t2 & 15, l0 = (t2 >> 4) * 4;
        const int tok_o = t2 >> 2, qo = t2 & 3;
        const bf16* xsrc = proj + (size_t)(b * T + l0) * LD + COL_LX + 128 * n + cch * 8;
        const bf16* gsrc = proj + (size_t)(b * T + tok_o) * LD + COL_LG + dch + 8 * qo;
        u32x4 rows[7];
#pragma unroll
        for (int j = 0; j < 7; ++j) { rows[j] = (u32x4){0u, 0u, 0u, 0u}; if (l0 + j - 3 >= 0) rows[j] = *(const u32x4*)(xsrc + (ptrdiff_t)(j - 3) * LD); }
        u32x4 gate_n = *(const u32x4*)gsrc;
        float carry = 0.f;
        __syncthreads();
#pragma unroll 1
        for (int c = 0; c < 16; ++c) {
            { float w[4][8], o[8];
#pragma unroll
              for (int k = 0; k < 4; ++k) { const f32x4 a = *(const LAS f32x4*)(CW + k * 128 + cch * 8), bq = *(const LAS f32x4*)(CW + k * 128 + cch * 8 + 4);
#pragma unroll
                  for (int e = 0; e < 4; ++e) { w[k][e] = a[e]; w[k][4 + e] = bq[e]; } }
              const f32x4 ba = *(const LAS f32x4*)(CW + 512 + cch * 8), bb = *(const LAS f32x4*)(CW + 512 + cch * 8 + 4);
#pragma unroll
              for (int j = 0; j < 4; ++j) {
#pragma unroll
                  for (int e = 0; e < 4; ++e) { o[e] = ba[e]; o[4 + e] = bb[e]; }
#pragma unroll
                  for (int k = 0; k < 4; ++k) { const u32x4 x = rows[j + k];
                      o[0] += w[k][0] * bflo(x.x); o[1] += w[k][1] * bfhi(x.x); o[2] += w[k][2] * bflo(x.y); o[3] += w[k][3] * bfhi(x.y);
                      o[4] += w[k][4] * bflo(x.z); o[5] += w[k][5] * bfhi(x.z); o[6] += w[k][6] * bflo(x.w); o[7] += w[k][7] * bfhi(x.w); }
                  *(LAS u32x4*)(XC + (l0 + j) * KS + cch * 16) = pack8(o); } }
            const u32x4 gate_c = gate_n;
            if (c < 15) {
#pragma unroll
                for (int j = 0; j < 7; ++j) rows[j] = *(const u32x4*)(xsrc + (ptrdiff_t)((c + 1) * 128 + j - 3) * LD);
                gate_n = *(const u32x4*)(gsrc + (size_t)(c + 1) * 128 * LD);
            }
            LDS_BAR();
            { bf16x8 af[4];
#pragma unroll
              for (int ks = 0; ks < 4; ++ks) af[ks] = *(const LAS bf16x8*)(XC + (16 * wave + lr) * KS + 64 * ks + 16 * lg);
#pragma unroll
              for (int nt = 0; nt < 2; ++nt) { f32x4 ar = (f32x4){0.f, 0.f, 0.f, 0.f}, ai = ar;
#pragma unroll
                  for (int ks = 0; ks < 4; ++ks) { ar = __builtin_amdgcn_mfma_f32_16x16x32_bf16(af[ks], wrf[nt][ks], ar, 0, 0, 0); ai = __builtin_amdgcn_mfma_f32_16x16x32_bf16(af[ks], wif[nt][ks], ai, 0, 0, 0); }
                  const int dl = 16 * nt + lr;
#pragma unroll
                  for (int e = 0; e < 4; ++e) { const int tok = 16 * wave + 4 * lg + e;
                      const float rg = sigmoidf_(ar[e] + brv[nt]), ig = sigmoidf_(ai[e] + biv[nt]);
                      const float la = rg * spl[nt]; const float a = __expf(la);
                      const float xc = bf2f(*(const LAS bf16*)(XC + tok * KS + (32 * dq + dl) * 2));
                      Aa[lru_idx(tok, dl)] = a; Uu[lru_idx(tok, dl)] = __builtin_amdgcn_sqrtf(fmaxf(1.0f - a * a, 0.f)) * ig * xc; } } }
            LDS_BAR();
            { const int d = t2 >> 4, seg = t2 & 15;
              float hl[8], ac[8]; float hh = 0.f, aa = 1.f;
#pragma unroll
              for (int k = 0; k < 8; ++k) { const float a = Aa[lru_idx(8 * seg + k, d)], u = Uu[lru_idx(8 * seg + k, d)]; hh = a * hh + u; aa *= a; hl[k] = hh; ac[k] = aa; }
              float pa = aa, ph = hh;
              { float qa, qh;
                qa = row_shr<1>(1.f, pa); qh = row_shr<1>(0.f, ph); ph = pa * qh + ph; pa = pa * qa;
                qa = row_shr<2>(1.f, pa); qh = row_shr<2>(0.f, ph); ph = pa * qh + ph; pa = pa * qa;
                qa = row_shr<4>(1.f, pa); qh = row_shr<4>(0.f, ph); ph = pa * qh + ph; pa = pa * qa;
                qa = row_shr<8>(1.f, pa); qh = row_shr<8>(0.f, ph); ph = pa * qh + ph; pa = pa * qa; }
              const float ea = row_shr<1>(1.f, pa), eh = row_shr<1>(0.f, ph);
              const float cin = ea * carry + eh;
              const float ta = __shfl(pa, 15, 16), th = __shfl(ph, 15, 16); carry = ta * carry + th;
#pragma unroll
              for (int k = 0; k < 8; ++k) Uu[lru_idx(8 * seg + k, d)] = hl[k] + ac[k] * cin; }
            LDS_BAR();
            { const f32x4 h0 = *(const LAS f32x4*)(Uu + lru_idx(tok_o, 8 * qo)), h1v = *(const LAS f32x4*)(Uu + lru_idx(tok_o, 8 * qo + 4));
              float y[8];
              y[0] = h0[0] * gelu_tanh(bflo(gate_c.x)); y[1] = h0[1] * gelu_tanh(bfhi(gate_c.x)); y[2] = h0[2] * gelu_tanh(bflo(gate_c.y)); y[3] = h0[3] * gelu_tanh(bfhi(gate_c.y));
              y[4] = h1v[0] * gelu_tanh(bflo(gate_c.z)); y[5] = h1v[1] * gelu_tanh(bfhi(gate_c.z)); y[6] = h1v[2] * gelu_tanh(bflo(gate_c.w)); y[7] = h1v[3] * gelu_tanh(bfhi(gate_c.w));
              *(u32x4*)(yl + (size_t)(b * T + c * 128 + tok_o) * YLD + dch + 8 * qo) = pack8(y); }
        }
    }
}

__device__ __forceinline__ void router_phase(LAS unsigned char* lds, const float* __restrict__ pre, const float* lg_, const float* lb_, const bf16* __restrict__ rwh, const bf16* __restrict__ rwl, const float* rbias,
                                             float* __restrict__ h1, bf16* __restrict__ h1b, unsigned* gcnt, int* __restrict__ lts, float* __restrict__ lw, int* __restrict__ tmap, int* __restrict__ wgcnt, int G, int bid, int tid, int pflags) {
    const int lane = tid & 63, wave = __builtin_amdgcn_readfirstlane(tid >> 6);
    const bool table = MK_ONE && (M / 16 + G - 1) / G <= 4;
    constexpr int XS2 = 4112;
    LAS unsigned char* XH = lds; LAS unsigned char* XL = lds + 16 * XS2;
    LAS float* PART = (LAS float*)(lds + 32 * XS2);
    LAS int* SELT = (LAS int*)(PART + 2048);
    LAS float* SELW = (LAS float*)(SELT + 512);
    LAS int* LCNT = (LAS int*)(SELW + 512);
    LAS int* LBASE = LCNT + 64;
    LAS int* LPOS = LBASE + 64;
    if (tid < 64) LCNT[tid] = 0;
    const int ntiles = M / 16;
    int nflush = 0;
    for (int tile = bid; ; tile += G) {
        const bool have = tile < ntiles;
        if (have) {
            __syncthreads();
#pragma unroll 1
            for (int rr = 0; rr < 2; ++rr) { const int rl = 2 * wave + rr; const size_t row = (size_t)tile * 16 + rl;
                float v[4][8];
#pragma unroll
                for (int j = 0; j < 4; ++j) { const f32x4 a = __builtin_nontemporal_load((const f32x4*)(pre + row * D + 512 * j + 8 * lane)), bq = __builtin_nontemporal_load((const f32x4*)(pre + row * D + 512 * j + 8 * lane + 4));
#pragma unroll
                    for (int e = 0; e < 4; ++e) { v[j][e] = a[e]; v[j][4 + e] = bq[e]; } }
                float s = 0.f;
#pragma unroll
                for (int j = 0; j < 4; ++j)
#pragma unroll
                    for (int e = 0; e < 8; ++e) s += v[j][e];
                const float mean = wave_sum(s) * (1.f / D); float s2 = 0.f;
#pragma unroll
                for (int j = 0; j < 4; ++j)
#pragma unroll
                    for (int e = 0; e < 8; ++e) { v[j][e] -= mean; s2 += v[j][e] * v[j][e]; }
                const float rstd = 1.f / sqrtf(wave_sum(s2) * (1.f / D) + LN_EPS);
#pragma unroll
                for (int j = 0; j < 4; ++j) { const int c0 = 512 * j + 8 * lane;
                    const f32x4 g0 = *(const f32x4*)(lg_ + c0), g1 = *(const f32x4*)(lg_ + c0 + 4), b0 = *(const f32x4*)(lb_ + c0), b1 = *(const f32x4*)(lb_ + c0 + 4);
                    f32x4 y0, y1;
#pragma unroll
                    for (int e = 0; e < 4; ++e) { y0[e] = v[j][e] * rstd * g0[e] + b0[e]; y1[e] = v[j][4 + e] * rstd * g1[e] + b1[e]; }
                    if (!(pflags & 2)) { *(f32x4*)(h1 + row * D + c0) = y0; *(f32x4*)(h1 + row * D + c0 + 4) = y1; }
                    u32x2 w; w.x = pk4_fp8(y0[0], y0[1], y0[2], y0[3]); w.y = pk4_fp8(y1[0], y1[1], y1[2], y1[3]); *(u32x2*)((unsigned char*)h1b + row * D + c0) = w;
                    float yh[8], yl[8];
#pragma unroll
                    for (int e = 0; e < 4; ++e) { yh[e] = bf2f(pk2(y0[e], 0.f) & 0xffffu); yl[e] = y0[e] - yh[e]; yh[4 + e] = bf2f(pk2(y1[e], 0.f) & 0xffffu); yl[4 + e] = y1[e] - yh[4 + e]; }
                    *(LAS u32x4*)(XH + rl * XS2 + c0 * 2) = pack8(yh); *(LAS u32x4*)(XL + rl * XS2 + c0 * 2) = pack8(yl); }
            }
            __syncthreads();
            { const int nt = wave & 3, kh = wave >> 2, r = lane & 15, g = lane >> 4;
              f32x4 acc = (f32x4){0.f, 0.f, 0.f, 0.f}, acc2 = acc, acc3 = acc;
              const size_t wo = ((size_t)(32 * kh * 4 + nt) * 64 + lane) * 8;
              const LAS unsigned char* xh = XH + r * XS2 + (1024 * kh + 8 * g) * 2; const LAS unsigned char* xl = XL + r * XS2 + (1024 * kh + 8 * g) * 2;
#pragma unroll 4
              for (int ks = 0; ks < ((pflags & 1) ? 4 : 32); ++ks) {
                  const bf16x8 bh = *(const bf16x8*)(rwh + wo + (size_t)ks * 2048), bl = *(const bf16x8*)(rwl + wo + (size_t)ks * 2048);
                  const bf16x8 ah = *(const LAS bf16x8*)(xh + 64 * ks), al = *(const LAS bf16x8*)(xl + 64 * ks);
                  acc = __builtin_amdgcn_mfma_f32_16x16x32_bf16(ah, bh, acc, 0, 0, 0); acc2 = __builtin_amdgcn_mfma_f32_16x16x32_bf16(ah, bl, acc2, 0, 0, 0); acc3 = __builtin_amdgcn_mfma_f32_16x16x32_bf16(al, bh, acc3, 0, 0, 0); }
              acc += acc2 + acc3;
#pragma unroll
              for (int e = 0; e < 4; ++e) PART[(kh * 16 + 4 * g + e) * 64 + 16 * nt + r] = acc[e]; }
            __syncthreads();
#pragma unroll 1
            for (int rr = 0; rr < 2; ++rr) { const int rl = 2 * wave + rr; const int tok = tile * 16 + rl;
                const float logit = PART[rl * 64 + lane] + PART[(16 + rl) * 64 + lane];
                const float score = 1.0f / (1.0f + __expf(-logit)); const float choice = score + rbias[lane];
                const int grp = lane >> 3;
                float m1 = choice; m1 = fmaxf(m1, __shfl_xor(m1, 1)); m1 = fmaxf(m1, __shfl_xor(m1, 2)); m1 = fmaxf(m1, __shfl_xor(m1, 4));
                const unsigned long long bm = __ballot(choice == m1); const unsigned gm = (unsigned)(bm >> (8 * grp)) & 0xffu; const int first = __builtin_ctz(gm) + 8 * grp;
                float m2 = (lane == first) ? -INFINITY : choice; m2 = fmaxf(m2, __shfl_xor(m2, 1)); m2 = fmaxf(m2, __shfl_xor(m2, 2)); m2 = fmaxf(m2, __shfl_xor(m2, 4));
                const float gs = m1 + m2;
                int grank = 0;
#pragma unroll
                for (int j = 0; j < 8; ++j) { const float o = __shfl(gs, 8 * j); grank += (o > gs || (o == gs && j < grp)) ? 1 : 0; }
                const bool keep = grank < 4;
                const float masked = keep ? choice : -INFINITY;
                int rank = 64; float cur = masked;
#pragma unroll 1
                for (int it8 = 0; it8 < 8; ++it8) {
                    float v = cur;
                    v = fmaxf(v, __int_as_float(__builtin_amdgcn_update_dpp(__float_as_int(v), __float_as_int(v), 0xb1, 0xf, 0xf, false)));
                    v = fmaxf(v, __int_as_float(__builtin_amdgcn_update_dpp(__float_as_int(v), __float_as_int(v), 0x4e, 0xf, 0xf, false)));
                    v = fmaxf(v, __int_as_float(__builtin_amdgcn_update_dpp(__float_as_int(v), __float_as_int(v), 0x141, 0xf, 0xf, false)));
                    v = fmaxf(v, __int_as_float(__builtin_amdgcn_update_dpp(__float_as_int(v), __float_as_int(v), 0x140, 0xf, 0xf, false)));
                    const float r0 = __int_as_float(__builtin_amdgcn_readlane(__float_as_int(v), 0)), r1 = __int_as_float(__builtin_amdgcn_readlane(__float_as_int(v), 16));
                    const float r2 = __int_as_float(__builtin_amdgcn_readlane(__float_as_int(v), 32)), r3 = __int_as_float(__builtin_amdgcn_readlane(__float_as_int(v), 48));
                    const float mxw = fmaxf(fmaxf(r0, r1), fmaxf(r2, r3));
                    const unsigned long long eq = __ballot(cur == mxw);
                    const int win = __builtin_ctzll(eq);
                    if (lane == win) { rank = it8; cur = -INFINITY; }
                }
                const bool sel = keep && rank < 8;
                const float wsum = wave_sum(sel ? score : 0.f);
                if (sel) { const int idx = (nflush * 16 + rl) * 8 + rank; SELT[idx] = (tok * 16 + rank) | (lane << 24); SELW[idx] = score / wsum * 2.5f; }
            }
            ++nflush;
        }
        const bool more = (tile + G) < ntiles;
        if (table) {
            if (!more) {
                __syncthreads();
                const int nent = nflush * 128;
                if (tid < nent) { const int e = (SELT[tid] >> 24) & 63; LPOS[tid] = atomicAdd((int*)&LCNT[e], 1); }
                __syncthreads();
                if (tid < 64) wgcnt[bid * 64 + tid] = LCNT[tid];
                if (tid == 64) LBASE[0] = nent;
            }
        } else if (nflush == 4 || (!more && nflush > 0)) {
            __syncthreads();
            const int nent = nflush * 128; int e = 0, lp = 0;
            if (tid < nent) { e = (SELT[tid] >> 24) & 63; lp = atomicAdd((int*)&LCNT[e], 1); LPOS[tid] = lp; }
            __syncthreads();
            if (tid < 64) { const int n = LCNT[tid]; LBASE[tid] = n ? (int)__hip_atomic_fetch_add(gcnt + tid * 16, (unsigned)n, __ATOMIC_RELAXED, __HIP_MEMORY_SCOPE_AGENT) : 0; LCNT[tid] = 0; }
            __syncthreads();
            if (tid < nent) { const int pos = LBASE[e] + lp; const int ts = SELT[tid] & 0xffffff; lts[e * 16384 + pos] = ts; lw[e * 16384 + pos] = SELW[tid]; tmap[(ts >> 4) * 8 + (ts & 15)] = (e << 16) | pos; }
            nflush = 0;
        }
        if (!more) break;
    }
}

__device__ __forceinline__ void router_lists(LAS unsigned char* lds, const int* __restrict__ wgcnt, unsigned* gcnt, int* __restrict__ lts, float* __restrict__ lw, int* __restrict__ tmap, int G, int bid, int tid) {
    if (!MK_ONE || (M / 16 + G - 1) / G > 4) return;
    constexpr int XS2 = 4112;
    LAS float* PART = (LAS float*)(lds + 32 * XS2);
    LAS int* SELT = (LAS int*)(PART + 2048); LAS float* SELW = (LAS float*)(SELT + 512); LAS int* LCNT = (LAS int*)(SELW + 512); LAS int* LBASE = LCNT + 64; LAS int* LPOS = LBASE + 64;
    LAS int* RED = (LAS int*)PART;
    const int nent = LBASE[0];
    __syncthreads();
    { const int e = tid & 63, part = tid >> 6; int sum = 0;
      const int w0 = part * ((G + 7) / 8), w1 = min(min(w0 + (G + 7) / 8, G), bid);
      for (int w = w0; w < w1; ++w) sum += wgcnt[w * 64 + e];
      RED[part * 64 + e] = sum; }
    __syncthreads();
    if (tid < 64) { int b = 0;
#pragma unroll
        for (int p = 0; p < 8; ++p) b += RED[p * 64 + tid];
        LBASE[tid] = b;
        if (bid == G - 1) gcnt[tid * 16] = (unsigned)(b + LCNT[tid]); }
    __syncthreads();
    if (tid < nent) { const int v = SELT[tid]; const int e = (v >> 24) & 63, ts = v & 0xffffff; const int pos = LBASE[e] + LPOS[tid];
        lts[e * 16384 + pos] = ts; lw[e * 16384 + pos] = SELW[tid]; tmap[(ts >> 4) * 8 + (ts & 15)] = (e << 16) | pos; }
}

__device__ __forceinline__ void combine_phase(const bf16* __restrict__ Y, const float* __restrict__ h1, const int* __restrict__ tmap, const float* __restrict__ lw, const unsigned* cnt, const float* g, const float* b, float* of, bf16* ob, unsigned char* oq, int gw, int NGW, int lane) {
    int nb = ((int)cnt[lane * 16] + 255) >> 8, s = nb;
#pragma unroll
    for (int o = 1; o < 64; o <<= 1) { const int t = __shfl_up(s, o); if (lane >= o) s += t; }
    const int pex = s - nb, NBr = __builtin_amdgcn_readlane(s, 63);
    for (int row = gw; row < M; row += NGW) {
        int ln_ = lane; asm volatile("" : "+v"(ln_)); const int lane = ln_;
        const int tm = tmap[row * 8 + (lane & 7)];
        const int yrow = __shfl(pex, tm >> 16) * 256 + (tm & 0xffff);
        const float wsl = lw[(tm >> 16) * 16384 + (tm & 0xffff)];
        float v[4][8];
#pragma unroll
        for (int j = 0; j < 4; ++j) { const int c0 = 512 * j + 8 * lane; const f32x4 a = __builtin_nontemporal_load((const f32x4*)(h1 + (size_t)row * D + c0)), bq = __builtin_nontemporal_load((const f32x4*)(h1 + (size_t)row * D + c0 + 4));
#pragma unroll
            for (int e = 0; e < 4; ++e) { v[j][e] = ALPHA * a[e]; v[j][4 + e] = ALPHA * bq[e]; } }
#pragma unroll
        for (int sl = 0; sl < 9; ++sl) { const int yr = sl < 8 ? __builtin_amdgcn_readlane(yrow, sl) : NBr * 256 + row; const float w = sl < 8 ? __builtin_bit_cast(float, __builtin_amdgcn_readlane(__builtin_bit_cast(int, wsl), sl)) : 1.0f;
#pragma unroll
            for (int j = 0; j < 4; ++j) { const u32x2 y = __builtin_nontemporal_load((const u32x2*)((const unsigned char*)Y + (size_t)yr * D + 512 * j + 8 * lane));
                const f32x2 a0 = __builtin_amdgcn_cvt_pk_f32_fp8((int)y.x, false), a1 = __builtin_amdgcn_cvt_pk_f32_fp8((int)y.x, true), a2 = __builtin_amdgcn_cvt_pk_f32_fp8((int)y.y, false), a3 = __builtin_amdgcn_cvt_pk_f32_fp8((int)y.y, true);
                v[j][0] += w * a0[0]; v[j][1] += w * a0[1]; v[j][2] += w * a1[0]; v[j][3] += w * a1[1]; v[j][4] += w * a2[0]; v[j][5] += w * a2[1]; v[j][6] += w * a3[0]; v[j][7] += w * a3[1]; }
            if (sl % 3 == 2) asm volatile("" ::: "memory"); }
        ln_store(v, g, b, lane, of ? of + (size_t)row * D : nullptr, ob ? ob + (size_t)row * D : nullptr, oq ? oq + (size_t)row * D : nullptr);
    }
}

struct Args { const float* in[34]; float* out; unsigned char* ws; int ph_lo, ph_hi, flags, pad; };
typedef const Args __attribute__((address_space(4)))* ArgP;
#ifndef PH_MASK
#define PH_MASK 0x7ff
#endif
#if MK_ONE
#define GRID_BAR() do { XcdBarrier b2_ = bar; asm volatile("" : "+s"(b2_.bar)); xcd_barrier(b2_); } while (0)
#else
#define GRID_BAR() do { } while (0)
#endif
#define IN(k) (((PH_MASK >> (((k)) % NPH)) & 1) && lo <= (k) && (k) < hi)
#define SEAM(k) do { if (IN(k) && IN((k) + 1)) GRID_BAR(); } while (0)
template <int L> __device__ __forceinline__ void layer_body(LAS unsigned char* lds, const int tid0, const int bid0, const int G, const int NGW, ArgP ap0, const XcdBarrier& bar, const int lo, const int hi) {
    {
        constexpr int l = L; constexpr int P = l * NPH;
#define PHASE_ENV() int tid = tid0 * 64 + (int)__builtin_amdgcn_mbcnt_hi(~0u, __builtin_amdgcn_mbcnt_lo(~0u, 0u)), bid = bid0; asm volatile("" : "+v"(tid)); asm volatile("" : "+s"(bid));     const int lane = tid & 63, wave = __builtin_amdgcn_readfirstlane(tid >> 6), gw = bid * 8 + wave; (void)lane; (void)gw; \
        ArgP ap = ap0; asm volatile("" : "+s"(ap)); InTab in = ap->in; unsigned char* ws = ap->ws; unsigned* ctl = (unsigned*)(ws + WS_CTL); bf16* projb = (bf16*)(ws + WS_PROJ); \
        float* hbuf = (float*)(ws + WS_H); bf16* hb = (bf16*)(ws + WS_HB); float* h1 = (float*)(ws + WS_H1); bf16* h1b = (bf16*)(ws + WS_H1B); unsigned char* wbase = ws + WS_W; \
        (void)in; (void)ctl; (void)projb; (void)hbuf; (void)hb; (void)h1; (void)h1b; (void)wbase
        if (IN(P + 0)) {
            PHASE_ENV();
            p0_convert(lds, in, l, wbase, gw, NGW, wave, lane);
            if (l == 0) {
                for (int row = gw; row < M; row += NGW) { float v[4][8];
#pragma unroll
                    for (int j = 0; j < 4; ++j) { const f32x4 x0 = *(const f32x4*)(in[0] + (size_t)row * D + 512 * j + 8 * lane), x1 = *(const f32x4*)(in[0] + (size_t)row * D + 512 * j + 8 * lane + 4);
#pragma unroll
                        for (int e = 0; e < 4; ++e) { v[j][e] = x0[e]; v[j][4 + e] = x1[e]; } }
                    ln_store(v, in[1], in[2], lane, hbuf + (size_t)row * D, hb + (size_t)row * D, ws + WS_HQ + (size_t)row * D); }
            }
        }
        SEAM(P + 0);
        if (IN(P + 1)) {
            PHASE_ENV();
            { DenseSchedT<true> S; S.init(M, 6144, D, G, bid, wbase + W_IN8); EpiStoreF8 E{ws + WS_G8, 6144};
              pg8::gemm_phase<EpiStoreF8, DenseSchedT<true>, true>(lds, (const char*)(ws + WS_HQ), D, S, E, tid); }
            { int t2 = tid; asm volatile("" : "+v"(t2));
              DenseSchedT<true> S; S.init(M, N8 - 6144, D, G, bid, wbase + W_IN8 + (size_t)6144 * D); EpiStoreBf16 E{projb, LD, 6144};
              pg8::gemm_phase<EpiStoreBf16, DenseSchedT<true>, true>(lds, (const char*)(ws + WS_HQ), D, S, E, t2); }
            { DenseSched S; S.init(M, LD - N8, D, G, bid, wbase + W_IN + (size_t)N8 * D * 2); EpiStoreBf16 E{projb, LD, N8};
              pg8::gemm_phase(lds, (const char*)hb, D, S, E, tid); }
        }
        SEAM(P + 1);
        if (IN(P + 2)) {
            PHASE_ENV();
#ifndef NO_SSD1
            ssd_states_phase(lds, projb, in[12] + (size_t)l * 4 * 1536, in[13] + (size_t)l * 1536, in[14] + l * 16, in[15] + l * 16,
                             (float*)(ws + WS_SST), (float*)(ws + WS_ALAST), G, bid, tid);
#endif
#ifndef NO_ATTN
            attn_phase(lds, projb, (bf16*)(ws + WS_OG), (float*)(ws + WS_LSE), G, bid, tid);
#endif
        }
        SEAM(P + 2);
        if (IN(P + 3)) {
            PHASE_ENV();
            ssd_pass_phase((float*)(ws + WS_SST), (const float*)(ws + WS_ALAST), G, bid, tid);
            attn_merge((const bf16*)(ws + WS_OG), (const float*)(ws + WS_LSE), (bf16*)(ws + WS_YL) + 2048, gw, NGW, lane);
            lru_phase(lds, projb, in[5] + (size_t)l * 4 * 1024, in[6] + (size_t)l * 1024, (const bf16*)(wbase + W_LR), (const bf16*)(wbase + W_LI),
                      in[8] + l * 1024, in[10] + l * 1024, in[11] + l * 1024, (bf16*)(ws + WS_YL), G, bid, tid);
        }
        SEAM(P + 3);
        if (IN(P + 4)) {
            PHASE_ENV();
            ssd_out_phase(lds, projb, in[12] + (size_t)l * 4 * 1536, in[13] + (size_t)l * 1536, in[14] + l * 16, in[15] + l * 16,
                          in[16] + l * 16, in[17] + l * 1024, (const float*)(ws + WS_SST), (bf16*)(ws + WS_YL) + 1024, G, bid, tid);
        }
        SEAM(P + 4);
        if (IN(P + 5)) {
            PHASE_ENV();
            const float* bg = in[4] + (size_t)l * 3 * D;
            { DenseSched S; S.init(M, D, YLD, G, bid, wbase + W_PL); EpiGate3 E{ws + WS_G8, bg, (bf16*)(ws + WS_MB)};
              pg8::gemm_phase(lds, (const char*)(ws + WS_YL), YLD, S, E, tid); }
        }
        SEAM(P + 5);
        if (IN(P + 6)) {
            PHASE_ENV();
            DenseSched S; S.init(M, D, D, G, bid, wbase + W_OUT); EpiResid E{hbuf, (float*)(ws + WS_PRE)};
            pg8::gemm_phase(lds, (const char*)(ws + WS_MB), D, S, E, tid);
        }
        SEAM(P + 6);
        if (IN(P + 7)) {
            PHASE_ENV();
            router_phase(lds, (const float*)(ws + WS_PRE), in[22] + (size_t)l * D, in[23] + (size_t)l * D, (const bf16*)(wbase + W_RH), (const bf16*)(wbase + W_RL), in[25] + l * NE,
                         h1, h1b, ctl + CW_CNT + l * 64 * 16, (int*)(ws + WS_LTS), (float*)(ws + WS_LW), (int*)(ws + WS_TMAP), (int*)(ws + WS_WGCNT), G, bid, tid, ap->flags);
            GRID_BAR();
            router_lists(lds, (const int*)(ws + WS_WGCNT), ctl + CW_CNT + l * 64 * 16, (int*)(ws + WS_LTS), (float*)(ws + WS_LW), (int*)(ws + WS_TMAP), G, bid, tid);
        }
        SEAM(P + 7);
        if (IN(P + 8)) {
            PHASE_ENV();
            MoeSched<true> S; S.init(G, bid, ctl + CW_CNT + l * 64 * 16, (const int*)(ws + WS_LTS), wbase + W_UP, lane);
            EpiMoeUp E{ws + WS_HID};
            pg8::gemm_phase<EpiMoeUp, MoeSched<true>, true>(lds, (const char*)h1b, D, S, E, tid);
        }
        SEAM(P + 8);
        if (IN(P + 9)) {
            PHASE_ENV();
            MoeSched<false> S; S.init(G, bid, ctl + CW_CNT + l * 64 * 16, (const int*)(ws + WS_LTS), wbase + W_DN, lane);
            EpiMoeDown E{(bf16*)(ws + WS_Y)};
            pg8::gemm_phase<EpiMoeDown, MoeSched<false>, true>(lds, (const char*)(ws + WS_HID), EDIM, S, E, tid);
        }
        SEAM(P + 9);
        if (IN(P + 10)) {
            PHASE_ENV();
            const bool lastl = (l == DEPTH - 1);
            combine_phase((const bf16*)(ws + WS_Y), h1, (const int*)(ws + WS_TMAP), (const float*)(ws + WS_LW), ctl + CW_CNT + l * 64 * 16, in[32] + (size_t)l * D, in[33] + (size_t)l * D, lastl ? ap->out : hbuf, lastl ? nullptr : hb, lastl ? nullptr : ws + WS_HQ, gw, NGW, lane);
        }
        if (l + 1 < DEPTH) SEAM(P + 10);
    }
}
#undef IN
#undef SEAM
__global__ void __launch_bounds__(512, 2) fwd_kernel(Args args) {
    extern __shared__ __attribute__((aligned(16))) unsigned char lds_raw[];
    LAS unsigned char* lds = (LAS unsigned char*)lds_raw;
    const int tid0 = threadIdx.x;
    const int G = gridDim.x, bid0 = blockIdx.x, NGW = G * 8;
    ArgP ap0 = (ArgP)__builtin_amdgcn_kernarg_segment_ptr();
    volatile LAS unsigned* MISC = (volatile LAS unsigned*)(lds + MISC_OFF);
    if (tid0 < 16) MISC[tid0] = 0u;
    __syncthreads();
    XcdBarrier bar; bar.bar = (unsigned*)(ap0->ws + WS_CTL) + CW_BAR; bar.x = 0; bar.st = MISC;
#if MK_ONE
    bar = xcd_barrier_post((unsigned*)(ap0->ws + WS_CTL) + CW_BAR, MISC);
#endif
    const int lo = ap0->ph_lo, hi = ap0->ph_hi;
    const int wave0 = __builtin_amdgcn_readfirstlane(tid0 >> 6);
    layer_body<0>(lds, wave0, bid0, G, NGW, ap0, bar, lo, hi);
    layer_body<1>(lds, wave0, bid0, G, NGW, ap0, bar, lo, hi);
}


extern "C" void kernel_launch(void* const* d_in, const int* in_sizes, int n_in, void* d_out, int out_size, void* d_ws, size_t ws_size, hipStream_t stream) {
    static int grid = 0;
    if (grid == 0) {
        if (n_in != 34 || out_size != M * D || ws_size < WS_END) { fprintf(stderr, "kernel_launch: unexpected shapes (n_in %d out %d ws %zu)\n", n_in, out_size, ws_size); grid = -1; return; }
        int dev = 0, cus = 0, per_cu = 0;
        if (hipGetDevice(&dev) != hipSuccess || hipDeviceGetAttribute(&cus, hipDeviceAttributeMultiprocessorCount, dev) != hipSuccess) { grid = -1; return; }
        if (hipFuncSetAttribute((const void*)fwd_kernel, hipFuncAttributeMaxDynamicSharedMemorySize, LDS_BYTES) != hipSuccess) { fprintf(stderr, "kernel_launch: hipFuncSetAttribute failed\n"); grid = -1; return; }
        if (hipOccupancyMaxActiveBlocksPerMultiprocessor(&per_cu, (const void*)fwd_kernel, 512, LDS_BYTES) != hipSuccess || per_cu < 1)
            fprintf(stderr, "kernel_launch: occupancy query reports %d\n", per_cu);
        (void)hipGetLastError();
        grid = cus;
    }
    if (grid < 0) return;
    (void)hipMemsetAsync((char*)d_ws + WS_CTL, 0, CTL_BYTES, stream);
    Args a{};
    for (int i = 0; i < 34; ++i) a.in[i] = (const float*)d_in[i];
    a.out = (float*)d_out; a.ws = (unsigned char*)d_ws;
#if MK_ONE
    a.ph_lo = 0; a.ph_hi = DEPTH * NPH;
    hipLaunchKernelGGL(fwd_kernel, dim3(grid), dim3(512), LDS_BYTES, stream, a);
#ifdef PROBE_PHASE
    a.ph_lo = NPH + PROBE_PHASE; a.ph_hi = NPH + PROBE_PHASE + 1;
#ifdef PROBE_FLAGS
    a.flags = PROBE_FLAGS;
#endif
    hipLaunchKernelGGL(fwd_kernel, dim3(grid), dim3(512), LDS_BYTES, stream, a);
#endif
#else
    for (int p = 0; p < DEPTH * NPH; ++p) { a.ph_lo = p; a.ph_hi = p + 1; hipLaunchKernelGGL(fwd_kernel, dim3(grid), dim3(512), LDS_BYTES, stream, a); }
#endif
}
```

```cpp
#include <hip/hip_runtime.h>
#include <cstdio>
#include <cstdint>

#ifndef MK_ONE
#define MK_ONE 1
#endif

#define LAS __attribute__((address_space(3)))
typedef unsigned short bf16;
typedef short bf16x8 __attribute__((ext_vector_type(8)));
typedef float f32x4 __attribute__((ext_vector_type(4)));
typedef float f32x2 __attribute__((ext_vector_type(2)));
typedef unsigned u32x4 __attribute__((ext_vector_type(4)));
typedef unsigned u32x2 __attribute__((ext_vector_type(2)));
typedef int i32x8 __attribute__((ext_vector_type(8)));

constexpr int D = 2048, NBATCH = 8, T = 2048, M = NBATCH * T, DEPTH = 2;
constexpr int D_IN = 15888;
constexpr int LD = 16128;
constexpr int COL_G = 0, COL_LG = 6144, COL_Z = 7168, COL_Q = 8192, COL_K = 11264, COL_V = 12288, COL_LX = 13312, COL_XBC = 14336, COL_DT = 15872;
constexpr int N8 = 14336;
constexpr int NE = 64, EDIM = 512, TOPK = 8;
constexpr float LN_EPS = 1e-5f, RMS_EPS = 1e-6f, ALPHA = 1.41421356237f;
constexpr int YLD = 3072;
constexpr int NPH = 11;

constexpr size_t MiB = 1u << 20;
constexpr size_t WS_CTL = 0, CTL_BYTES = 1 * MiB;
constexpr size_t WS_LTS = 2 * MiB, WS_LW = 6 * MiB;
constexpr size_t WS_ALAST = 10 * MiB;
constexpr size_t WS_LSE = 11 * MiB;
constexpr size_t WS_W = 16 * MiB;
constexpr size_t W_IN = 0, W_PL = 63 * MiB, W_PS = 67 * MiB, W_PA = 71 * MiB, W_OUT = 75 * MiB, W_LR = 83 * MiB, W_LI = W_LR + 262144, W_RH = W_LR + 524288, W_RL = W_RH + 262144, W_UP = 84 * MiB, W_IN8 = 216 * MiB, W_DN = 344 * MiB;
constexpr size_t WS_H = 490 * MiB, WS_HB = 618 * MiB, WS_H1 = 682 * MiB, WS_H1B = 810 * MiB;
constexpr size_t WS_PROJ = 874 * MiB;
constexpr size_t WS_PRE = WS_PROJ, WS_Y = WS_H1B;
constexpr size_t WS_TMAP = 13 * MiB;
constexpr size_t WS_WGCNT = 14 * MiB;
constexpr size_t WS_YL = 1450 * MiB, WS_YS = 1482 * MiB, WS_YA = 1514 * MiB, WS_OG = 1546 * MiB;
constexpr size_t WS_HID = WS_YL;
constexpr size_t WS_SST = 1644 * MiB;
constexpr size_t WS_G8 = 1708 * MiB;
constexpr size_t WS_MF = 1708 * MiB, WS_MB = 1836 * MiB, WS_HQ = 1900 * MiB, WS_END = 1932 * MiB;
constexpr int CW_BAR = 4096;
constexpr int CW_CNT = 16384;

constexpr int LDS_BYTES = 147456;
constexpr int MISC_OFF = 147456 - 64;

#define LDS_WAIT() asm volatile("s_waitcnt lgkmcnt(0)" ::: "memory")
#define VM_WAIT() asm volatile("s_waitcnt vmcnt(0)" ::: "memory")
__device__ __forceinline__ float bf2f(unsigned v) { return __uint_as_float(v << 16); }
__device__ __forceinline__ float bflo(unsigned w) { return __uint_as_float(w << 16); }
__device__ __forceinline__ float bfhi(unsigned w) { return __uint_as_float(w & 0xffff0000u); }
__device__ __forceinline__ unsigned pk2(float lo, float hi) { unsigned r; asm volatile("v_cvt_pk_bf16_f32 %0, %1, %2" : "=v"(r) : "v"(lo), "v"(hi)); return r; }
__device__ __forceinline__ unsigned pk4_fp8(float a, float b, float c, float d) { int r = __builtin_amdgcn_cvt_pk_fp8_f32(a, b, 0, false); r = __builtin_amdgcn_cvt_pk_fp8_f32(c, d, r, true); return (unsigned)r; }
__device__ __forceinline__ u32x4 pack8(const float (&v)[8]) { u32x4 o; o.x = pk2(v[0], v[1]); o.y = pk2(v[2], v[3]); o.z = pk2(v[4], v[5]); o.w = pk2(v[6], v[7]); return o; }
template <int N> __device__ __forceinline__ float row_shr(float old, float v) {
    return __int_as_float(__builtin_amdgcn_update_dpp(__float_as_int(old), __float_as_int(v), 0x110 + N, 0xf, 0xf, false)); }
__device__ __forceinline__ void st16_wt(void* p, u32x4 v) { asm volatile("global_store_dwordx4 %0, %1, off sc0 sc1\n\ts_nop 1" :: "v"(p), "v"(v) : "memory"); }
__device__ __forceinline__ void st8_wt(void* p, u32x2 v) { asm volatile("global_store_dwordx2 %0, %1, off sc0 sc1" :: "v"(p), "v"(v) : "memory"); }
__device__ __forceinline__ float sigmoidf_(float x) { return __builtin_amdgcn_rcpf(1.0f + __expf(-x)); }
__device__ __forceinline__ float siluf_(float x) { return x * sigmoidf_(x); }
__device__ __forceinline__ float softplusf_(float x) { return x > 20.f ? x : log1pf(__expf(x)); }
__device__ __forceinline__ float gelu_tanh(float x) { const float u = 0.7978845608f * (x + 0.044715f * x * x * x); const float t = 1.0f - 2.0f * __builtin_amdgcn_rcpf(1.0f + __expf(2.0f * u)); return 0.5f * x * (1.0f + t); }
__device__ __forceinline__ float wave_sum(float v) {
#pragma unroll
    for (int o = 1; o < 64; o <<= 1) v += __shfl_xor(v, o);
    return v;
}
__device__ __forceinline__ bf16x8 as_bf16x8(u32x4 v) { return __builtin_bit_cast(bf16x8, v); }
__device__ __forceinline__ void tr_read2(unsigned a0, unsigned a1, u32x2& r0, u32x2& r1) {
    asm volatile("ds_read_b64_tr_b16 %0, %2\n\tds_read_b64_tr_b16 %1, %3\n\ts_waitcnt lgkmcnt(0)" : "=&v"(r0), "=&v"(r1) : "v"(a0), "v"(a1) : "memory");
}

__device__ __forceinline__ void tr_issue16(unsigned a0, unsigned a1, u32x2 (&lo)[8], u32x2 (&hi)[8]) {
    asm volatile("ds_read_b64_tr_b16 %0, %16\n\tds_read_b64_tr_b16 %8, %17\n\t"
                 "ds_read_b64_tr_b16 %1, %16 offset:32\n\tds_read_b64_tr_b16 %9, %17 offset:32\n\t"
                 "ds_read_b64_tr_b16 %2, %16 offset:64\n\tds_read_b64_tr_b16 %10, %17 offset:64\n\t"
                 "ds_read_b64_tr_b16 %3, %16 offset:96\n\tds_read_b64_tr_b16 %11, %17 offset:96\n\t"
                 "ds_read_b64_tr_b16 %4, %16 offset:128\n\tds_read_b64_tr_b16 %12, %17 offset:128\n\t"
                 "ds_read_b64_tr_b16 %5, %16 offset:160\n\tds_read_b64_tr_b16 %13, %17 offset:160\n\t"
                 "ds_read_b64_tr_b16 %6, %16 offset:192\n\tds_read_b64_tr_b16 %14, %17 offset:192\n\t"
                 "ds_read_b64_tr_b16 %7, %16 offset:224\n\tds_read_b64_tr_b16 %15, %17 offset:224"
                 : "=&v"(lo[0]), "=&v"(lo[1]), "=&v"(lo[2]), "=&v"(lo[3]), "=&v"(lo[4]), "=&v"(lo[5]), "=&v"(lo[6]), "=&v"(lo[7]),
                   "=&v"(hi[0]), "=&v"(hi[1]), "=&v"(hi[2]), "=&v"(hi[3]), "=&v"(hi[4]), "=&v"(hi[5]), "=&v"(hi[6]), "=&v"(hi[7])
                 : "v"(a0), "v"(a1) : "memory");
}
__device__ __forceinline__ void tr_wait16(u32x2 (&lo)[8], u32x2 (&hi)[8]) {
    asm volatile("s_waitcnt lgkmcnt(0)" : "+v"(lo[0]), "+v"(lo[1]), "+v"(lo[2]), "+v"(lo[3]), "+v"(lo[4]), "+v"(lo[5]), "+v"(lo[6]), "+v"(lo[7]),
                   "+v"(hi[0]), "+v"(hi[1]), "+v"(hi[2]), "+v"(hi[3]), "+v"(hi[4]), "+v"(hi[5]), "+v"(hi[6]), "+v"(hi[7]) :: "memory");
}
__device__ __forceinline__ void tr_read16(unsigned a0, unsigned a1, u32x2 (&lo)[8], u32x2 (&hi)[8]) {
    asm volatile("ds_read_b64_tr_b16 %0, %16\n\tds_read_b64_tr_b16 %8, %17\n\t"
                 "ds_read_b64_tr_b16 %1, %16 offset:32\n\tds_read_b64_tr_b16 %9, %17 offset:32\n\t"
                 "ds_read_b64_tr_b16 %2, %16 offset:64\n\tds_read_b64_tr_b16 %10, %17 offset:64\n\t"
                 "ds_read_b64_tr_b16 %3, %16 offset:96\n\tds_read_b64_tr_b16 %11, %17 offset:96\n\t"
                 "ds_read_b64_tr_b16 %4, %16 offset:128\n\tds_read_b64_tr_b16 %12, %17 offset:128\n\t"
                 "ds_read_b64_tr_b16 %5, %16 offset:160\n\tds_read_b64_tr_b16 %13, %17 offset:160\n\t"
                 "ds_read_b64_tr_b16 %6, %16 offset:192\n\tds_read_b64_tr_b16 %14, %17 offset:192\n\t"
                 "ds_read_b64_tr_b16 %7, %16 offset:224\n\tds_read_b64_tr_b16 %15, %17 offset:224\n\t"
                 "s_waitcnt lgkmcnt(0)"
                 : "=&v"(lo[0]), "=&v"(lo[1]), "=&v"(lo[2]), "=&v"(lo[3]), "=&v"(lo[4]), "=&v"(lo[5]), "=&v"(lo[6]), "=&v"(lo[7]),
                   "=&v"(hi[0]), "=&v"(hi[1]), "=&v"(hi[2]), "=&v"(hi[3]), "=&v"(hi[4]), "=&v"(hi[5]), "=&v"(hi[6]), "=&v"(hi[7])
                 : "v"(a0), "v"(a1) : "memory");
}
namespace pg8 {
struct Pair8 { bf16x8 a, b; };
__device__ __forceinline__ i32x8 cat8(bf16x8 lo, bf16x8 hi) { return __builtin_bit_cast(i32x8, Pair8{lo, hi}); }
constexpr int BM = 256, BK = 64, HALF = 128, HTB = HALF * BK * 2, STAGE_BYTES = 8 * HTB;
__device__ __forceinline__ int lds_byte(int r, int c) { const int st = (r >> 4) * 2 + (c >> 5), rr = r & 15, cc = c & 31, ob = rr * 64 + cc * 2; return st * 1024 + (ob ^ (((ob >> 9) & 1) << 5)); }
__device__ __forceinline__ void stage_rc(int b, int& R, int& C) { const int st = b / 1024, sb = b % 1024, swz = sb ^ (((sb >> 9) & 1) << 5); R = (st >> 1) * 16 + swz / 64; C = (st & 1) * 32 + (swz % 64) / 2; }
__device__ __forceinline__ int perm32(int rho) { const int n = rho >> 4, i = rho & 15; return 8 * (i >> 2) + 4 * n + (i & 3); }

template <class Epi, class Sched, bool FP8 = false>
__device__ __forceinline__ void gemm_phase(LAS unsigned char* lds, const char* Abase, const int K, const Sched& S, const Epi& E, const int tid) {
    const int wid = __builtin_amdgcn_readfirstlane(tid >> 6), lane = tid & 63, wr = wid >> 2, wc = wid & 3, fr = lane & 15, fq = lane >> 4;
    const int rowb = FP8 ? K : 2 * K, nt = rowb / 128;
    unsigned voffB[2];
#pragma unroll
    for (int i = 0; i < 2; ++i) { int R, C; stage_rc(tid * 16 + i * 8192, R, C); const int Rb = Epi::PERM == 2 ? (64 * (R >> 5) + 16 * ((R & 15) >> 2) + 4 * ((R >> 4) & 1) + (R & 3)) : Epi::PERM == 1 ? ((R & ~31) + perm32(R & 31)) : R; voffB[i] = (unsigned)(Rb * rowb + C * 2); }
    const size_t kstep = (size_t)(BK * 2);
    const size_t hstep = (size_t)(Epi::PERM == 2 ? 8 : HALF) * rowb;
    const unsigned ldsw = (unsigned)wid * 1024u;
    const int aoff = lds_byte(wr * 64 + fr, fq * 8), boff = lds_byte(wc * 32 + fr, fq * 8);
#define PG8_SA(b, h) (((b) * 2 + (h)) * HTB)
#define PG8_SB(b, h) ((4 + (b) * 2 + (h)) * HTB)
#define PG8_STAGE(bufoff, gbase, voff) do { _Pragma("unroll") for (int _i = 0; _i < 2; ++_i) \
        __builtin_amdgcn_global_load_lds((const unsigned*)((const char*)(gbase) + (voff)[_i]), (LAS unsigned*)(lds + (bufoff) + ldsw + _i * 8192), 16, 0, 0); } while (0)
#define PG8_LDA(dst, b, h) do { _Pragma("unroll") for (int m = 0; m < 4; ++m) _Pragma("unroll") for (int k = 0; k < 2; ++k) dst[m][k] = *(const LAS bf16x8*)(lds + PG8_SA(b, h) + aoff + m * 2048 + k * 1024); } while (0)
#define PG8_LDB(dst, b, h) do { _Pragma("unroll") for (int n = 0; n < 2; ++n) _Pragma("unroll") for (int k = 0; k < 2; ++k) dst[n][k] = *(const LAS bf16x8*)(lds + PG8_SB(b, h) + boff + n * 2048 + k * 1024); } while (0)
#define PG8_MMA(ai, bj, At, Bt) do { __builtin_amdgcn_s_setprio(1); _Pragma("unroll") for (int m = 0; m < 4; ++m) _Pragma("unroll") for (int n = 0; n < 2; ++n) { \
        if constexpr (FP8) acc[ai][bj][m][n] = __builtin_amdgcn_mfma_scale_f32_16x16x128_f8f6f4(cat8(Bt[n][0], Bt[n][1]), cat8(At[m][0], At[m][1]), acc[ai][bj][m][n], 0, 0, 0, 0, 0, 0); \
        else { _Pragma("unroll") for (int k = 0; k < 2; ++k) acc[ai][bj][m][n] = __builtin_amdgcn_mfma_f32_16x16x32_bf16(Bt[n][k], At[m][k], acc[ai][bj][m][n], 0, 0, 0); } } __builtin_amdgcn_s_setprio(0); } while (0)
#define PG8_WAIT_V(n) asm volatile("s_waitcnt vmcnt(" #n ")" ::: "memory")
#define PG8_WAIT_L(n) asm volatile("s_waitcnt lgkmcnt(" #n ")" ::: "memory")
#define PG8_BAR __builtin_amdgcn_s_barrier()
#define PG8_SCHED __builtin_amdgcn_sched_barrier(0)
    typename Sched::Unit cur, nxt; int ui = 0;
    if (!S.next(0, cur)) return;
    f32x4 acc[2][2][4][2];
#pragma unroll
    for (int a = 0; a < 2; ++a)
#pragma unroll
        for (int b = 0; b < 2; ++b)
#pragma unroll
            for (int m = 0; m < 4; ++m)
#pragma unroll
                for (int n = 0; n < 2; ++n) acc[a][b][m][n] = (f32x4){0.f, 0.f, 0.f, 0.f};
    bf16x8 At[4][2], B0[2][2], B1[2][2];
    unsigned oc[2][2];
    S.aoffs(cur, tid, oc);
    const char* cB = S.bptr(cur);
    PG8_STAGE(PG8_SB(0, 0), cB, voffB); PG8_STAGE(PG8_SA(0, 0), Abase, oc[0]); PG8_STAGE(PG8_SB(0, 1), cB + hstep, voffB); PG8_STAGE(PG8_SA(0, 1), Abase, oc[1]);
    if (wr == 1) PG8_BAR;
    PG8_WAIT_V(4); PG8_BAR;
    PG8_STAGE(PG8_SB(1, 0), cB + kstep, voffB); PG8_STAGE(PG8_SA(1, 0), Abase + kstep, oc[0]); PG8_STAGE(PG8_SB(1, 1), cB + hstep + kstep, voffB);
    PG8_WAIT_V(6); PG8_BAR;
    for (;;) {
        const bool has_next = S.next(ui + 1, nxt);
        const char* nB = has_next ? S.bptr(nxt) : cB;
#pragma unroll 1
        for (int t = 0; t < nt; t += 2) {
            const bool last = (t == nt - 2);
            if constexpr (Epi::MID > 0) { if (t > 0 && (t % Epi::MID) == 0) E.mid(acc, cur, t / Epi::MID, wr, wc, fr, fq); }
            const char* a1 = Abase + (size_t)(t + 1) * kstep;
            const char* a2 = last ? Abase : Abase + (size_t)(t + 2) * kstep; const char* b2 = last ? nB : cB + (size_t)(t + 2) * kstep;
            const char* a3 = a2 + kstep; const char* b3 = b2 + kstep;
            PG8_LDB(B0, 0, 0); PG8_SCHED; PG8_LDA(At, 0, 0); PG8_STAGE(PG8_SA(1, 1), a1, oc[1]);
            PG8_WAIT_L(8); PG8_BAR; PG8_WAIT_L(0); PG8_MMA(0, 0, At, B0); PG8_BAR; PG8_SCHED;
            if (last && has_next) S.aoffs(nxt, tid, oc);
            PG8_LDB(B1, 0, 1); PG8_STAGE(PG8_SB(0, 0), b2, voffB);
            PG8_BAR; PG8_WAIT_L(0); PG8_MMA(0, 1, At, B1); PG8_BAR;
            PG8_LDA(At, 0, 1); PG8_STAGE(PG8_SA(0, 0), a2, oc[0]);
            PG8_BAR; PG8_WAIT_L(0); PG8_MMA(1, 0, At, B0); PG8_BAR; PG8_SCHED;
            PG8_STAGE(PG8_SB(0, 1), b2 + hstep, voffB);
            PG8_WAIT_V(6); PG8_BAR; PG8_MMA(1, 1, At, B1); PG8_BAR;
            PG8_LDB(B0, 1, 0); PG8_SCHED; PG8_LDA(At, 1, 0); PG8_STAGE(PG8_SA(0, 1), a2, oc[1]);
            PG8_WAIT_L(8); PG8_BAR; PG8_WAIT_L(0); PG8_MMA(0, 0, At, B0); PG8_BAR; PG8_SCHED;
            PG8_LDB(B1, 1, 1); PG8_STAGE(PG8_SB(1, 0), b3, voffB);
            PG8_BAR; PG8_WAIT_L(0); PG8_MMA(0, 1, At, B1); PG8_BAR;
            PG8_LDA(At, 1, 1); PG8_STAGE(PG8_SA(1, 0), a3, oc[0]);
            PG8_BAR; PG8_WAIT_L(0); PG8_MMA(1, 0, At, B0); PG8_BAR; PG8_SCHED;
            PG8_STAGE(PG8_SB(1, 1), b3 + hstep, voffB);
            PG8_WAIT_V(6); PG8_BAR; PG8_MMA(1, 1, At, B1); PG8_BAR;
        }
        if (wr == 0) PG8_BAR;
        if constexpr (FP8) {
#pragma unroll
            for (int a = 0; a < 2; ++a)
#pragma unroll
                for (int b = 0; b < 2; ++b)
#pragma unroll
                    for (int m = 0; m < 4; ++m)
#pragma unroll
                        for (int n = 0; n < 2; ++n) acc[a][b][m][n] *= 0.03125f;
        }
        E(acc, cur, wr, wc, fr, fq);
        if (!has_next) break;
#pragma unroll
        for (int a = 0; a < 2; ++a)
#pragma unroll
            for (int b = 0; b < 2; ++b)
#pragma unroll
                for (int m = 0; m < 4; ++m)
#pragma unroll
                    for (int n = 0; n < 2; ++n) acc[a][b][m][n] = (f32x4){0.f, 0.f, 0.f, 0.f};
        cur = nxt; cB = nB; ++ui;
        if (wr == 1) PG8_BAR;
    }
    PG8_WAIT_V(0);
    PG8_BAR;
#undef PG8_SA
#undef PG8_SB
#undef PG8_STAGE
#undef PG8_LDA
#undef PG8_LDB
#undef PG8_MMA
#undef PG8_WAIT_V
#undef PG8_WAIT_L
#undef PG8_BAR
#undef PG8_SCHED
}
}

struct DenseUnit { int pm, pn; };
template <bool F8 = false> struct DenseSchedT {
    typedef DenseUnit Unit;
    int nM, nN, nwg, G, c, K; const char* Bt;
    __device__ __forceinline__ void init(int M_, int N_, int K_, int G_, int c_, const void* Bt_) { nM = M_ / 256; nN = N_ / 256; nwg = nM * nN; G = G_; c = c_; K = K_; Bt = (const char*)Bt_; }
    __device__ __forceinline__ bool next(int i, Unit& u) const {
        const long L = (long)i * G + c; if (L >= nwg) return false;
        int wgid = (int)L; { const int q = nwg / 8, r = nwg % 8, xcd = wgid % 8, off = wgid / 8; wgid = (xcd < r ? xcd * (q + 1) : r * (q + 1) + (xcd - r) * q) + off; }
        const int nig = 8 * nN, gid = wgid / nig, fm = gid * 8, gsz = (nM - fm) < 8 ? (nM - fm) : 8;
        u.pm = fm + ((wgid % nig) % gsz); u.pn = (wgid % nig) / gsz; return true;
    }
    __device__ __forceinline__ const char* bptr(const Unit& u) const { return Bt + (size_t)u.pn * 256 * K * (F8 ? 1 : 2); }
    __device__ __forceinline__ void aoffs(const Unit& u, int tid, unsigned (&o)[2][2]) const {
#pragma unroll
        for (int i = 0; i < 2; ++i) { int R, C; pg8::stage_rc(tid * 16 + i * 8192, R, C);
#pragma unroll
            for (int h = 0; h < 2; ++h) o[h][i] = F8 ? (unsigned)((u.pm * 256 + 128 * h + R) * K + C * 2) : (unsigned)((u.pm * 256 + 128 * h + R) * K + C) * 2u; }
    }
};
typedef DenseSchedT<false> DenseSched;
struct MoeUnit { int e, rb, pn, nvalid, blk; };
template <bool UP> struct MoeSched {
    typedef MoeUnit Unit;
    int x, w, W, nunits, NBr; int pe[9]; int pend, cntl;
    const int* lts; const char* Wt;
    static constexpr int NPN = UP ? 4 : 8, BPG = 32 / NPN;
    __device__ __forceinline__ void init(int G_, int bid, const unsigned* cnt, const int* lts_, const void* W_, int lane) {
        x = bid & 7; w = bid >> 3; W = (G_ - x + 7) >> 3; lts = lts_; Wt = (const char*)W_;
        cntl = (int)cnt[lane * 16]; const int nb = (cntl + 255) >> 8; int s = nb;
#pragma unroll
        for (int o = 1; o < 64; o <<= 1) { const int t = __shfl_up(s, o); if (lane >= o) s += t; }
        pend = s; NBr = __builtin_amdgcn_readlane(s, 63);
        pe[0] = 0;
#pragma unroll
        for (int k = 0; k < 8; ++k) pe[k + 1] = pe[k] + __builtin_amdgcn_readlane(nb, x + 8 * k);
        nunits = (pe[8] + 8) * NPN;
    }
    __device__ __forceinline__ bool next(int i, Unit& u) const {
        const int j = i * W + w; if (j >= nunits) return false;
        const int Bx = pe[8] + 8, FG = Bx / BPG; int bi;
        if (j < FG * 32) { bi = (j >> 5) * BPG + (j & 31) / NPN; u.pn = j % NPN; }
        else { const int j2 = j - FG * 32; bi = FG * BPG + j2 / NPN; u.pn = j2 % NPN; }
        if (bi < pe[8]) {
            int k = 0, st = 0;
#pragma unroll
            for (int q = 1; q < 8; ++q) if (bi >= pe[q]) { k = q; st = pe[q]; }
            const int e = x + 8 * k;
            const int base = e ? __builtin_amdgcn_readlane(pend, e - 1) : 0;
            const int ce = __builtin_amdgcn_readlane(cntl, e);
            u.e = e; u.rb = bi - st; u.blk = base + u.rb; const int rem = ce - u.rb * 256; u.nvalid = rem < 256 ? rem : 256;
        } else { u.e = 64; u.rb = x + 8 * (bi - pe[8]); u.blk = NBr + u.rb; u.nvalid = 256; }
        return true;
    }
    __device__ __forceinline__ const char* bptr(const Unit& u) const {
        return UP ? Wt + ((size_t)u.e * 1024 + (size_t)u.pn * 256) * 2048 : Wt + ((size_t)u.e * 2048 + (size_t)u.pn * 256) * 512;
    }
    __device__ __forceinline__ void aoffs(const Unit& u, int tid, unsigned (&o)[2][2]) const {
#pragma unroll
        for (int i = 0; i < 2; ++i) { int R, C; pg8::stage_rc(tid * 16 + i * 8192, R, C);
#pragma unroll
            for (int h = 0; h < 2; ++h) {
                const int r = 128 * h + R;
                if (UP) {
                    int tok;
                    if (u.e < 64) { tok = 0; if (r < u.nvalid) tok = lts[u.e * 16384 + u.rb * 256 + r] >> 4; }
                    else tok = u.rb * 256 + r;
                    o[h][i] = (unsigned)(tok * 2048 + C * 2);
                } else o[h][i] = (unsigned)((u.blk * 256 + r) * 512 + C * 2);
            } }
    }
};

struct EpiStoreBf16 {
    static constexpr int PERM = 1, MID = 0;
    bf16* O; int ldc; int coff;
    __device__ __forceinline__ void operator()(const f32x4 (&acc)[2][2][4][2], const DenseUnit& u, int wr, int wc, int fr, int fq) const {
        const int row0 = u.pm * 256 + wr * 64 + fr, col0 = coff + u.pn * 256 + wc * 32 + 8 * fq;
#pragma unroll
        for (int ai = 0; ai < 2; ++ai)
#pragma unroll
            for (int m = 0; m < 4; ++m) { bf16* rowp = O + (size_t)(row0 + ai * 128 + m * 16) * ldc + col0;
#pragma unroll
                for (int bj = 0; bj < 2; ++bj) { const f32x4 v0 = acc[ai][bj][m][0], v1 = acc[ai][bj][m][1];
                    u32x4 w; w.x = pk2(v0[0], v0[1]); w.y = pk2(v0[2], v0[3]); w.z = pk2(v1[0], v1[1]); w.w = pk2(v1[2], v1[3]);
                    st16_wt(rowp + bj * 128, w); } }
    }
};
struct EpiStoreF8 {
    static constexpr int PERM = 2, MID = 0;
    unsigned char* O; int ldc;
    __device__ __forceinline__ void operator()(const f32x4 (&acc)[2][2][4][2], const DenseUnit& u, int wr, int wc, int fr, int fq) const {
        const int row0 = u.pm * 256 + wr * 64 + fr, col0 = u.pn * 256 + wc * 64 + 16 * fq;
#pragma unroll
        for (int ai = 0; ai < 2; ++ai)
#pragma unroll
            for (int m = 0; m < 4; ++m) { const f32x4 v0 = acc[ai][0][m][0], v1 = acc[ai][0][m][1], v2 = acc[ai][1][m][0], v3 = acc[ai][1][m][1];
                u32x4 o; o.x = pk4_fp8(v0[0], v0[1], v0[2], v0[3]); o.y = pk4_fp8(v1[0], v1[1], v1[2], v1[3]); o.z = pk4_fp8(v2[0], v2[1], v2[2], v2[3]); o.w = pk4_fp8(v3[0], v3[1], v3[2], v3[3]);
                st16_wt(O + (size_t)(row0 + ai * 128 + m * 16) * ldc + col0, o); }
    }
};
template <int MODE> struct EpiGate {
    static constexpr int PERM = 1, MID = 0;
    const bf16* proj; const float* bg; bf16* mb; int gcol;
    __device__ __forceinline__ void operator()(const f32x4 (&acc)[2][2][4][2], const DenseUnit& u, int wr, int wc, int fr, int fq) const {
        const int row0 = u.pm * 256 + wr * 64 + fr, col0 = u.pn * 256 + wc * 32 + 8 * fq;
        f32x4 bv[2][2];
#pragma unroll
        for (int bj = 0; bj < 2; ++bj) { bv[bj][0] = *(const f32x4*)(bg + gcol + col0 + bj * 128); bv[bj][1] = *(const f32x4*)(bg + gcol + col0 + bj * 128 + 4); }
#pragma unroll
        for (int ai = 0; ai < 2; ++ai)
#pragma unroll
            for (int mh = 0; mh < 2; ++mh) {
                u32x4 gr[2][2], pm[2][2];
#pragma unroll
                for (int mm = 0; mm < 2; ++mm) { const size_t row = (size_t)(row0 + ai * 128 + (2 * mh + mm) * 16);
#pragma unroll
                    for (int bj = 0; bj < 2; ++bj) { gr[mm][bj] = *(const u32x4*)(proj + row * LD + COL_G + gcol + col0 + bj * 128);
                        if (MODE >= 1) pm[mm][bj] = *(const u32x4*)(mb + row * D + col0 + bj * 128); } }
#pragma unroll
                for (int mm = 0; mm < 2; ++mm) { const int m = 2 * mh + mm; const size_t row = (size_t)(row0 + ai * 128 + m * 16);
#pragma unroll
                    for (int bj = 0; bj < 2; ++bj) { const u32x4 g = gr[mm][bj];
                        f32x4 g0, g1;
                        g0[0] = sigmoidf_(bflo(g.x) + bv[bj][0][0]); g0[1] = sigmoidf_(bfhi(g.x) + bv[bj][0][1]); g0[2] = sigmoidf_(bflo(g.y) + bv[bj][0][2]); g0[3] = sigmoidf_(bfhi(g.y) + bv[bj][0][3]);
                        g1[0] = sigmoidf_(bflo(g.z) + bv[bj][1][0]); g1[1] = sigmoidf_(bfhi(g.z) + bv[bj][1][1]); g1[2] = sigmoidf_(bflo(g.w) + bv[bj][1][2]); g1[3] = sigmoidf_(bfhi(g.w) + bv[bj][1][3]);
                        f32x4 v0 = acc[ai][bj][m][0] * g0, v1 = acc[ai][bj][m][1] * g1;
                        if (MODE >= 1) { const u32x4 p = pm[mm][bj]; v0[0] += bflo(p.x); v0[1] += bfhi(p.x); v0[2] += bflo(p.y); v0[3] += bfhi(p.y); v1[0] += bflo(p.z); v1[1] += bfhi(p.z); v1[2] += bflo(p.w); v1[3] += bfhi(p.w); }
                        u32x4 w; w.x = pk2(v0[0], v0[1]); w.y = pk2(v0[2], v0[3]); w.z = pk2(v1[0], v1[1]); w.w = pk2(v1[2], v1[3]); *(u32x4*)(mb + row * D + col0 + bj * 128) = w;
                    } }
                asm volatile("" ::: "memory"); }
    }
};
struct EpiGate3 {
    static constexpr int PERM = 2, MID = 16;
    const unsigned char* g8; const float* bg; bf16* mb;
    static __device__ __forceinline__ float rat(float a, float b) { return (1.0f + __builtin_amdgcn_exp2f(b * -1.44269504f)) * __builtin_amdgcn_rcpf(1.0f + __builtin_amdgcn_exp2f(a * -1.44269504f)); }
    __device__ __forceinline__ void mid(f32x4 (&acc)[2][2][4][2], const DenseUnit& u, int s, int wr, int wc, int fr, int fq) const {
        const int row0 = u.pm * 256 + wr * 64 + fr, col0 = u.pn * 256 + wc * 64 + 16 * fq;
        const unsigned char* pa = g8 + (s - 1) * 2048 + col0; const float* ba = bg + (s - 1) * 2048 + col0;
#pragma unroll
        for (int ai = 0; ai < 2; ++ai) {
            u32x4 ga[4], gb[4];
#pragma unroll
            for (int m = 0; m < 4; ++m) { const size_t row = (size_t)(row0 + ai * 128 + m * 16); ga[m] = *(const u32x4*)(pa + row * 6144); gb[m] = *(const u32x4*)(pa + row * 6144 + 2048); }
#pragma unroll
            for (int q = 0; q < 4; ++q) {
                const f32x4 a = *(const f32x4*)(ba + 4 * q), b = *(const f32x4*)(ba + 2048 + 4 * q);
#pragma unroll
                for (int m = 0; m < 4; ++m) { const int pw = (int)ga[m][q], qw = (int)gb[m][q];
                    const f32x2 p0 = __builtin_amdgcn_cvt_pk_f32_fp8(pw, false), p1 = __builtin_amdgcn_cvt_pk_f32_fp8(pw, true), q0 = __builtin_amdgcn_cvt_pk_f32_fp8(qw, false), q1 = __builtin_amdgcn_cvt_pk_f32_fp8(qw, true);
                    f32x4 r; r[0] = rat(p0[0] + a[0], q0[0] + b[0]); r[1] = rat(p0[1] + a[1], q0[1] + b[1]); r[2] = rat(p1[0] + a[2], q1[0] + b[2]); r[3] = rat(p1[1] + a[3], q1[1] + b[3]);
                    acc[ai][q >> 1][m][q & 1] *= r; } }
            asm volatile("" ::: "memory"); }
    }
    __device__ __forceinline__ void operator()(const f32x4 (&acc)[2][2][4][2], const DenseUnit& u, int wr, int wc, int fr, int fq) const {
        const int row0 = u.pm * 256 + wr * 64 + fr, col0 = u.pn * 256 + wc * 64 + 16 * fq;
        const unsigned char* pa = g8 + 4096 + col0; const float* ba = bg + 4096 + col0;
#pragma unroll
        for (int ai = 0; ai < 2; ++ai) {
            u32x4 ga[4];
#pragma unroll
            for (int m = 0; m < 4; ++m) ga[m] = *(const u32x4*)(pa + (size_t)(row0 + ai * 128 + m * 16) * 6144);
#pragma unroll
            for (int m = 0; m < 4; ++m) { u32x4 w[2];
#pragma unroll
                for (int q = 0; q < 4; ++q) { const f32x4 a = *(const f32x4*)(ba + 4 * q); const int pw = (int)ga[m][q];
                    const f32x2 p0 = __builtin_amdgcn_cvt_pk_f32_fp8(pw, false), p1 = __builtin_amdgcn_cvt_pk_f32_fp8(pw, true); const f32x4 v = acc[ai][q >> 1][m][q & 1];
                    w[q >> 1][2 * (q & 1)] = pk2(v[0] * sigmoidf_(p0[0] + a[0]), v[1] * sigmoidf_(p0[1] + a[1])); w[q >> 1][2 * (q & 1) + 1] = pk2(v[2] * sigmoidf_(p1[0] + a[2]), v[3] * sigmoidf_(p1[1] + a[3])); }
                bf16* op = mb + (size_t)(row0 + ai * 128 + m * 16) * D + col0; *(u32x4*)op = w[0]; *(u32x4*)(op + 8) = w[1]; }
            asm volatile("" ::: "memory"); }
    }
};
struct EpiResid {
    static constexpr int PERM = 0, MID = 0;
    float* pre;
    __device__ __forceinline__ void operator()(const f32x4 (&acc)[2][2][4][2], const DenseUnit& u, int wr, int wc, int fr, int fq) const {
        const int row0 = u.pm * 256 + wr * 64 + fr, col0 = u.pn * 256 + wc * 32 + 4 * fq;
#pragma unroll
        for (int ai = 0; ai < 2; ++ai)
#pragma unroll
            for (int m = 0; m < 4; ++m) { const size_t off = (size_t)(row0 + ai * 128 + m * 16) * D + col0;
#pragma unroll
                for (int bj = 0; bj < 2; ++bj)
#pragma unroll
                    for (int n = 0; n < 2; ++n) st16_wt(pre + off + bj * 128 + n * 16, __builtin_bit_cast(u32x4, acc[ai][bj][m][n])); }
    }
};
struct EpiMoeUp {
    static constexpr int PERM = 1, MID = 0;
    unsigned char* H;
    __device__ __forceinline__ void operator()(const f32x4 (&acc)[2][2][4][2], const MoeUnit& u, int wr, int wc, int fr, int fq) const {
        const int row0 = u.blk * 256 + wr * 64 + fr, col0 = u.pn * 128 + wc * 32 + 8 * fq;
#pragma unroll
        for (int ai = 0; ai < 2; ++ai)
#pragma unroll
            for (int m = 0; m < 4; ++m) {
                const f32x4 g0 = acc[ai][0][m][0], g1 = acc[ai][0][m][1], u0 = acc[ai][1][m][0], u1 = acc[ai][1][m][1];
                u32x2 w; w.x = pk4_fp8(siluf_(g0[0]) * u0[0], siluf_(g0[1]) * u0[1], siluf_(g0[2]) * u0[2], siluf_(g0[3]) * u0[3]);
                w.y = pk4_fp8(siluf_(g1[0]) * u1[0], siluf_(g1[1]) * u1[1], siluf_(g1[2]) * u1[2], siluf_(g1[3]) * u1[3]);
                *(u32x2*)(H + (size_t)(row0 + ai * 128 + m * 16) * 512 + col0) = w; }
    }
};
struct EpiMoeDown {
    static constexpr int PERM = 2, MID = 0;
    bf16* Y;
    __device__ __forceinline__ void operator()(const f32x4 (&acc)[2][2][4][2], const MoeUnit& u, int wr, int wc, int fr, int fq) const {
        const int col0 = u.pn * 256 + wc * 64 + 16 * fq;
#pragma unroll
        for (int ai = 0; ai < 2; ++ai)
#pragma unroll
            for (int m = 0; m < 4; ++m) { const int r = ai * 128 + wr * 64 + m * 16 + fr;
                if (r < u.nvalid) {
                    unsigned char* rowp = (unsigned char*)Y + (size_t)(u.blk * 256 + r) * D + col0;
                    const f32x4 v0 = acc[ai][0][m][0], v1 = acc[ai][0][m][1], v2 = acc[ai][1][m][0], v3 = acc[ai][1][m][1];
                    u32x4 o; o.x = pk4_fp8(v0[0], v0[1], v0[2], v0[3]); o.y = pk4_fp8(v1[0], v1[1], v1[2], v1[3]); o.z = pk4_fp8(v2[0], v2[1], v2[2], v2[3]); o.w = pk4_fp8(v3[0], v3[1], v3[2], v3[3]);
                    *(u32x4*)rowp = o;
                } }
    }
};

#define XB_TMO      128
#define XB_XCNT(j)  (256  + 64 * (j))
#define XB_XSUB(j)  (1280 + 64 * (j))
#define XB_XGEN(j)  (2304 + 64 * (j))
#define XB_TOP      3328
#define XB_TOPGEN   3392
#define XCD_BAR_WORDS 3456
#define XB_SPIN_CAP (1u << 18)
__device__ __forceinline__ unsigned xb_ld(unsigned* p)              { return __hip_atomic_load(p, __ATOMIC_RELAXED, __HIP_MEMORY_SCOPE_AGENT); }
__device__ __forceinline__ unsigned xb_add(unsigned* p, unsigned v) { return __hip_atomic_fetch_add(p, v, __ATOMIC_RELAXED, __HIP_MEMORY_SCOPE_AGENT); }
__device__ __forceinline__ unsigned xb_xcc_id() { return (unsigned)__builtin_amdgcn_s_getreg((3 << 11) | 20) & 0xFu; }
#define XB_SPIN(cond, bar) do { unsigned _sp = 0; while (cond) { __builtin_amdgcn_s_sleep(1); \
    if ((++_sp & 255u) == 0u) { if (xb_ld(&(bar)[XB_TMO])) break; if (_sp > XB_SPIN_CAP) { atomicAdd(&(bar)[XB_TMO], 1u); break; } } } } while (0)
struct XcdBarrier { unsigned* bar; unsigned x; volatile LAS unsigned* st; };
__device__ __forceinline__ XcdBarrier xcd_barrier_post(unsigned* bar, volatile LAS unsigned* st) {
    XcdBarrier b; b.bar = bar; b.x = xb_xcc_id(); b.st = st;
    if (threadIdx.x == 0) (void)xb_add(&bar[XB_XCNT(b.x)], 1u);
    return b;
}
__device__ __forceinline__ void xcd_barrier_complete(unsigned* bar, unsigned x, unsigned& nloc, unsigned& nx) {
    const unsigned G = gridDim.x * gridDim.y * gridDim.z;
    unsigned sum, cnt, mine, sp = 0u;
    for (;;) {
        sum = 0u; cnt = 0u; mine = 0u;
#pragma unroll
        for (unsigned j = 0; j < 16; ++j) { const unsigned c = xb_ld(&bar[XB_XCNT(j)]); sum += c; cnt += (c > 0u) ? 1u : 0u; mine = (j == x) ? c : mine; }
        if (sum == G) break;
        __builtin_amdgcn_s_sleep(1);
        if ((++sp & 255u) == 0u) { if (xb_ld(&bar[XB_TMO])) break; if (sp > XB_SPIN_CAP) { atomicAdd(&bar[XB_TMO], 1u); break; } }
    }
    nloc = mine > 0u ? mine : 1u; nx = cnt > 0u ? cnt : 1u;
}
__device__ __forceinline__ void xcd_barrier(const XcdBarrier& b) {
    asm volatile("s_waitcnt vmcnt(0)" ::: "memory");
    __syncthreads();
    if (threadIdx.x == 0) {
        unsigned* bar = b.bar;
        __builtin_amdgcn_s_waitcnt(0);
        unsigned nloc = b.st[0], nx = b.st[1];
        if (nloc == 0u) { xcd_barrier_complete(bar, b.x, nloc, nx); b.st[0] = nloc; b.st[1] = nx; }
        const unsigned old = xb_add(&bar[XB_XSUB(b.x)], 1u);
        const unsigned gen = old / nloc;
        if (old + 1u == (gen + 1u) * nloc) {
            __builtin_amdgcn_fence(__ATOMIC_RELEASE, "agent");
            asm volatile("s_waitcnt vmcnt(0)" ::: "memory");
            const unsigned og = xb_add(&bar[XB_TOP], 1u);
            const unsigned tg = og / nx;
            if (og + 1u == (tg + 1u) * nx) xb_add(&bar[XB_TOPGEN], 1u);
            else XB_SPIN(xb_ld(&bar[XB_TOPGEN]) == tg, bar);
            __builtin_amdgcn_fence(__ATOMIC_ACQUIRE, "agent");
            xb_add(&bar[XB_XGEN(b.x)], 1u);
            asm volatile("s_waitcnt vmcnt(0)" ::: "memory");
        } else {
            XB_SPIN(xb_ld(&bar[XB_XGEN(b.x)]) == gen, bar);
            __builtin_amdgcn_fence(__ATOMIC_ACQUIRE, "agent");
            asm volatile("s_waitcnt vmcnt(0)" ::: "memory");
        }
    }
    __syncthreads();
}

typedef const float* cfp_t;
typedef const cfp_t __attribute__((address_space(4)))* InTab;
__device__ __forceinline__ void stagger(int bid, unsigned step_10ns) {
    const unsigned cls = (unsigned)(bid >> 3) & 3u;
    if (cls) { const unsigned long long t0 = __builtin_amdgcn_s_memrealtime(); while (__builtin_amdgcn_s_memrealtime() - t0 < (unsigned long long)(cls * step_10ns)) __builtin_amdgcn_s_sleep(8); }
}
template <int F8 = 0> __device__ __forceinline__ void cvt_item(const float* W, int ld, int Kd, bf16* WT, LAS float* scr, int k0, int nsrc, int drow, int nvalid, int lane, size_t lo_off = 0) {
    const int nn = lane & 31;
    { float t[32]; const float* wp = W + (size_t)(k0 + (lane >> 5)) * ld + nsrc + nn;
#pragma unroll
      for (int i = 0; i < 32; ++i) t[i] = (nn < nvalid) ? __builtin_nontemporal_load(wp + (size_t)(2 * i) * ld) : 0.f;
#pragma unroll
      for (int i = 0; i < 32; ++i) scr[(2 * i + (lane >> 5)) * 33 + nn] = t[i]; }
    LDS_WAIT(); asm volatile("" ::: "memory");
    const int c = lane & 7;
#pragma unroll
    for (int j = 0; j < 4; ++j) { const int n = (lane >> 3) + 8 * j; const LAS float* s = scr + (8 * c) * 33 + n;
        if constexpr (F8 == 2) { float hi[8], lo[8];
#pragma unroll
            for (int e = 0; e < 8; ++e) { const float x = s[e * 33]; hi[e] = bf2f(pk2(x, 0.f) & 0xffffu); lo[e] = x - hi[e]; }
            const int kk = k0 + 8 * c, nn2 = drow + n; const size_t off = ((size_t)((kk >> 5) * 4 + (nn2 >> 4)) * 64 + ((kk & 31) >> 3) * 16 + (nn2 & 15)) * 8;
            if (n < nvalid) { *(u32x4*)(WT + off) = pack8(hi); *(u32x4*)(WT + lo_off + off) = pack8(lo); } }
        else if constexpr (F8 == 1) { u32x2 o; o.x = pk4_fp8(s[0 * 33] * 32.f, s[1 * 33] * 32.f, s[2 * 33] * 32.f, s[3 * 33] * 32.f); o.y = pk4_fp8(s[4 * 33] * 32.f, s[5 * 33] * 32.f, s[6 * 33] * 32.f, s[7 * 33] * 32.f);
            if (n < nvalid) *(u32x2*)((unsigned char*)WT + (size_t)(drow + n) * Kd + k0 + 8 * c) = o; }
        else { u32x4 o; o.x = pk2(s[0 * 33], s[1 * 33]); o.y = pk2(s[2 * 33], s[3 * 33]); o.z = pk2(s[4 * 33], s[5 * 33]); o.w = pk2(s[6 * 33], s[7 * 33]);
            if (n < nvalid) *(u32x4*)(WT + (size_t)(drow + n) * Kd + k0 + 8 * c) = o; } }
    LDS_WAIT(); asm volatile("" ::: "memory");
}
__device__ __forceinline__ void ln_store(float (&v)[4][8], const float* g, const float* b, int lane, float* of, bf16* ob, unsigned char* oq = nullptr) {
    float s = 0.f;
#pragma unroll
    for (int j = 0; j < 4; ++j)
#pragma unroll
        for (int e = 0; e < 8; ++e) s += v[j][e];
    const float mean = wave_sum(s) * (1.f / D); float s2 = 0.f;
#pragma unroll
    for (int j = 0; j < 4; ++j)
#pragma unroll
        for (int e = 0; e < 8; ++e) { v[j][e] -= mean; s2 += v[j][e] * v[j][e]; }
    const float rstd = 1.f / sqrtf(wave_sum(s2) * (1.f / D) + LN_EPS);
#pragma unroll
    for (int j = 0; j < 4; ++j) { const int c0 = 512 * j + 8 * lane;
        const f32x4 g0 = *(const f32x4*)(g + c0), g1 = *(const f32x4*)(g + c0 + 4), b0 = *(const f32x4*)(b + c0), b1 = *(const f32x4*)(b + c0 + 4);
        f32x4 y0, y1;
#pragma unroll
        for (int e = 0; e < 4; ++e) { y0[e] = v[j][e] * rstd * g0[e] + b0[e]; y1[e] = v[j][4 + e] * rstd * g1[e] + b1[e]; }
        if (of) { *(f32x4*)(of + c0) = y0; *(f32x4*)(of + c0 + 4) = y1; }
        if (ob) { u32x4 w; w.x = pk2(y0[0], y0[1]); w.y = pk2(y0[2], y0[3]); w.z = pk2(y1[0], y1[1]); w.w = pk2(y1[2], y1[3]); *(u32x4*)(ob + c0) = w; }
        if (oq) { u32x2 w; w.x = pk4_fp8(y0[0], y0[1], y0[2], y0[3]); w.y = pk4_fp8(y1[0], y1[1], y1[2], y1[3]); *(u32x2*)(oq + c0) = w; } }
}
struct XItem { const float* W; unsigned char* WT; int ld, Kd, k0, drow; };
template <bool UPF> __device__ __forceinline__ XItem x_decode(int r, InTab in, int l, unsigned char* wbase) {
    XItem q;
    if (UPF) { const int e = r / 512, p = r % 512, w = p / 256, kb = (p % 256) / 16, nb = p % 16, j0 = nb * 32;
        q.W = (e < 64 ? in[26 + w] + ((size_t)l * NE + e) * 2048 * 512 : in[29 + w] + (size_t)l * 2048 * 512) + j0;
        q.WT = wbase + W_UP + (size_t)e * 1024 * 2048; q.ld = 512; q.Kd = 2048; q.k0 = kb * 128; q.drow = (j0 / 128) * 256 + w * 128 + (j0 % 128); }
    else { const int e = r / 256, p = r % 256, kb = p / 64, nb = p % 64;
        q.W = (e < 64 ? in[28] + ((size_t)l * NE + e) * 512 * 2048 : in[31] + (size_t)l * 512 * 2048) + nb * 32;
        q.WT = wbase + W_DN + (size_t)e * 2048 * 512; q.ld = 2048; q.Kd = 512; q.k0 = kb * 128; q.drow = nb * 32; }
    return q;
}
template <bool UPF> __device__ __forceinline__ void x_family(LAS float* scr, InTab in, int l, unsigned char* wbase, int gw, int NGW, int lane) {
    constexpr int NI = UPF ? 65 * 2 * 256 : 65 * 256;
#pragma unroll 1
    for (int it = gw; it < NI; it += NGW) {
        const XItem q = x_decode<UPF>(it, in, l, wbase);
        float t[64]; const float* wp = q.W + (size_t)(q.k0 + (lane >> 5)) * q.ld + (lane & 31);
#pragma unroll
        for (int i = 0; i < 64; ++i) t[i] = __builtin_nontemporal_load(wp + (size_t)(2 * i) * q.ld);
#pragma unroll
        for (int hf = 0; hf < 2; ++hf) {
            const int nn = lane & 31;
#pragma unroll
            for (int i = 0; i < 32; ++i) scr[(2 * i + (lane >> 5)) * 33 + nn] = t[32 * hf + i];
            LDS_WAIT(); asm volatile("" ::: "memory");
            const int c = lane & 7;
#pragma unroll
            for (int j = 0; j < 4; ++j) { const int n = (lane >> 3) + 8 * j; const LAS float* s = scr + (8 * c) * 33 + n;
                u32x2 o; o.x = pk4_fp8(s[0 * 33] * 32.f, s[1 * 33] * 32.f, s[2 * 33] * 32.f, s[3 * 33] * 32.f); o.y = pk4_fp8(s[4 * 33] * 32.f, s[5 * 33] * 32.f, s[6 * 33] * 32.f, s[7 * 33] * 32.f);
                *(u32x2*)(q.WT + (size_t)(q.drow + n) * q.Kd + q.k0 + 64 * hf + 8 * c) = o; }
            LDS_WAIT(); asm volatile("" ::: "memory");
        }
    }
}
__device__ __forceinline__ void p0_convert(LAS unsigned char* lds, InTab in, int l, unsigned char* wbase, int gw, int NGW, int wave, int lane) {
    LAS float* scr = (LAS float*)(lds + wave * 16384);
    constexpr int I_IN = 32 * 497, I_PR = 1024, I_OUT = 2048, I_LR = 128, I_UP = 65 * 2 * 512, I_DN = 65 * 512;
    constexpr int I_RT = 64;
    constexpr int NITEMS = I_IN + 3 * I_PR + I_OUT + I_LR + I_RT;
    bf16* Win = (bf16*)(wbase + W_IN);
    for (int it = gw; it < NITEMS; it += NGW) {
        int r = it;
        if (r < I_IN) { const int kb = r / 497, nb = r % 497;
            int nsrc, drow, nv = 32;
            if (nb < 192) { nsrc = nb * 32; drow = nb * 32; }
            else if (nb < 224) { nsrc = nb * 32; drow = COL_LX + (nb - 192) * 32; }
            else if (nb < 256) { nsrc = nb * 32; drow = COL_LG + (nb - 224) * 32; }
            else if (nb < 288) { nsrc = nb * 32; drow = COL_Z + (nb - 256) * 32; }
            else if (nb < 336) { nsrc = nb * 32; drow = COL_XBC + (nb - 288) * 32; }
            else if (nb < 432) { nsrc = 10768 + (nb - 336) * 32; drow = COL_Q + (nb - 336) * 32; }
            else if (nb < 464) { nsrc = 10768 + (nb - 336) * 32; drow = COL_K + (nb - 432) * 32; }
            else if (nb < 496) { nsrc = 10768 + (nb - 336) * 32; drow = COL_V + (nb - 464) * 32; }
            else { nsrc = 10752; drow = COL_DT; nv = 16; }
            if (drow < N8) cvt_item<1>(in[3] + (size_t)l * D * D_IN, D_IN, 2048, (bf16*)(wbase + W_IN8), scr, kb * 64, nsrc, drow, nv, lane);
            else cvt_item(in[3] + (size_t)l * D * D_IN, D_IN, 2048, Win, scr, kb * 64, nsrc, drow, nv, lane);
            continue; }
        r -= I_IN;
        if (r < 3 * I_PR) { const int w = r / I_PR, q = r % I_PR, kb = q / 64, nb = q % 64;
            const float* src = in[18 + w] + (size_t)l * 1024 * D; bf16* dst = (bf16*)(wbase + W_PL) + w * 1024;
            cvt_item(src, 2048, YLD, dst, scr, kb * 64, nb * 32, nb * 32, 32, lane); continue; }
        r -= 3 * I_PR;
        if (r < I_OUT) { const int kb = r / 64, nb = r % 64; cvt_item(in[21] + (size_t)l * D * D, 2048, 2048, (bf16*)(wbase + W_OUT), scr, kb * 64, nb * 32, nb * 32, 32, lane); continue; }
        r -= I_OUT;
        if (r < I_LR) { const int w = r / 64, q = r % 64, blk = q / 8, kb = (q % 8) / 4, nb = q % 4;
            cvt_item(in[7 + 2 * w] + (size_t)l * 8 * 16384 + blk * 16384, 128, 128, (bf16*)(wbase + W_LR + (size_t)w * 262144) + blk * 16384, scr, kb * 64, nb * 32, nb * 32, 32, lane); continue; }
        r -= I_LR;
        { const int kb = r / 2, nb = r % 2;
            cvt_item<2>(in[24] + (size_t)l * D * NE, NE, 2048, (bf16*)(wbase + W_RH), scr, kb * 64, nb * 32, nb * 32, 32, lane, (W_RL - W_RH) / 2); }
    }
    x_family<true>(scr, in, l, wbase, gw, NGW, lane);
    x_family<false>(scr, in, l, wbase, gw, NGW, lane);
    { u32x4* z = (u32x4*)(Win + (size_t)(COL_DT + 16) * 2048); const int n16 = 240 * 2048 * 2 / 16;
      for (int i = gw * 64 + lane; i < n16; i += NGW * 64) z[i] = (u32x4){0u, 0u, 0u, 0u}; }
}

template <int TPT> __device__ __forceinline__ void conv8(const bf16* src, int l0g, const float* cw, int cstride, const float* cb, float (&out)[TPT][8]) {
    u32x4 rows[TPT + 3];
#pragma unroll
    for (int j = 0; j < TPT + 3; ++j) { rows[j] = (u32x4){0u, 0u, 0u, 0u}; if (l0g + j - 3 >= 0) rows[j] = *(const u32x4*)(src + (ptrdiff_t)(j - 3) * LD); }
    float w[4][8], bb[8];
#pragma unroll
    for (int k = 0; k < 4; ++k) { const f32x4 a = *(const f32x4*)(cw + k * cstride), b = *(const f32x4*)(cw + k * cstride + 4);
#pragma unroll
        for (int e = 0; e < 4; ++e) { w[k][e] = a[e]; w[k][4 + e] = b[e]; } }
    { const f32x4 a = *(const f32x4*)cb, b = *(const f32x4*)(cb + 4);
#pragma unroll
      for (int e = 0; e < 4; ++e) { bb[e] = a[e]; bb[4 + e] = b[e]; } }
#pragma unroll
    for (int j = 0; j < TPT; ++j) {
#pragma unroll
        for (int e = 0; e < 8; ++e) out[j][e] = bb[e];
#pragma unroll
        for (int k = 0; k < 4; ++k) { const u32x4 x = rows[j + k];
            out[j][0] += w[k][0] * bflo(x.x); out[j][1] += w[k][1] * bfhi(x.x); out[j][2] += w[k][2] * bflo(x.y); out[j][3] += w[k][3] * bfhi(x.y);
            out[j][4] += w[k][4] * bflo(x.z); out[j][5] += w[k][5] * bfhi(x.z); out[j][6] += w[k][6] * bflo(x.w); out[j][7] += w[k][7] * bfhi(x.w); }
    }
}

__device__ __forceinline__ int lru_idx(int tok, int d) { return tok * 32 + (d ^ (4 * ((tok >> 3) & 7))); }
#define LDS_BAR() do { asm volatile("s_waitcnt lgkmcnt(0)" ::: "memory"); __builtin_amdgcn_s_barrier(); asm volatile("" ::: "memory"); } while (0)
constexpr int KS = 272;
struct AttnTask { int grp, b, h, dil, r, tb; };
__device__ __forceinline__ AttnTask attn_decode(int run, int k) {
    AttnTask t; t.grp = run >> 8; const int bh = (run >> 2) & 63, ti = 4 * (run & 3) + k; t.b = bh >> 3; t.h = bh & 7;
    if (t.grp == 0) { t.dil = 1; t.r = 0; t.tb = ti; } else if (t.grp == 1) { t.dil = 4; t.r = ti >> 2; t.tb = ti & 3; } else { t.dil = 16; t.r = ti; t.tb = 0; }
    return t;
}
__device__ __forceinline__ void attn_prefetch(const bf16* __restrict__ proj, const AttnTask& t, bool prev, int tid, u32x4 (&kr)[8], u32x4 (&vr)[8]) {
#pragma unroll
    for (int j = 0; j < 8; ++j) { const int idx = tid + 512 * j, row = idx >> 4, ch = idx & 15;
        if (prev || j >= 4) { const int tk = (t.tb * 128 - 128 + row) * t.dil + t.r; const bf16* src = proj + (size_t)(t.b * T + tk) * LD + t.h * 128 + ch * 8;
            kr[j] = *(const u32x4*)(src + COL_K); vr[j] = *(const u32x4*)(src + COL_V); } }
}
__device__ __forceinline__ void attn_phase(LAS unsigned char* lds, const bf16* __restrict__ proj, bf16* __restrict__ og, float* __restrict__ lse, int G, int bid, int tid) {
    const int lane = tid & 63, wave = __builtin_amdgcn_readfirstlane(tid >> 6);
    const int lr = lane & 15, lg = lane >> 4, lq = (lane & 15) >> 2, lp = lane & 3;
    LAS unsigned char* Kl = lds; LAS unsigned char* Vl = lds + 256 * KS;
    const unsigned vbase = (unsigned)(uintptr_t)Vl;
    u32x4 kr[8], vr[8];
    constexpr int NRUN = 768;
    if (bid < NRUN) { const AttnTask t0 = attn_decode(bid, 0); attn_prefetch(proj, t0, t0.tb != 0, tid, kr, vr); }
    for (int it = 0; bid + (it >> 2) * G < NRUN; ++it) {
        const int run = bid + (it >> 2) * G, k = it & 3;
        const AttnTask t = attn_decode(run, k);
        const int grp = t.grp, b = t.b, h = t.h, dil = t.dil, r = t.r, tb = t.tb;
        const int ub = tb * 128;
        const int ph = (k & 1) * 128;
        const bool prev = (k == 0) && tb != 0;
        LDS_BAR();
#pragma unroll
        for (int j = 0; j < 8; ++j) { const int idx = tid + 512 * j, row = (idx >> 4) ^ ph, ch = idx & 15;
            if (prev || j >= 4) { *(LAS u32x4*)(Kl + row * KS + ch * 16) = kr[j]; *(LAS u32x4*)(Vl + row * KS + ch * 16) = vr[j]; } }
        const int iq = 16 * wave + lr; const int tq = (ub + iq) * dil + r;
        const bf16* qp = proj + (size_t)(b * T + tq) * LD + COL_Q + grp * 1024 + h * 128 + 8 * lg;
        bf16x8 qf[4];
#pragma unroll
        for (int ks = 0; ks < 4; ++ks) qf[ks] = *(const bf16x8*)(qp + 32 * ks);
        { const int itn = it + 1, runn = bid + (itn >> 2) * G;
          if (runn < NRUN) { const AttnTask tn = attn_decode(runn, itn & 3); attn_prefetch(proj, tn, ((itn & 3) == 0) && tn.tb != 0, tid, kr, vr); } }
        LDS_BAR();
        const float slope = exp2f(-8.0f * (float)(grp * 8 + h + 1) / 24.0f) * (float)dil;
        const float scale = 0.08838834764831845f;
        int kb_lo = wave >> 1; const int kb_hi = (16 * wave + 143) >> 5; if (tb == 0 && kb_lo < 4) kb_lo = 4;
        float sj[2][4];
#pragma unroll
        for (int sb = 0; sb < 2; ++sb)
#pragma unroll
            for (int e = 0; e < 4; ++e) sj[sb][e] = slope * (float)(16 * sb + 4 * lg + e);
        float m_run = -1e30f, l_run = 0.f;
        f32x4 accO[8];
#pragma unroll
        for (int c = 0; c < 8; ++c) accO[c] = (f32x4){0.f, 0.f, 0.f, 0.f};
        for (int kb = kb_lo; kb <= kb_hi; ++kb) {
            const unsigned va = vbase + (unsigned)(((32 * kb + 4 * lg + lq) ^ ph) * KS + 8 * lp);
            u32x2 vlo[8], vhi[8]; tr_issue16(va, va + 16 * KS, vlo, vhi);
            f32x4 sacc[2];
#pragma unroll
            for (int sb = 0; sb < 2; ++sb) { sacc[sb] = (f32x4){0.f, 0.f, 0.f, 0.f};
#pragma unroll
                for (int ks = 0; ks < 4; ++ks) { const bf16x8 kf = *(const LAS bf16x8*)(Kl + ((32 * kb + 16 * sb + lr) ^ ph) * KS + 64 * ks + 16 * lg);
                    sacc[sb] = __builtin_amdgcn_mfma_f32_16x16x32_bf16(kf, qf[ks], sacc[sb], 0, 0, 0); } }
            const float kbt = slope * (float)(32 * kb);
            float sv[2][4];
#pragma unroll
            for (int sb = 0; sb < 2; ++sb)
#pragma unroll
                for (int e = 0; e < 4; ++e) sv[sb][e] = sacc[sb][e] * scale + (sj[sb][e] + kbt);
            if (!((32 * kb >= 16 * wave + 15) && (32 * kb + 31 <= 16 * wave + 128))) {
#pragma unroll
                for (int sb = 0; sb < 2; ++sb)
#pragma unroll
                    for (int e = 0; e < 4; ++e) { const int dist = iq + 128 - (32 * kb + 16 * sb + 4 * lg + e); if (dist < 0 || dist > 128) sv[sb][e] = -1e30f; }
            }
            float mx = fmaxf(fmaxf(fmaxf(sv[0][0], sv[0][1]), fmaxf(sv[0][2], sv[0][3])), fmaxf(fmaxf(sv[1][0], sv[1][1]), fmaxf(sv[1][2], sv[1][3])));
            mx = fmaxf(mx, __shfl_xor(mx, 16)); mx = fmaxf(mx, __shfl_xor(mx, 32));
            if (__builtin_amdgcn_ballot_w64(mx > m_run + 8.0f) != 0ull) {
                const float m_new = fmaxf(m_run, mx); const float alpha = __expf(m_run - m_new);
                l_run *= alpha; m_run = m_new;
#pragma unroll
                for (int c = 0; c < 8; ++c) accO[c] *= alpha;
            }
            float p[2][4]; float ps = 0.f;
#pragma unroll
            for (int sb = 0; sb < 2; ++sb)
#pragma unroll
                for (int e = 0; e < 4; ++e) { p[sb][e] = __expf(sv[sb][e] - m_run); ps += p[sb][e]; }
            l_run += ps;
            u32x4 pw; pw.x = pk2(p[0][0], p[0][1]); pw.y = pk2(p[0][2], p[0][3]); pw.z = pk2(p[1][0], p[1][1]); pw.w = pk2(p[1][2], p[1][3]);
            const bf16x8 pf = as_bf16x8(pw);
            tr_wait16(vlo, vhi);
#pragma unroll
            for (int c = 0; c < 8; ++c) { u32x4 vw; vw.x = vlo[c].x; vw.y = vlo[c].y; vw.z = vhi[c].x; vw.w = vhi[c].y;
                accO[c] = __builtin_amdgcn_mfma_f32_16x16x32_bf16(as_bf16x8(vw), pf, accO[c], 0, 0, 0); }
        }
        float lt = l_run; lt += __shfl_xor(lt, 16); lt += __shfl_xor(lt, 32);
        const float inv = 1.0f / lt;
        bf16* op = og + ((size_t)grp * M + (size_t)(b * T + tq)) * 1024 + h * 128 + 4 * lg;
#pragma unroll
        for (int c = 0; c < 8; ++c) { u32x2 w; w.x = pk2(accO[c][0] * inv, accO[c][1] * inv); w.y = pk2(accO[c][2] * inv, accO[c][3] * inv); *(u32x2*)(op + 16 * c) = w; }
        if (lg == 0) lse[((size_t)grp * M + (size_t)(b * T + tq)) * 8 + h] = m_run + __logf(lt) - slope * (float)(iq + 128);
    }
}
__device__ __forceinline__ void attn_merge(const bf16* __restrict__ og, const float* __restrict__ lse, bf16* __restrict__ ya, int gw, int NGW, int lane) {
    for (int row = gw; row < M; row += NGW) {
#pragma unroll
        for (int j = 0; j < 2; ++j) { const int cb = lane + 64 * j, h = cb >> 4;
            const float l0 = lse[(size_t)row * 8 + h], l1 = lse[((size_t)M + row) * 8 + h], l2 = lse[((size_t)2 * M + row) * 8 + h];
            const float mx = fmaxf(l0, fmaxf(l1, l2)); float w0 = __expf(l0 - mx), w1 = __expf(l1 - mx), w2 = __expf(l2 - mx); const float inv = 1.0f / (w0 + w1 + w2); w0 *= inv; w1 *= inv; w2 *= inv;
            const u32x4 a = *(const u32x4*)(og + (size_t)row * 1024 + cb * 8), b = *(const u32x4*)(og + ((size_t)M + row) * 1024 + cb * 8), c = *(const u32x4*)(og + ((size_t)2 * M + row) * 1024 + cb * 8);
            u32x4 o;
            o.x = pk2(w0 * bflo(a.x) + w1 * bflo(b.x) + w2 * bflo(c.x), w0 * bfhi(a.x) + w1 * bfhi(b.x) + w2 * bfhi(c.x));
            o.y = pk2(w0 * bflo(a.y) + w1 * bflo(b.y) + w2 * bflo(c.y), w0 * bfhi(a.y) + w1 * bfhi(b.y) + w2 * bfhi(c.y));
            o.z = pk2(w0 * bflo(a.z) + w1 * bflo(b.z) + w2 * bflo(c.z), w0 * bfhi(a.z) + w1 * bfhi(b.z) + w2 * bfhi(c.z));
            o.w = pk2(w0 * bflo(a.w) + w1 * bflo(b.w) + w2 * bflo(c.w), w0 * bfhi(a.w) + w1 * bfhi(b.w) + w2 * bfhi(c.w));
            *(u32x4*)(ya + (size_t)row * YLD + cb * 8) = o; }
    }
}

__device__ __forceinline__ float ssd_dt_acum(LAS float* DT, LAS float* AC, const bf16* __restrict__ proj, const float* dt_bias, const float* a_log, int b, int c, int g, int wave, int lane) {
    const int h = 8 * g + wave; const float bias = dt_bias[h], a = -__expf(a_log[h]);
    const size_t rowb = (size_t)(b * T + c * 128 + 2 * lane) * LD + COL_DT + h;
    const float d0 = softplusf_(bf2f(proj[rowb]) + bias), d1 = softplusf_(bf2f(proj[rowb + LD]) + bias);
    const float v0 = d0 * a, v1 = d1 * a; float s = v0 + v1;
#pragma unroll
    for (int o = 1; o < 64; o <<= 1) { const float t = __shfl_up(s, o); if (lane >= o) s += t; }
    DT[wave * 128 + 2 * lane] = d0; DT[wave * 128 + 2 * lane + 1] = d1;
    AC[wave * 128 + 2 * lane] = s - v1; AC[wave * 128 + 2 * lane + 1] = s;
    return __shfl(s, 63);
}
__device__ __forceinline__ void ssd_stage_bc(LAS unsigned char* img, const bf16* __restrict__ proj, const float* cw, const float* cb, int b, int c, int chan0, int tid) {
    const int ch = tid & 15, tg = tid >> 4;
    const int l0 = tg * 4, col = chan0 + ch * 8;
    float o[4][8];
    conv8<4>(proj + (size_t)(b * T + c * 128 + l0) * LD + COL_XBC + col, c * 128 + l0, cw + col, 1536, cb + col, o);
#pragma unroll
    for (int j = 0; j < 4; ++j) { float v[8];
#pragma unroll
        for (int e = 0; e < 8; ++e) v[e] = siluf_(o[j][e]);
        *(LAS u32x4*)(img + (l0 + j) * KS + ch * 16) = pack8(v); }
}
constexpr int XS = 528;
template <bool SCALE> __device__ __forceinline__ void ssd_stage_x(LAS unsigned char* img, const bf16* __restrict__ proj, const float* cw, const float* cb, int b, int c, int chan0, LAS const float* WL, int hb, int tid) {
    const int ch = tid & 31, tg = tid >> 5;
    const int col = chan0 + ch * 8;
#pragma unroll 1
    for (int sub = 0; sub < 2; ++sub) {
        const int l0 = tg * 8 + sub * 4;
        float o[4][8];
        conv8<4>(proj + (size_t)(b * T + c * 128 + l0) * LD + COL_XBC + col, c * 128 + l0, cw + col, 1536, cb + col, o);
#pragma unroll
        for (int j = 0; j < 4; ++j) { float v[8]; const float sc = SCALE ? WL[(hb + (ch >> 3)) * 128 + l0 + j] : 1.0f;
#pragma unroll
            for (int e = 0; e < 8; ++e) v[e] = siluf_(o[j][e]) * sc;
            *(LAS u32x4*)(img + (l0 + j) * XS + ch * 16) = pack8(v); }
    }
}
__device__ __forceinline__ void ssd_states_phase(LAS unsigned char* lds, const bf16* __restrict__ proj, const float* cw, const float* cb, const float* dt_bias, const float* a_log,
                                                 float* __restrict__ sst, float* __restrict__ alast, int G, int bid, int tid) {
    const int lane = tid & 63, wave = __builtin_amdgcn_readfirstlane(tid >> 6);
    LAS float* DT = (LAS float*)lds; LAS float* AC = DT + 1024; LAS float* WL = AC + 1024;
    LAS unsigned char* BMi = lds + 12288; LAS unsigned char* Xi = BMi + 128 * KS;
    const unsigned bbase = (unsigned)(uintptr_t)BMi, xbase = (unsigned)(uintptr_t)Xi;
    for (int unit = bid; unit < 256; unit += G) {
        const int b = unit >> 5, c = (unit >> 1) & 15, g = unit & 1;
        __syncthreads();
        const float al = ssd_dt_acum(DT, AC, proj, dt_bias, a_log, b, c, g, wave, lane);
        if (lane == 0) alast[(b * 16 + c) * 16 + 8 * g + wave] = al;
        LDS_WAIT();
        WL[wave * 128 + 2 * lane] = DT[wave * 128 + 2 * lane] * __expf(al - AC[wave * 128 + 2 * lane]);
        WL[wave * 128 + 2 * lane + 1] = DT[wave * 128 + 2 * lane + 1] * __expf(al - AC[wave * 128 + 2 * lane + 1]);
        ssd_stage_bc(BMi, proj, cw, cb, b, c, 1024 + 128 * g, tid);
        __syncthreads();
#pragma unroll 1
        for (int pass = 0; pass < 2; ++pass) {
            if (pass) __syncthreads();
            ssd_stage_x<true>(Xi, proj, cw, cb, b, c, 512 * g + 256 * pass, WL, 4 * pass, tid);
            __syncthreads();
            int ln = lane; asm volatile("" : "+v"(ln));
            const int lr = ln & 15, lg = ln >> 4, lq = (ln & 15) >> 2, lp = ln & 3;
            const int hl = wave >> 1, ph = wave & 1;
            f32x4 acc[2][8];
#pragma unroll
            for (int mt = 0; mt < 2; ++mt)
#pragma unroll
                for (int nt = 0; nt < 8; ++nt) acc[mt][nt] = (f32x4){0.f, 0.f, 0.f, 0.f};
            const unsigned xa = xbase + (unsigned)((8 * lg + lq) * XS + (64 * hl + 32 * ph + 4 * lp) * 2);
            const unsigned ba = bbase + (unsigned)((8 * lg + lq) * KS + (4 * lp) * 2);
#pragma unroll
            for (int ks = 0; ks < 4; ++ks) {
                bf16x8 af[2];
#pragma unroll
                for (int mt = 0; mt < 2; ++mt) { const unsigned a0 = xa + (unsigned)(32 * ks * XS + 32 * mt);
                    u32x2 lo, hi; tr_read2(a0, a0 + 4 * XS, lo, hi); u32x4 w; w.x = lo.x; w.y = lo.y; w.z = hi.x; w.w = hi.y; af[mt] = as_bf16x8(w); }
#pragma unroll
                for (int nt = 0; nt < 8; ++nt) { const unsigned b0 = ba + (unsigned)(32 * ks * KS + 32 * nt);
                    u32x2 lo, hi; tr_read2(b0, b0 + 4 * KS, lo, hi); u32x4 w; w.x = lo.x; w.y = lo.y; w.z = hi.x; w.w = hi.y; const bf16x8 bfr = as_bf16x8(w);
#pragma unroll
                    for (int mt = 0; mt < 2; ++mt) acc[mt][nt] = __builtin_amdgcn_mfma_f32_16x16x32_bf16(af[mt], bfr, acc[mt][nt], 0, 0, 0); }
            }
            const int h = 8 * g + 4 * pass + hl;
#pragma unroll
            for (int mt = 0; mt < 2; ++mt) {
                float* sp = sst + ((size_t)((b * 16 + c) * 16 + h) * 64 + 32 * ph + 16 * mt + 4 * lg) * 128 + lr;
                asm volatile("" : "+v"(sp));
#pragma unroll
                for (int nt = 0; nt < 8; ++nt)
#pragma unroll
                    for (int e = 0; e < 4; ++e) sp[e * 128 + 16 * nt] = acc[mt][nt][e];
            }
        }
    }
}
__device__ __forceinline__ void ssd_pass_phase(float* __restrict__ sst, const float* __restrict__ alast, int G, int bid, int tid) {
    for (int i = bid * 512 + tid; i < 262144; i += G * 512) {
        const int b = i >> 15, q = i & 32767, h = q >> 11;
        f32x4* base = (f32x4*)sst + (size_t)b * 16 * 32768 + q;
        f32x4 v[16];
#pragma unroll
        for (int c = 0; c < 16; ++c) v[c] = base[(size_t)c * 32768];
        f32x4 e = (f32x4){0.f, 0.f, 0.f, 0.f};
#pragma unroll
        for (int c = 0; c < 16; ++c) { base[(size_t)c * 32768] = e; const float dec = __expf(alast[(b * 16 + c) * 16 + h]); e = e * dec + v[c]; }
    }
}
__device__ __forceinline__ void ssd_out_phase(LAS unsigned char* lds, const bf16* __restrict__ proj, const float* cw, const float* cb, const float* dt_bias, const float* a_log,
                                              const float* dskip, const float* norm_g, const float* __restrict__ sst, bf16* ys, int G, int bid, int tid) {
    const int lane = tid & 63, wave = __builtin_amdgcn_readfirstlane(tid >> 6);
    LAS float* DT = (LAS float*)lds; LAS float* AC = DT + 1024;
    LAS unsigned char* BMi = lds + 8192; LAS unsigned char* CMi = BMi + 128 * KS; LAS unsigned char* Xi = CMi + 128 * KS;
    const unsigned xbase = (unsigned)(uintptr_t)Xi;
    for (int unit = bid; unit < 256; unit += G) {
        const int b = unit >> 5, c = (unit >> 1) & 15, g = unit & 1;
        __syncthreads();
        (void)ssd_dt_acum(DT, AC, proj, dt_bias, a_log, b, c, g, wave, lane);
        ssd_stage_bc(BMi, proj, cw, cb, b, c, 1024 + 128 * g, tid);
        ssd_stage_bc(CMi, proj, cw, cb, b, c, 1280 + 128 * g, tid);
        ssd_stage_x<false>(Xi, proj, cw, cb, b, c, 512 * g, nullptr, 0, tid);
        __syncthreads();
        int ln0 = lane; asm volatile("" : "+v"(ln0));
        const int l = 16 * wave + (ln0 & 15);
        bf16x8 cf[4];
#pragma unroll
        for (int ks = 0; ks < 4; ++ks) cf[ks] = *(const LAS bf16x8*)(CMi + l * KS + 64 * ks + 16 * (ln0 >> 4));
        f32x4 cbT[8];
#pragma unroll
        for (int sb = 0; sb < 8; ++sb) { cbT[sb] = (f32x4){0.f, 0.f, 0.f, 0.f};
            if (sb <= wave) {
#pragma unroll
                for (int ks = 0; ks < 4; ++ks) { const bf16x8 bfr = *(const LAS bf16x8*)(BMi + (16 * sb + (ln0 & 15)) * KS + 64 * ks + 16 * (ln0 >> 4));
                    cbT[sb] = __builtin_amdgcn_mfma_f32_16x16x32_bf16(bfr, cf[ks], cbT[sb], 0, 0, 0); } } }
        float ssq = 0.f;
        const size_t tokrow = (size_t)(b * T + c * 128 + l);
        const int ep_p = tid >> 3, ep_n0 = (tid & 7) * 16;
        f32x4 er[4];
#define SSD_E_LOAD(hh_) do { const float* q_ = sst + ((size_t)((b * 16 + c) * 16 + 8 * g + (hh_)) * 64 + ep_p) * 128 + ep_n0; \
            _Pragma("unroll") for (int j_ = 0; j_ < 4; ++j_) er[j_] = *(const f32x4*)(q_ + 4 * j_); } while (0)
#define SSD_E_WRITE(buf_) do { u32x4 w0_, w1_; w0_.x = pk2(er[0][0], er[0][1]); w0_.y = pk2(er[0][2], er[0][3]); w0_.z = pk2(er[1][0], er[1][1]); w0_.w = pk2(er[1][2], er[1][3]); \
            w1_.x = pk2(er[2][0], er[2][1]); w1_.y = pk2(er[2][2], er[2][3]); w1_.z = pk2(er[3][0], er[3][1]); w1_.w = pk2(er[3][2], er[3][3]); \
            LAS unsigned char* d_ = BMi + (buf_) * 17408 + ep_p * KS + ep_n0 * 2; *(LAS u32x4*)d_ = w0_; *(LAS u32x4*)(d_ + 16) = w1_; } while (0)
        SSD_E_LOAD(0);
        __syncthreads();
        SSD_E_WRITE(0);
        __syncthreads();
#pragma unroll 1
        for (int hh = 0; hh < 8; ++hh) {
            const int pass = hh >> 2, hl = hh & 3;
            if (hh == 4) { ssd_stage_x<false>(Xi, proj, cw, cb, b, c, 512 * g + 256, nullptr, 0, tid); __syncthreads(); }
            {
                int ln = lane; asm volatile("" : "+v"(ln));
                const int lr = ln & 15, lg = ln >> 4, lq = (ln & 15) >> 2, lp = ln & 3;
                const int h = 8 * g + hh;
                const float acl = AC[hh * 128 + l];
                f32x4 acc[4];
#pragma unroll
                for (int mt = 0; mt < 4; ++mt) acc[mt] = (f32x4){0.f, 0.f, 0.f, 0.f};
                u32x2 zv[4];
#pragma unroll
                for (int mt = 0; mt < 4; ++mt) zv[mt] = *(const u32x2*)(proj + tokrow * LD + COL_Z + 512 * g + 256 * pass + 64 * hl + 16 * mt + 4 * lg);
                if (hh + 1 < 8) SSD_E_LOAD(hh + 1);
                const LAS unsigned char* eb = BMi + (hh & 1) * 17408 + lr * KS + 16 * lg;
#pragma unroll
                for (int mt = 0; mt < 4; ++mt)
#pragma unroll
                    for (int ks = 0; ks < 4; ++ks) { const bf16x8 ef = *(const LAS bf16x8*)(eb + 16 * mt * KS + 64 * ks);
                        acc[mt] = __builtin_amdgcn_mfma_f32_16x16x32_bf16(ef, cf[ks], acc[mt], 0, 0, 0); }
                const float eal = __expf(acl);
#pragma unroll
                for (int mt = 0; mt < 4; ++mt) acc[mt] *= eal;
#pragma unroll
                for (int kk = 0; kk < 4; ++kk) {
                    if (2 * kk <= wave) {
                        float pv[8];
#pragma unroll
                        for (int hb2 = 0; hb2 < 2; ++hb2) { const int sb = 2 * kk + hb2, s0 = 16 * sb + 4 * lg;
                            const f32x4 av = *(const LAS f32x4*)(AC + hh * 128 + s0), dv = *(const LAS f32x4*)(DT + hh * 128 + s0);
#pragma unroll
                            for (int e = 0; e < 4; ++e) { const float w = (s0 + e <= l) ? __expf(acl - av[e]) * dv[e] : 0.f; pv[4 * hb2 + e] = cbT[sb][e] * w; } }
                        const bf16x8 pf = as_bf16x8(pack8(pv));
                        const unsigned va = xbase + (unsigned)((32 * kk + 4 * lg + lq) * XS + (64 * hl + 4 * lp) * 2);
#pragma unroll
                        for (int mt = 0; mt < 4; ++mt) { u32x2 lo, hi; tr_read2(va + 32 * mt, va + 32 * mt + 16 * XS, lo, hi); u32x4 vw; vw.x = lo.x; vw.y = lo.y; vw.z = hi.x; vw.w = hi.y;
                            acc[mt] = __builtin_amdgcn_mfma_f32_16x16x32_bf16(as_bf16x8(vw), pf, acc[mt], 0, 0, 0); }
                    } }
                const float dsk = dskip[h];
#pragma unroll
                for (int mt = 0; mt < 4; ++mt) { const int chl = 64 * hl + 16 * mt + 4 * lg;
                    const u32x2 xv = *(const LAS u32x2*)(Xi + l * XS + chl * 2);
                    float y0 = (acc[mt][0] + dsk * bflo(xv.x)) * siluf_(bflo(zv[mt].x)), y1 = (acc[mt][1] + dsk * bfhi(xv.x)) * siluf_(bfhi(zv[mt].x));
                    float y2 = (acc[mt][2] + dsk * bflo(xv.y)) * siluf_(bflo(zv[mt].y)), y3 = (acc[mt][3] + dsk * bfhi(xv.y)) * siluf_(bfhi(zv[mt].y));
                    ssq += y0 * y0 + y1 * y1 + y2 * y2 + y3 * y3;
                    u32x2 o; o.x = pk2(y0, y1); o.y = pk2(y2, y3);
                    *(u32x2*)(ys + tokrow * YLD + 512 * g + 256 * pass + chl) = o; }
                if (hh + 1 < 8) SSD_E_WRITE((hh + 1) & 1);
            }
            __syncthreads();
        }
#undef SSD_E_LOAD
#undef SSD_E_WRITE
        VM_WAIT();
        ssq += __shfl_xor(ssq, 16); ssq += __shfl_xor(ssq, 32);
        const float rstd = 1.0f / sqrtf(ssq * (1.0f / 512.0f) + RMS_EPS);
        { int ln = lane; asm volatile("" : "+v"(ln));
          const int lg = ln >> 4;
          bf16* yp = ys + tokrow * YLD + 512 * g + 4 * lg;
          u32x2 yv[8][4];
#pragma unroll
          for (int hh = 0; hh < 8; ++hh)
#pragma unroll
              for (int mt = 0; mt < 4; ++mt) yv[hh][mt] = *(const u32x2*)(yp + 64 * hh + 16 * mt);
#pragma unroll
          for (int hh = 0; hh < 8; ++hh)
#pragma unroll
              for (int mt = 0; mt < 4; ++mt) { const f32x4 ng = *(const f32x4*)(norm_g + 512 * g + 64 * hh + 16 * mt + 4 * lg); const u32x2 y = yv[hh][mt];
                  u32x2 o; o.x = pk2(bflo(y.x) * rstd * ng[0], bfhi(y.x) * rstd * ng[1]); o.y = pk2(bflo(y.y) * rstd * ng[2], bfhi(y.y) * rstd * ng[3]);
                  *(u32x2*)(yp + 64 * hh + 16 * mt) = o; } }
    }
}

__device__ __forceinline__ void lru_phase(LAS unsigned char* lds, const bf16* __restrict__ proj, const float* cw, const float* cb, const bf16* __restrict__ wrt, const bf16* __restrict__ wit,
                                          const float* br, const float* bi, const float* lam, bf16* __restrict__ yl, int G, int bid, int tid) {
    const int wave = __builtin_amdgcn_readfirstlane(tid >> 6);
    LAS unsigned char* XC = lds;
    LAS float* Aa = (LAS float*)(lds + 128 * KS);
    LAS float* Uu = Aa + 4096;
    LAS float* CW = Uu + 4096;
    for (int unit = bid; unit < 256; unit += G) {
        const int b = unit >> 5, n = (unit >> 2) & 7, dq = unit & 3;
        const int dch = 128 * n + 32 * dq;
        __syncthreads();
        for (int i = tid; i < 640; i += 512) { const int k = i >> 7, c = i & 127; CW[i] = k < 4 ? cw[k * 1024 + 128 * n + c] : cb[128 * n + c]; }
        int t2 = tid; asm volatile("" : "+v"(t2));
        const int lane = t2 & 63, lr = lane & 15, lg = lane >> 4;
        bf16x8 wrf[2][4], wif[2][4]; float brv[2], biv[2], spl[2];
#pragma unroll
        for (int nt = 0; nt < 2; ++nt) { const size_t wo = (size_t)n * 16384 + (size_t)(32 * dq + 16 * nt + lr) * 128 + 8 * lg;
#pragma unroll
            for (int ks = 0; ks < 4; ++ks) { wrf[nt][ks] = *(const bf16x8*)(wrt + wo + 32 * ks); wif[nt][ks] = *(const bf16x8*)(wit + wo + 32 * ks); }
            const int dl = dch + 16 * nt + lr; brv[nt] = br[dl]; biv[nt] = bi[dl]; spl[nt] = -8.0f * softplusf_(-lam[dl]); }
        const int cch = t2 & 15, l0 = (t2 >> 4) * 4;
        const int tok_o = t2 >> 2, qo = t2 & 3;
        const bf16* xsrc = proj + (size_t)(b * T + l0) * LD + COL_LX + 128 * n + cch * 8;
        const bf16* gsrc = proj + (size_t)(b * T + tok_o) * LD + COL_LG + dch + 8 * qo;
        u32x4 rows[7];
#pragma unroll
        for (int j = 0; j < 7; ++j) { rows[j] = (u32x4){0u, 0u, 0u, 0u}; if (l0 + j - 3 >= 0) rows[j] = *(const u32x4*)(xsrc + (ptrdiff_t)(j - 3) * LD); }
        u32x4 gate_n = *(const u32x4*)gsrc;
        float carry = 0.f;
        __syncthreads();
#pragma unroll 1
        for (int c = 0; c < 16; ++c) {
            { float w[4][8], o[8];
#pragma unroll
              for (int k = 0; k < 4; ++k) { const f32x4 a = *(const LAS f32x4*)(CW + k * 128 + cch * 8), bq = *(const LAS f32x4*)(CW + k * 128 + cch * 8 + 4);
#pragma unroll
                  for (int e = 0; e < 4; ++e) { w[k][e] = a[e]; w[k][4 + e] = bq[e]; } }
              const f32x4 ba = *(const LAS f32x4*)(CW + 512 + cch * 8), bb = *(const LAS f32x4*)(CW + 512 + cch * 8 + 4);
#pragma unroll
              for (int j = 0; j < 4; ++j) {
#pragma unroll
                  for (int e = 0; e < 4; ++e) { o[e] = ba[e]; o[4 + e] = bb[e]; }
#pragma unroll
                  for (int k = 0; k < 4; ++k) { const u32x4 x = rows[j + k];
                      o[0] += w[k][0] * bflo(x.x); o[1] += w[k][1] * bfhi(x.x); o[2] += w[k][2] * bflo(x.y); o[3] += w[k][3] * bfhi(x.y);
                      o[4] += w[k][4] * bflo(x.z); o[5] += w[k][5] * bfhi(x.z); o[6] += w[k][6] * bflo(x.w); o[7] += w[k][7] * bfhi(x.w); }
                  *(LAS u32x4*)(XC + (l0 + j) * KS + cch * 16) = pack8(o); } }
            const u32x4 gate_c = gate_n;
            if (c < 15) {
#pragma unroll
                for (int j = 0; j < 7; ++j) rows[j] = *(const u32x4*)(xsrc + (ptrdiff_t)((c + 1) * 128 + j - 3) * LD);
                gate_n = *(const u32x4*)(gsrc + (size_t)(c + 1) * 128 * LD);
            }
            LDS_BAR();
            { bf16x8 af[4];
#pragma unroll
              for (int ks = 0; ks < 4; ++ks) af[ks] = *(const LAS bf16x8*)(XC + (16 * wave + lr) * KS + 64 * ks + 16 * lg);
#pragma unroll
              for (int nt = 0; nt < 2; ++nt) { f32x4 ar = (f32x4){0.f, 0.f, 0.f, 0.f}, ai = ar;
#pragma unroll
                  for (int ks = 0; ks < 4; ++ks) { ar = __builtin_amdgcn_mfma_f32_16x16x32_bf16(af[ks], wrf[nt][ks], ar, 0, 0, 0); ai = __builtin_amdgcn_mfma_f32_16x16x32_bf16(af[ks], wif[nt][ks], ai, 0, 0, 0); }
                  const int dl = 16 * nt + lr;
#pragma unroll
                  for (int e = 0; e < 4; ++e) { const int tok = 16 * wave + 4 * lg + e;
                      const float rg = sigmoidf_(ar[e] + brv[nt]), ig = sigmoidf_(ai[e] + biv[nt]);
                      const float la = rg * spl[nt]; const float a = __expf(la);
                      const float xc = bf2f(*(const LAS bf16*)(XC + tok * KS + (32 * dq + dl) * 2));
                      Aa[lru_idx(tok, dl)] = a; Uu[lru_idx(tok, dl)] = __builtin_amdgcn_sqrtf(fmaxf(1.0f - a * a, 0.f)) * ig * xc; } } }
            LDS_BAR();
            { const int d = t2 >> 4, seg = t2 & 15;
              float hl[8], ac[8]; float hh = 0.f, aa = 1.f;
#pragma unroll
              for (int k = 0; k < 8; ++k) { const float a = Aa[lru_idx(8 * seg + k, d)], u = Uu[lru_idx(8 * seg + k, d)]; hh = a * hh + u; aa *= a; hl[k] = hh; ac[k] = aa; }
              float pa = aa, ph = hh;
              { float qa, qh;
                qa = row_shr<1>(1.f, pa); qh = row_shr<1>(0.f, ph); ph = pa * qh + ph; pa = pa * qa;
                qa = row_shr<2>(1.f, pa); qh = row_shr<2>(0.f, ph); ph = pa * qh + ph; pa = pa * qa;
                qa = row_shr<4>(1.f, pa); qh = row_shr<4>(0.f, ph); ph = pa * qh + ph; pa = pa * qa;
                qa = row_shr<8>(1.f, pa); qh = row_shr<8>(0.f, ph); ph = pa * qh + ph; pa = pa * qa; }
              const float ea = row_shr<1>(1.f, pa), eh = row_shr<1>(0.f, ph);
              const float cin = ea * carry + eh;
              const float ta = __shfl(pa, 15, 16), th = __shfl(ph, 15, 16); carry = ta * carry + th;
#pragma unroll
              for (int k = 0; k < 8; ++k) Uu[lru_idx(8 * seg + k, d)] = hl[k] + ac[k] * cin; }
            LDS_BAR();
            { const f32x4 h0 = *(const LAS f32x4*)(Uu + lru_idx(tok_o, 8 * qo)), h1v = *(const LAS f32x4*)(Uu + lru_idx(tok_o, 8 * qo + 4));
              float y[8];
              y[0] = h0[0] * gelu_tanh(bflo(gate_c.x)); y[1] = h0[1] * gelu_tanh(bfhi(gate_c.x)); y[2] = h0[2] * gelu_tanh(bflo(gate_c.y)); y[3] = h0[3] * gelu_tanh(bfhi(gate_c.y));
              y[4] = h1v[0] * gelu_tanh(bflo(gate_c.z)); y[5] = h1v[1] * gelu_tanh(bfhi(gate_c.z)); y[6] = h1v[2] * gelu_tanh(bflo(gate_c.w)); y[7] = h1v[3] * gelu_tanh(bfhi(gate_c.w));
              *(u32x4*)(yl + (size_t)(b * T + c * 128 + tok_o) * YLD + dch + 8 * qo) = pack8(y); }
        }
    }
}

__device__ __forceinline__ void router_phase(LAS unsigned char* lds, const float* __restrict__ pre, const float* __restrict__ hres, const float* lg_, const float* lb_, const bf16* __restrict__ rwh, const bf16* __restrict__ rwl, const float* rbias,
                                             float* __restrict__ h1, bf16* __restrict__ h1b, unsigned* gcnt, int* __restrict__ lts, float* __restrict__ lw, int* __restrict__ tmap, int* __restrict__ wgcnt, int G, int bid, int tid, int pflags) {
    const int lane = tid & 63, wave = __builtin_amdgcn_readfirstlane(tid >> 6);
    const bool table = MK_ONE && (M / 16 + G - 1) / G <= 4;
    constexpr int XS2 = 4112;
    LAS unsigned char* XH = lds; LAS unsigned char* XL = lds + 16 * XS2;
    LAS float* PART = (LAS float*)(lds + 32 * XS2);
    LAS int* SELT = (LAS int*)(PART + 2048);
    LAS float* SELW = (LAS float*)(SELT + 512);
    LAS int* LCNT = (LAS int*)(SELW + 512);
    LAS int* LBASE = LCNT + 64;
    LAS int* LPOS = LBASE + 64;
    if (tid < 64) LCNT[tid] = 0;
    const int ntiles = M / 16;
    int nflush = 0;
    for (int tile = bid; ; tile += G) {
        const bool have = tile < ntiles;
        if (have) {
            __syncthreads();
#pragma unroll 1
            for (int rr = 0; rr < 2; ++rr) { const int rl = 2 * wave + rr; const size_t row = (size_t)tile * 16 + rl;
                float v[4][8];
#pragma unroll
                for (int j = 0; j < 4; ++j) { const f32x4 a = *(const f32x4*)(pre + row * D + 512 * j + 8 * lane), bq = *(const f32x4*)(pre + row * D + 512 * j + 8 * lane + 4);
                    const f32x4 ha = *(const f32x4*)(hres + row * D + 512 * j + 8 * lane), hq = *(const f32x4*)(hres + row * D + 512 * j + 8 * lane + 4);
#pragma unroll
                    for (int e = 0; e < 4; ++e) { v[j][e] = ALPHA * ha[e] + a[e]; v[j][4 + e] = ALPHA * hq[e] + bq[e]; } }
                float s = 0.f;
#pragma unroll
                for (int j = 0; j < 4; ++j)
#pragma unroll
                    for (int e = 0; e < 8; ++e) s += v[j][e];
                const float mean = wave_sum(s) * (1.f / D); float s2 = 0.f;
#pragma unroll
                for (int j = 0; j < 4; ++j)
#pragma unroll
                    for (int e = 0; e < 8; ++e) { v[j][e] -= mean; s2 += v[j][e] * v[j][e]; }
                const float rstd = 1.f / sqrtf(wave_sum(s2) * (1.f / D) + LN_EPS);
#pragma unroll
                for (int j = 0; j < 4; ++j) { const int c0 = 512 * j + 8 * lane;
                    const f32x4 g0 = *(const f32x4*)(lg_ + c0), g1 = *(const f32x4*)(lg_ + c0 + 4), b0 = *(const f32x4*)(lb_ + c0), b1 = *(const f32x4*)(lb_ + c0 + 4);
                    f32x4 y0, y1;
#pragma unroll
                    for (int e = 0; e < 4; ++e) { y0[e] = v[j][e] * rstd * g0[e] + b0[e]; y1[e] = v[j][4 + e] * rstd * g1[e] + b1[e]; }
                    if (!(pflags & 2)) { *(f32x4*)(h1 + row * D + c0) = y0; *(f32x4*)(h1 + row * D + c0 + 4) = y1; }
                    u32x2 w; w.x = pk4_fp8(y0[0], y0[1], y0[2], y0[3]); w.y = pk4_fp8(y1[0], y1[1], y1[2], y1[3]); *(u32x2*)((unsigned char*)h1b + row * D + c0) = w;
                    float yh[8], yl[8];
#pragma unroll
                    for (int e = 0; e < 4; ++e) { yh[e] = bf2f(pk2(y0[e], 0.f) & 0xffffu); yl[e] = y0[e] - yh[e]; yh[4 + e] = bf2f(pk2(y1[e], 0.f) & 0xffffu); yl[4 + e] = y1[e] - yh[4 + e]; }
                    *(LAS u32x4*)(XH + rl * XS2 + c0 * 2) = pack8(yh); *(LAS u32x4*)(XL + rl * XS2 + c0 * 2) = pack8(yl); }
            }
            __syncthreads();
            { const int nt = wave & 3, kh = wave >> 2, r = lane & 15, g = lane >> 4;
              f32x4 acc = (f32x4){0.f, 0.f, 0.f, 0.f}, acc2 = acc, acc3 = acc;
              const size_t wo = ((size_t)(32 * kh * 4 + nt) * 64 + lane) * 8;
              const LAS unsigned char* xh = XH + r * XS2 + (1024 * kh + 8 * g) * 2; const LAS unsigned char* xl = XL + r * XS2 + (1024 * kh + 8 * g) * 2;
#pragma unroll 4
              for (int ks = 0; ks < ((pflags & 1) ? 4 : 32); ++ks) {
                  const bf16x8 bh = *(const bf16x8*)(rwh + wo + (size_t)ks * 2048), bl = *(const bf16x8*)(rwl + wo + (size_t)ks * 2048);
                  const bf16x8 ah = *(const LAS bf16x8*)(xh + 64 * ks), al = *(const LAS bf16x8*)(xl + 64 * ks);
                  acc = __builtin_amdgcn_mfma_f32_16x16x32_bf16(ah, bh, acc, 0, 0, 0); acc2 = __builtin_amdgcn_mfma_f32_16x16x32_bf16(ah, bl, acc2, 0, 0, 0); acc3 = __builtin_amdgcn_mfma_f32_16x16x32_bf16(al, bh, acc3, 0, 0, 0); }
              acc += acc2 + acc3;
#pragma unroll
              for (int e = 0; e < 4; ++e) PART[(kh * 16 + 4 * g + e) * 64 + 16 * nt + r] = acc[e]; }
            __syncthreads();
#pragma unroll 1
            for (int rr = 0; rr < 2; ++rr) { const int rl = 2 * wave + rr; const int tok = tile * 16 + rl;
                const float logit = PART[rl * 64 + lane] + PART[(16 + rl) * 64 + lane];
                const float score = 1.0f / (1.0f + __expf(-logit)); const float choice = score + rbias[lane];
                const int grp = lane >> 3;
                float m1 = choice; m1 = fmaxf(m1, __shfl_xor(m1, 1)); m1 = fmaxf(m1, __shfl_xor(m1, 2)); m1 = fmaxf(m1, __shfl_xor(m1, 4));
                const unsigned long long bm = __ballot(choice == m1); const unsigned gm = (unsigned)(bm >> (8 * grp)) & 0xffu; const int first = __builtin_ctz(gm) + 8 * grp;
                float m2 = (lane == first) ? -INFINITY : choice; m2 = fmaxf(m2, __shfl_xor(m2, 1)); m2 = fmaxf(m2, __shfl_xor(m2, 2)); m2 = fmaxf(m2, __shfl_xor(m2, 4));
                const float gs = m1 + m2;
                int grank = 0;
#pragma unroll
                for (int j = 0; j < 8; ++j) { const float o = __shfl(gs, 8 * j); grank += (o > gs || (o == gs && j < grp)) ? 1 : 0; }
                const bool keep = grank < 4;
                const float masked = keep ? choice : -INFINITY;
                int rank = 64; float cur = masked;
#pragma unroll 1
                for (int it8 = 0; it8 < 8; ++it8) {
                    float v = cur;
                    v = fmaxf(v, __int_as_float(__builtin_amdgcn_update_dpp(__float_as_int(v), __float_as_int(v), 0xb1, 0xf, 0xf, false)));
                    v = fmaxf(v, __int_as_float(__builtin_amdgcn_update_dpp(__float_as_int(v), __float_as_int(v), 0x4e, 0xf, 0xf, false)));
                    v = fmaxf(v, __int_as_float(__builtin_amdgcn_update_dpp(__float_as_int(v), __float_as_int(v), 0x141, 0xf, 0xf, false)));
                    v = fmaxf(v, __int_as_float(__builtin_amdgcn_update_dpp(__float_as_int(v), __float_as_int(v), 0x140, 0xf, 0xf, false)));
                    const float r0 = __int_as_float(__builtin_amdgcn_readlane(__float_as_int(v), 0)), r1 = __int_as_float(__builtin_amdgcn_readlane(__float_as_int(v), 16));
                    const float r2 = __int_as_float(__builtin_amdgcn_readlane(__float_as_int(v), 32)), r3 = __int_as_float(__builtin_amdgcn_readlane(__float_as_int(v), 48));
                    const float mxw = fmaxf(fmaxf(r0, r1), fmaxf(r2, r3));
                    const unsigned long long eq = __ballot(cur == mxw);
                    const int win = __builtin_ctzll(eq);
                    if (lane == win) { rank = it8; cur = -INFINITY; }
                }
                const bool sel = keep && rank < 8;
                const float wsum = wave_sum(sel ? score : 0.f);
                if (sel) { const int idx = (nflush * 16 + rl) * 8 + rank; SELT[idx] = (tok * 16 + rank) | (lane << 24); SELW[idx] = score / wsum * 2.5f; }
            }
            ++nflush;
        }
        const bool more = (tile + G) < ntiles;
        if (table) {
            if (!more) {
                __syncthreads();
                const int nent = nflush * 128;
                if (tid < nent) { const int e = (SELT[tid] >> 24) & 63; LPOS[tid] = atomicAdd((int*)&LCNT[e], 1); }
                __syncthreads();
                if (tid < 64) wgcnt[bid * 64 + tid] = LCNT[tid];
                if (tid == 64) LBASE[0] = nent;
            }
        } else if (nflush == 4 || (!more && nflush > 0)) {
            __syncthreads();
            const int nent = nflush * 128; int e = 0, lp = 0;
            if (tid < nent) { e = (SELT[tid] >> 24) & 63; lp = atomicAdd((int*)&LCNT[e], 1); LPOS[tid] = lp; }
            __syncthreads();
            if (tid < 64) { const int n = LCNT[tid]; LBASE[tid] = n ? (int)__hip_atomic_fetch_add(gcnt + tid * 16, (unsigned)n, __ATOMIC_RELAXED, __HIP_MEMORY_SCOPE_AGENT) : 0; LCNT[tid] = 0; }
            __syncthreads();
            if (tid < nent) { const int pos = LBASE[e] + lp; const int ts = SELT[tid] & 0xffffff; lts[e * 16384 + pos] = ts; lw[e * 16384 + pos] = SELW[tid]; tmap[(ts >> 4) * 8 + (ts & 15)] = (e << 16) | pos; }
            nflush = 0;
        }
        if (!more) break;
    }
}

__device__ __forceinline__ void router_lists(LAS unsigned char* lds, const int* __restrict__ wgcnt, unsigned* gcnt, int* __restrict__ lts, float* __restrict__ lw, int* __restrict__ tmap, int G, int bid, int tid) {
    if (!MK_ONE || (M / 16 + G - 1) / G > 4) return;
    constexpr int XS2 = 4112;
    LAS float* PART = (LAS float*)(lds + 32 * XS2);
    LAS int* SELT = (LAS int*)(PART + 2048); LAS float* SELW = (LAS float*)(SELT + 512); LAS int* LCNT = (LAS int*)(SELW + 512); LAS int* LBASE = LCNT + 64; LAS int* LPOS = LBASE + 64;
    LAS int* RED = (LAS int*)PART;
    const int nent = LBASE[0];
    __syncthreads();
    { const int e = tid & 63, part = tid >> 6; int sum = 0;
      const int w0 = part * ((G + 7) / 8), w1 = min(min(w0 + (G + 7) / 8, G), bid);
      for (int w = w0; w < w1; ++w) sum += wgcnt[w * 64 + e];
      RED[part * 64 + e] = sum; }
    __syncthreads();
    if (tid < 64) { int b = 0;
#pragma unroll
        for (int p = 0; p < 8; ++p) b += RED[p * 64 + tid];
        LBASE[tid] = b;
        if (bid == G - 1) gcnt[tid * 16] = (unsigned)(b + LCNT[tid]); }
    __syncthreads();
    if (tid < nent) { const int v = SELT[tid]; const int e = (v >> 24) & 63, ts = v & 0xffffff; const int pos = LBASE[e] + LPOS[tid];
        lts[e * 16384 + pos] = ts; lw[e * 16384 + pos] = SELW[tid]; tmap[(ts >> 4) * 8 + (ts & 15)] = (e << 16) | pos; }
}

__device__ __forceinline__ void combine_phase(const bf16* __restrict__ Y, const float* __restrict__ h1, const int* __restrict__ tmap, const float* __restrict__ lw, const unsigned* cnt, const float* g, const float* b, float* of, bf16* ob, unsigned char* oq, int gw, int NGW, int lane) {
    int nb = ((int)cnt[lane * 16] + 255) >> 8, s = nb;
#pragma unroll
    for (int o = 1; o < 64; o <<= 1) { const int t = __shfl_up(s, o); if (lane >= o) s += t; }
    const int pex = s - nb, NBr = __builtin_amdgcn_readlane(s, 63);
    for (int row = gw; row < M; row += NGW) {
        int ln_ = lane; asm volatile("" : "+v"(ln_)); const int lane = ln_;
        const int tm = tmap[row * 8 + (lane & 7)];
        const int yrow = __shfl(pex, tm >> 16) * 256 + (tm & 0xffff);
        const float wsl = lw[(tm >> 16) * 16384 + (tm & 0xffff)];
        float v[4][8];
#pragma unroll
        for (int j = 0; j < 4; ++j) { const int c0 = 512 * j + 8 * lane; const f32x4 a = *(const f32x4*)(h1 + (size_t)row * D + c0), bq = *(const f32x4*)(h1 + (size_t)row * D + c0 + 4);
#pragma unroll
            for (int e = 0; e < 4; ++e) { v[j][e] = ALPHA * a[e]; v[j][4 + e] = ALPHA * bq[e]; } }
#pragma unroll
        for (int sl = 0; sl < 9; ++sl) { const int yr = sl < 8 ? __builtin_amdgcn_readlane(yrow, sl) : NBr * 256 + row; const float w = sl < 8 ? __builtin_bit_cast(float, __builtin_amdgcn_readlane(__builtin_bit_cast(int, wsl), sl)) : 1.0f;
#pragma unroll
            for (int j = 0; j < 4; ++j) { const u32x2 y = *(const u32x2*)((const unsigned char*)Y + (size_t)yr * D + 512 * j + 8 * lane);
                const f32x2 a0 = __builtin_amdgcn_cvt_pk_f32_fp8((int)y.x, false), a1 = __builtin_amdgcn_cvt_pk_f32_fp8((int)y.x, true), a2 = __builtin_amdgcn_cvt_pk_f32_fp8((int)y.y, false), a3 = __builtin_amdgcn_cvt_pk_f32_fp8((int)y.y, true);
                v[j][0] += w * a0[0]; v[j][1] += w * a0[1]; v[j][2] += w * a1[0]; v[j][3] += w * a1[1]; v[j][4] += w * a2[0]; v[j][5] += w * a2[1]; v[j][6] += w * a3[0]; v[j][7] += w * a3[1]; }
            if (sl % 3 == 2) asm volatile("" ::: "memory"); }
        ln_store(v, g, b, lane, of ? of + (size_t)row * D : nullptr, ob ? ob + (size_t)row * D : nullptr, oq ? oq + (size_t)row * D : nullptr);
    }
}

struct Args { const float* in[34]; float* out; unsigned char* ws; int ph_lo, ph_hi, flags, pad; };
typedef const Args __attribute__((address_space(4)))* ArgP;
#ifndef PH_MASK
#define PH_MASK 0x7ff
#endif
#if MK_ONE
#define GRID_BAR() do { XcdBarrier b2_ = bar; asm volatile("" : "+s"(b2_.bar)); xcd_barrier(b2_); } while (0)
#else
#define GRID_BAR() do { } while (0)
#endif
#define IN(k) (((PH_MASK >> (((k)) % NPH)) & 1) && lo <= (k) && (k) < hi)
#define SEAM(k) do { if (IN(k) && IN((k) + 1)) GRID_BAR(); } while (0)
template <int L> __device__ __forceinline__ void layer_body(LAS unsigned char* lds, const int tid0, const int bid0, const int G, const int NGW, ArgP ap0, const XcdBarrier& bar, const int lo, const int hi) {
    {
        constexpr int l = L; constexpr int P = l * NPH;
#define PHASE_ENV() int tid = tid0 * 64 + (int)__builtin_amdgcn_mbcnt_hi(~0u, __builtin_amdgcn_mbcnt_lo(~0u, 0u)), bid = bid0; asm volatile("" : "+v"(tid)); asm volatile("" : "+s"(bid));     const int lane = tid & 63, wave = __builtin_amdgcn_readfirstlane(tid >> 6), gw = bid * 8 + wave; (void)lane; (void)gw; \
        ArgP ap = ap0; asm volatile("" : "+s"(ap)); InTab in = ap->in; unsigned char* ws = ap->ws; unsigned* ctl = (unsigned*)(ws + WS_CTL); bf16* projb = (bf16*)(ws + WS_PROJ); \
        float* hbuf = (float*)(ws + WS_H); bf16* hb = (bf16*)(ws + WS_HB); float* h1 = (float*)(ws + WS_H1); bf16* h1b = (bf16*)(ws + WS_H1B); unsigned char* wbase = ws + WS_W; \
        (void)in; (void)ctl; (void)projb; (void)hbuf; (void)hb; (void)h1; (void)h1b; (void)wbase
        if (IN(P + 0)) {
            PHASE_ENV();
            p0_convert(lds, in, l, wbase, gw, NGW, wave, lane);
            if (l == 0) {
                for (int row = gw; row < M; row += NGW) { float v[4][8];
#pragma unroll
                    for (int j = 0; j < 4; ++j) { const f32x4 x0 = *(const f32x4*)(in[0] + (size_t)row * D + 512 * j + 8 * lane), x1 = *(const f32x4*)(in[0] + (size_t)row * D + 512 * j + 8 * lane + 4);
#pragma unroll
                        for (int e = 0; e < 4; ++e) { v[j][e] = x0[e]; v[j][4 + e] = x1[e]; } }
                    ln_store(v, in[1], in[2], lane, hbuf + (size_t)row * D, hb + (size_t)row * D, ws + WS_HQ + (size_t)row * D); }
            }
        }
        SEAM(P + 0);
        if (IN(P + 1)) {
            PHASE_ENV();
            { DenseSchedT<true> S; S.init(M, 6144, D, G, bid, wbase + W_IN8); EpiStoreF8 E{ws + WS_G8, 6144};
              pg8::gemm_phase<EpiStoreF8, DenseSchedT<true>, true>(lds, (const char*)(ws + WS_HQ), D, S, E, tid); }
            { int t2 = tid; asm volatile("" : "+v"(t2));
              DenseSchedT<true> S; S.init(M, N8 - 6144, D, G, bid, wbase + W_IN8 + (size_t)6144 * D); EpiStoreBf16 E{projb, LD, 6144};
              pg8::gemm_phase<EpiStoreBf16, DenseSchedT<true>, true>(lds, (const char*)(ws + WS_HQ), D, S, E, t2); }
            { DenseSched S; S.init(M, LD - N8, D, G, bid, wbase + W_IN + (size_t)N8 * D * 2); EpiStoreBf16 E{projb, LD, N8};
              pg8::gemm_phase(lds, (const char*)hb, D, S, E, tid); }
        }
        SEAM(P + 1);
        if (IN(P + 2)) {
            PHASE_ENV();
#ifndef NO_SSD1
            ssd_states_phase(lds, projb, in[12] + (size_t)l * 4 * 1536, in[13] + (size_t)l * 1536, in[14] + l * 16, in[15] + l * 16,
                             (float*)(ws + WS_SST), (float*)(ws + WS_ALAST), G, bid, tid);
#endif
#ifndef NO_ATTN
            attn_phase(lds, projb, (bf16*)(ws + WS_OG), (float*)(ws + WS_LSE), G, bid, tid);
#endif
        }
        SEAM(P + 2);
        if (IN(P + 3)) {
            PHASE_ENV();
            ssd_pass_phase((float*)(ws + WS_SST), (const float*)(ws + WS_ALAST), G, bid, tid);
            attn_merge((const bf16*)(ws + WS_OG), (const float*)(ws + WS_LSE), (bf16*)(ws + WS_YL) + 2048, gw, NGW, lane);
            lru_phase(lds, projb, in[5] + (size_t)l * 4 * 1024, in[6] + (size_t)l * 1024, (const bf16*)(wbase + W_LR), (const bf16*)(wbase + W_LI),
                      in[8] + l * 1024, in[10] + l * 1024, in[11] + l * 1024, (bf16*)(ws + WS_YL), G, bid, tid);
        }
        SEAM(P + 3);
        if (IN(P + 4)) {
            PHASE_ENV();
            ssd_out_phase(lds, projb, in[12] + (size_t)l * 4 * 1536, in[13] + (size_t)l * 1536, in[14] + l * 16, in[15] + l * 16,
                          in[16] + l * 16, in[17] + l * 1024, (const float*)(ws + WS_SST), (bf16*)(ws + WS_YL) + 1024, G, bid, tid);
        }
        SEAM(P + 4);
        if (IN(P + 5)) {
            PHASE_ENV();
            const float* bg = in[4] + (size_t)l * 3 * D;
            { DenseSched S; S.init(M, D, YLD, G, bid, wbase + W_PL); EpiGate3 E{ws + WS_G8, bg, (bf16*)(ws + WS_MB)};
              pg8::gemm_phase(lds, (const char*)(ws + WS_YL), YLD, S, E, tid); }
        }
        SEAM(P + 5);
        if (IN(P + 6)) {
            PHASE_ENV();
            DenseSched S; S.init(M, D, D, G, bid, wbase + W_OUT); EpiResid E{(float*)(ws + WS_PRE)};
            pg8::gemm_phase(lds, (const char*)(ws + WS_MB), D, S, E, tid);
        }
        SEAM(P + 6);
        if (IN(P + 7)) {
            PHASE_ENV();
            router_phase(lds, (const float*)(ws + WS_PRE), hbuf, in[22] + (size_t)l * D, in[23] + (size_t)l * D, (const bf16*)(wbase + W_RH), (const bf16*)(wbase + W_RL), in[25] + l * NE,
                         h1, h1b, ctl + CW_CNT + l * 64 * 16, (int*)(ws + WS_LTS), (float*)(ws + WS_LW), (int*)(ws + WS_TMAP), (int*)(ws + WS_WGCNT), G, bid, tid, ap->flags);
            GRID_BAR();
            router_lists(lds, (const int*)(ws + WS_WGCNT), ctl + CW_CNT + l * 64 * 16, (int*)(ws + WS_LTS), (float*)(ws + WS_LW), (int*)(ws + WS_TMAP), G, bid, tid);
        }
        SEAM(P + 7);
        if (IN(P + 8)) {
            PHASE_ENV();
            MoeSched<true> S; S.init(G, bid, ctl + CW_CNT + l * 64 * 16, (const int*)(ws + WS_LTS), wbase + W_UP, lane);
            EpiMoeUp E{ws + WS_HID};
            pg8::gemm_phase<EpiMoeUp, MoeSched<true>, true>(lds, (const char*)h1b, D, S, E, tid);
        }
        SEAM(P + 8);
        if (IN(P + 9)) {
            PHASE_ENV();
            MoeSched<false> S; S.init(G, bid, ctl + CW_CNT + l * 64 * 16, (const int*)(ws + WS_LTS), wbase + W_DN, lane);
            EpiMoeDown E{(bf16*)(ws + WS_Y)};
            pg8::gemm_phase<EpiMoeDown, MoeSched<false>, true>(lds, (const char*)(ws + WS_HID), EDIM, S, E, tid);
        }
        SEAM(P + 9);
        if (IN(P + 10)) {
            PHASE_ENV();
            const bool lastl = (l == DEPTH - 1);
            combine_phase((const bf16*)(ws + WS_Y), h1, (const int*)(ws + WS_TMAP), (const float*)(ws + WS_LW), ctl + CW_CNT + l * 64 * 16, in[32] + (size_t)l * D, in[33] + (size_t)l * D, lastl ? ap->out : hbuf, lastl ? nullptr : hb, lastl ? nullptr : ws + WS_HQ, gw, NGW, lane);
        }
        if (l + 1 < DEPTH) SEAM(P + 10);
    }
}
#undef IN
#undef SEAM
__global__ void __launch_bounds__(512, 2) fwd_kernel(Args args) {
    extern __shared__ __attribute__((aligned(16))) unsigned char lds_raw[];
    LAS unsigned char* lds = (LAS unsigned char*)lds_raw;
    const int tid0 = threadIdx.x;
    const int G = gridDim.x, bid0 = blockIdx.x, NGW = G * 8;
    ArgP ap0 = (ArgP)__builtin_amdgcn_kernarg_segment_ptr();
    volatile LAS unsigned* MISC = (volatile LAS unsigned*)(lds + MISC_OFF);
    if (tid0 < 16) MISC[tid0] = 0u;
    __syncthreads();
    XcdBarrier bar; bar.bar = (unsigned*)(ap0->ws + WS_CTL) + CW_BAR; bar.x = 0; bar.st = MISC;
#if MK_ONE
    bar = xcd_barrier_post((unsigned*)(ap0->ws + WS_CTL) + CW_BAR, MISC);
#endif
    const int lo = ap0->ph_lo, hi = ap0->ph_hi;
    const int wave0 = __builtin_amdgcn_readfirstlane(tid0 >> 6);
    layer_body<0>(lds, wave0, bid0, G, NGW, ap0, bar, lo, hi);
    layer_body<1>(lds, wave0, bid0, G, NGW, ap0, bar, lo, hi);
}


extern "C" void kernel_launch(void* const* d_in, const int* in_sizes, int n_in, void* d_out, int out_size, void* d_ws, size_t ws_size, hipStream_t stream) {
    static int grid = 0;
    if (grid == 0) {
        if (n_in != 34 || out_size != M * D || ws_size < WS_END) { fprintf(stderr, "kernel_launch: unexpected shapes (n_in %d out %d ws %zu)\n", n_in, out_size, ws_size); grid = -1; return; }
        int dev = 0, cus = 0, per_cu = 0;
        if (hipGetDevice(&dev) != hipSuccess || hipDeviceGetAttribute(&cus, hipDeviceAttributeMultiprocessorCount, dev) != hipSuccess) { grid = -1; return; }
        if (hipFuncSetAttribute((const void*)fwd_kernel, hipFuncAttributeMaxDynamicSharedMemorySize, LDS_BYTES) != hipSuccess) { fprintf(stderr, "kernel_launch: hipFuncSetAttribute failed\n"); grid = -1; return; }
        if (hipOccupancyMaxActiveBlocksPerMultiprocessor(&per_cu, (const void*)fwd_kernel, 512, LDS_BYTES) != hipSuccess || per_cu < 1)
            fprintf(stderr, "kernel_launch: occupancy query reports %d\n", per_cu);
        (void)hipGetLastError();
        grid = cus;
    }
    if (grid < 0) return;
    (void)hipMemsetAsync((char*)d_ws + WS_CTL, 0, CTL_BYTES, stream);
    Args a{};
    for (int i = 0; i < 34; ++i) a.in[i] = (const float*)d_in[i];
    a.out = (float*)d_out; a.ws = (unsigned char*)d_ws;
#if MK_ONE
    a.ph_lo = 0; a.ph_hi = DEPTH * NPH;
    hipLaunchKernelGGL(fwd_kernel, dim3(grid), dim3(512), LDS_BYTES, stream, a);
#ifdef PROBE_PHASE
    a.ph_lo = NPH + PROBE_PHASE; a.ph_hi = NPH + PROBE_PHASE + 1;
#ifdef PROBE_FLAGS
    a.flags = PROBE_FLAGS;
#endif
    hipLaunchKernelGGL(fwd_kernel, dim3(grid), dim3(512), LDS_BYTES, stream, a);
#endif
#else
    for (int p = 0; p < DEPTH * NPH; ++p) { a.ph_lo = p; a.ph_hi = p + 1; hipLaunchKernelGGL(fwd_kernel, dim3(grid), dim3(512), LDS_BYTES, stream, a); }
#endif
}
```

```cpp
#include <hip/hip_runtime.h>
#include <cstdio>
#include <cstdint>

#ifndef MK_ONE
#define MK_ONE 1
#endif

#define LAS __attribute__((address_space(3)))
typedef unsigned short bf16;
typedef short bf16x8 __attribute__((ext_vector_type(8)));
typedef float f32x4 __attribute__((ext_vector_type(4)));
typedef float f32x2 __attribute__((ext_vector_type(2)));
typedef unsigned u32x4 __attribute__((ext_vector_type(4)));
typedef unsigned u32x2 __attribute__((ext_vector_type(2)));
typedef int i32x8 __attribute__((ext_vector_type(8)));

constexpr int D = 2048, NBATCH = 8, T = 2048, M = NBATCH * T, DEPTH = 2;
constexpr int D_IN = 15888;
constexpr int LD = 16128;
constexpr int COL_G = 0, COL_Q = 6144, COL_K = 9216, COL_V = 10240, COL_LG = 11264, COL_Z = 12288, COL_LX = 13312, COL_XBC = 14336, COL_DT = 15872;
constexpr int N8 = LD;
constexpr int NE = 64, EDIM = 512, TOPK = 8;
constexpr float LN_EPS = 1e-5f, RMS_EPS = 1e-6f, ALPHA = 1.41421356237f;
constexpr int YLD = 3072;
constexpr int NPH = 11;

constexpr size_t MiB = 1u << 20;
constexpr size_t WS_CTL = 0, CTL_BYTES = 1 * MiB;
constexpr size_t WS_LTS = 2 * MiB, WS_LW = 6 * MiB;
constexpr size_t WS_ALAST = 10 * MiB;
constexpr size_t WS_LSE = 11 * MiB;
constexpr size_t WS_W = 16 * MiB;
constexpr size_t W_IN = 0, W_PL = 63 * MiB, W_PS = 67 * MiB, W_PA = 71 * MiB, W_OUT = 75 * MiB, W_LR = 83 * MiB, W_LI = W_LR + 262144, W_RH = W_LR + 524288, W_RL = W_RH + 262144, W_UP = 84 * MiB, W_IN8 = 216 * MiB, W_DN = 344 * MiB;
constexpr size_t WS_H = 490 * MiB, WS_HB = 618 * MiB, WS_H1 = 682 * MiB, WS_H1B = 810 * MiB;
constexpr size_t WS_PROJ = 874 * MiB;
constexpr size_t WS_PRE = WS_PROJ, WS_Y = WS_H1B;
constexpr size_t WS_TMAP = 13 * MiB;
constexpr size_t WS_WGCNT = 14 * MiB;
constexpr size_t WS_YL = 1450 * MiB, WS_YS = 1482 * MiB, WS_YA = 1514 * MiB, WS_OG = 1546 * MiB;
constexpr size_t WS_HID = WS_YL;
constexpr size_t WS_SST = 1644 * MiB;
constexpr size_t WS_SSTB = 1804 * MiB;
constexpr size_t WS_Q8 = 490 * MiB;
constexpr size_t WS_G8 = 1708 * MiB;
constexpr size_t WS_MF = 1708 * MiB, WS_MB = 1836 * MiB, WS_HQ = 1900 * MiB, WS_END = 1932 * MiB;
constexpr int CW_BAR = 4096;
constexpr int CW_CNT = 16384;

constexpr int LDS_BYTES = 147456;
constexpr int MISC_OFF = 147456 - 64;

#define LDS_WAIT() asm volatile("s_waitcnt lgkmcnt(0)" ::: "memory")
#define VM_WAIT() asm volatile("s_waitcnt vmcnt(0)" ::: "memory")
__device__ __forceinline__ float bf2f(unsigned v) { return __uint_as_float(v << 16); }
__device__ __forceinline__ float bflo(unsigned w) { return __uint_as_float(w << 16); }
__device__ __forceinline__ float bfhi(unsigned w) { return __uint_as_float(w & 0xffff0000u); }
__device__ __forceinline__ unsigned pk2(float lo, float hi) { unsigned r; asm volatile("v_cvt_pk_bf16_f32 %0, %1, %2" : "=v"(r) : "v"(lo), "v"(hi)); return r; }
__device__ __forceinline__ unsigned pk4_fp8(float a, float b, float c, float d) { int r = __builtin_amdgcn_cvt_pk_fp8_f32(a, b, 0, false); r = __builtin_amdgcn_cvt_pk_fp8_f32(c, d, r, true); return (unsigned)r; }
__device__ __forceinline__ u32x4 pack8(const float (&v)[8]) { u32x4 o; o.x = pk2(v[0], v[1]); o.y = pk2(v[2], v[3]); o.z = pk2(v[4], v[5]); o.w = pk2(v[6], v[7]); return o; }
template <int N> __device__ __forceinline__ float row_shr(float old, float v) {
    return __int_as_float(__builtin_amdgcn_update_dpp(__float_as_int(old), __float_as_int(v), 0x110 + N, 0xf, 0xf, false)); }
__device__ __forceinline__ void st16_wt(void* p, u32x4 v) { asm volatile("global_store_dwordx4 %0, %1, off sc0 sc1\n\ts_nop 1" :: "v"(p), "v"(v) : "memory"); }
__device__ __forceinline__ void st8_wt(void* p, u32x2 v) { asm volatile("global_store_dwordx2 %0, %1, off sc0 sc1" :: "v"(p), "v"(v) : "memory"); }
__device__ __forceinline__ float sigmoidf_(float x) { return __builtin_amdgcn_rcpf(1.0f + __expf(-x)); }
__device__ __forceinline__ float siluf_(float x) { return x * sigmoidf_(x); }
__device__ __forceinline__ float softplusf_(float x) { return x > 20.f ? x : log1pf(__expf(x)); }
__device__ __forceinline__ float gelu_tanh(float x) { const float u = 0.7978845608f * (x + 0.044715f * x * x * x); const float t = 1.0f - 2.0f * __builtin_amdgcn_rcpf(1.0f + __expf(2.0f * u)); return 0.5f * x * (1.0f + t); }
__device__ __forceinline__ float wave_sum(float v) {
#pragma unroll
    for (int o = 1; o < 64; o <<= 1) v += __shfl_xor(v, o);
    return v;
}
__device__ __forceinline__ bf16x8 as_bf16x8(u32x4 v) { return __builtin_bit_cast(bf16x8, v); }
__device__ __forceinline__ void tr_read2(unsigned a0, unsigned a1, u32x2& r0, u32x2& r1) {
    asm volatile("ds_read_b64_tr_b16 %0, %2\n\tds_read_b64_tr_b16 %1, %3\n\ts_waitcnt lgkmcnt(0)" : "=&v"(r0), "=&v"(r1) : "v"(a0), "v"(a1) : "memory");
}

__device__ __forceinline__ void tr_issue16(unsigned a0, unsigned a1, u32x2 (&lo)[8], u32x2 (&hi)[8]) {
    asm volatile("ds_read_b64_tr_b16 %0, %16\n\tds_read_b64_tr_b16 %8, %17\n\t"
                 "ds_read_b64_tr_b16 %1, %16 offset:32\n\tds_read_b64_tr_b16 %9, %17 offset:32\n\t"
                 "ds_read_b64_tr_b16 %2, %16 offset:64\n\tds_read_b64_tr_b16 %10, %17 offset:64\n\t"
                 "ds_read_b64_tr_b16 %3, %16 offset:96\n\tds_read_b64_tr_b16 %11, %17 offset:96\n\t"
                 "ds_read_b64_tr_b16 %4, %16 offset:128\n\tds_read_b64_tr_b16 %12, %17 offset:128\n\t"
                 "ds_read_b64_tr_b16 %5, %16 offset:160\n\tds_read_b64_tr_b16 %13, %17 offset:160\n\t"
                 "ds_read_b64_tr_b16 %6, %16 offset:192\n\tds_read_b64_tr_b16 %14, %17 offset:192\n\t"
                 "ds_read_b64_tr_b16 %7, %16 offset:224\n\tds_read_b64_tr_b16 %15, %17 offset:224"
                 : "=&v"(lo[0]), "=&v"(lo[1]), "=&v"(lo[2]), "=&v"(lo[3]), "=&v"(lo[4]), "=&v"(lo[5]), "=&v"(lo[6]), "=&v"(lo[7]),
                   "=&v"(hi[0]), "=&v"(hi[1]), "=&v"(hi[2]), "=&v"(hi[3]), "=&v"(hi[4]), "=&v"(hi[5]), "=&v"(hi[6]), "=&v"(hi[7])
                 : "v"(a0), "v"(a1) : "memory");
}
__device__ __forceinline__ void tr_wait16(u32x2 (&lo)[8], u32x2 (&hi)[8]) {
    asm volatile("s_waitcnt lgkmcnt(0)" : "+v"(lo[0]), "+v"(lo[1]), "+v"(lo[2]), "+v"(lo[3]), "+v"(lo[4]), "+v"(lo[5]), "+v"(lo[6]), "+v"(lo[7]),
                   "+v"(hi[0]), "+v"(hi[1]), "+v"(hi[2]), "+v"(hi[3]), "+v"(hi[4]), "+v"(hi[5]), "+v"(hi[6]), "+v"(hi[7]) :: "memory");
}
__device__ __forceinline__ void tr_read16(unsigned a0, unsigned a1, u32x2 (&lo)[8], u32x2 (&hi)[8]) {
    asm volatile("ds_read_b64_tr_b16 %0, %16\n\tds_read_b64_tr_b16 %8, %17\n\t"
                 "ds_read_b64_tr_b16 %1, %16 offset:32\n\tds_read_b64_tr_b16 %9, %17 offset:32\n\t"
                 "ds_read_b64_tr_b16 %2, %16 offset:64\n\tds_read_b64_tr_b16 %10, %17 offset:64\n\t"
                 "ds_read_b64_tr_b16 %3, %16 offset:96\n\tds_read_b64_tr_b16 %11, %17 offset:96\n\t"
                 "ds_read_b64_tr_b16 %4, %16 offset:128\n\tds_read_b64_tr_b16 %12, %17 offset:128\n\t"
                 "ds_read_b64_tr_b16 %5, %16 offset:160\n\tds_read_b64_tr_b16 %13, %17 offset:160\n\t"
                 "ds_read_b64_tr_b16 %6, %16 offset:192\n\tds_read_b64_tr_b16 %14, %17 offset:192\n\t"
                 "ds_read_b64_tr_b16 %7, %16 offset:224\n\tds_read_b64_tr_b16 %15, %17 offset:224\n\t"
                 "s_waitcnt lgkmcnt(0)"
                 : "=&v"(lo[0]), "=&v"(lo[1]), "=&v"(lo[2]), "=&v"(lo[3]), "=&v"(lo[4]), "=&v"(lo[5]), "=&v"(lo[6]), "=&v"(lo[7]),
                   "=&v"(hi[0]), "=&v"(hi[1]), "=&v"(hi[2]), "=&v"(hi[3]), "=&v"(hi[4]), "=&v"(hi[5]), "=&v"(hi[6]), "=&v"(hi[7])
                 : "v"(a0), "v"(a1) : "memory");
}
namespace pg8 {
struct Pair8 { bf16x8 a, b; };
__device__ __forceinline__ i32x8 cat8(bf16x8 lo, bf16x8 hi) { return __builtin_bit_cast(i32x8, Pair8{lo, hi}); }
constexpr int BM = 256, BK = 64, HALF = 128, HTB = HALF * BK * 2, STAGE_BYTES = 8 * HTB;
__device__ __forceinline__ int lds_byte(int r, int c) { const int st = (r >> 4) * 2 + (c >> 5), rr = r & 15, cc = c & 31, ob = rr * 64 + cc * 2; return st * 1024 + (ob ^ (((ob >> 9) & 1) << 5)); }
__device__ __forceinline__ void stage_rc(int b, int& R, int& C) { const int st = b / 1024, sb = b % 1024, swz = sb ^ (((sb >> 9) & 1) << 5); R = (st >> 1) * 16 + swz / 64; C = (st & 1) * 32 + (swz % 64) / 2; }
__device__ __forceinline__ int perm32(int rho) { const int n = rho >> 4, i = rho & 15; return 8 * (i >> 2) + 4 * n + (i & 3); }

template <class Epi, class Sched, bool FP8 = false>
__device__ __forceinline__ void gemm_phase(LAS unsigned char* lds, const char* Abase, const int K, const Sched& S, const Epi& E, const int tid) {
    const int wid = __builtin_amdgcn_readfirstlane(tid >> 6), lane = tid & 63, wr = wid >> 2, wc = wid & 3, fr = lane & 15, fq = lane >> 4;
    const int rowb = FP8 ? K : 2 * K, nt = rowb / 128;
    unsigned voffB[2];
#pragma unroll
    for (int i = 0; i < 2; ++i) { int R, C; stage_rc(tid * 16 + i * 8192, R, C); const int Rb = Epi::PERM == 2 ? (64 * (R >> 5) + 16 * ((R & 15) >> 2) + 4 * ((R >> 4) & 1) + (R & 3)) : Epi::PERM == 1 ? ((R & ~31) + perm32(R & 31)) : R; voffB[i] = (unsigned)(Rb * rowb + C * 2); }
    const size_t kstep = (size_t)(BK * 2);
    const size_t hstep = (size_t)(Epi::PERM == 2 ? 8 : HALF) * rowb;
    const unsigned ldsw = (unsigned)wid * 1024u;
    const int aoff = lds_byte(wr * 64 + fr, fq * 8), boff = lds_byte(wc * 32 + fr, fq * 8);
#define PG8_SA(b, h) (((b) * 2 + (h)) * HTB)
#define PG8_SB(b, h) ((4 + (b) * 2 + (h)) * HTB)
#define PG8_STAGE(bufoff, gbase, voff) do { _Pragma("unroll") for (int _i = 0; _i < 2; ++_i) \
        __builtin_amdgcn_global_load_lds((const unsigned*)((const char*)(gbase) + (voff)[_i]), (LAS unsigned*)(lds + (bufoff) + ldsw + _i * 8192), 16, 0, 0); } while (0)
#define PG8_LDA(dst, b, h) do { _Pragma("unroll") for (int m = 0; m < 4; ++m) _Pragma("unroll") for (int k = 0; k < 2; ++k) dst[m][k] = *(const LAS bf16x8*)(lds + PG8_SA(b, h) + aoff + m * 2048 + k * 1024); } while (0)
#define PG8_LDB(dst, b, h) do { _Pragma("unroll") for (int n = 0; n < 2; ++n) _Pragma("unroll") for (int k = 0; k < 2; ++k) dst[n][k] = *(const LAS bf16x8*)(lds + PG8_SB(b, h) + boff + n * 2048 + k * 1024); } while (0)
#define PG8_MMA(ai, bj, At, Bt) do { __builtin_amdgcn_s_setprio(1); _Pragma("unroll") for (int m = 0; m < 4; ++m) _Pragma("unroll") for (int n = 0; n < 2; ++n) { \
        if constexpr (FP8) acc[ai][bj][m][n] = __builtin_amdgcn_mfma_scale_f32_16x16x128_f8f6f4(cat8(Bt[n][0], Bt[n][1]), cat8(At[m][0], At[m][1]), acc[ai][bj][m][n], 0, 0, 0, 0, 0, 0); \
        else { _Pragma("unroll") for (int k = 0; k < 2; ++k) acc[ai][bj][m][n] = __builtin_amdgcn_mfma_f32_16x16x32_bf16(Bt[n][k], At[m][k], acc[ai][bj][m][n], 0, 0, 0); } } __builtin_amdgcn_s_setprio(0); } while (0)
#define PG8_WAIT_V(n) asm volatile("s_waitcnt vmcnt(" #n ")" ::: "memory")
#define PG8_WAIT_L(n) asm volatile("s_waitcnt lgkmcnt(" #n ")" ::: "memory")
#define PG8_BAR __builtin_amdgcn_s_barrier()
#define PG8_SCHED __builtin_amdgcn_sched_barrier(0)
    typename Sched::Unit cur, nxt; int ui = 0;
    if (!S.next(0, cur)) return;
    f32x4 acc[2][2][4][2];
#pragma unroll
    for (int a = 0; a < 2; ++a)
#pragma unroll
        for (int b = 0; b < 2; ++b)
#pragma unroll
            for (int m = 0; m < 4; ++m)
#pragma unroll
                for (int n = 0; n < 2; ++n) acc[a][b][m][n] = (f32x4){0.f, 0.f, 0.f, 0.f};
    bf16x8 At[4][2], B0[2][2], B1[2][2];
    unsigned oc[2][2];
    S.aoffs(cur, tid, oc);
    const char* cB = S.bptr(cur);
    PG8_STAGE(PG8_SB(0, 0), cB, voffB); PG8_STAGE(PG8_SA(0, 0), Abase, oc[0]); PG8_STAGE(PG8_SB(0, 1), cB + hstep, voffB); PG8_STAGE(PG8_SA(0, 1), Abase, oc[1]);
    if (wr == 1) PG8_BAR;
    PG8_WAIT_V(4); PG8_BAR;
    PG8_STAGE(PG8_SB(1, 0), cB + kstep, voffB); PG8_STAGE(PG8_SA(1, 0), Abase + kstep, oc[0]); PG8_STAGE(PG8_SB(1, 1), cB + hstep + kstep, voffB);
    PG8_WAIT_V(6); PG8_BAR;
    for (;;) {
        const bool has_next = S.next(ui + 1, nxt);
        const char* nB = has_next ? S.bptr(nxt) : cB;
#pragma unroll 1
        for (int t = 0; t < nt; t += 2) {
            const bool last = (t == nt - 2);
            if constexpr (Epi::MID > 0) { if (t > 0 && (t % Epi::MID) == 0) E.mid(acc, cur, t / Epi::MID, wr, wc, fr, fq); }
            const char* a1 = Abase + (size_t)(t + 1) * kstep;
            const char* a2 = last ? Abase : Abase + (size_t)(t + 2) * kstep; const char* b2 = last ? nB : cB + (size_t)(t + 2) * kstep;
            const char* a3 = a2 + kstep; const char* b3 = b2 + kstep;
            PG8_LDB(B0, 0, 0); PG8_SCHED; PG8_LDA(At, 0, 0); PG8_STAGE(PG8_SA(1, 1), a1, oc[1]);
            PG8_WAIT_L(8); PG8_BAR; PG8_WAIT_L(0); PG8_MMA(0, 0, At, B0); PG8_BAR; PG8_SCHED;
            if (last && has_next) S.aoffs(nxt, tid, oc);
            PG8_LDB(B1, 0, 1); PG8_STAGE(PG8_SB(0, 0), b2, voffB);
            PG8_BAR; PG8_WAIT_L(0); PG8_MMA(0, 1, At, B1); PG8_BAR;
            PG8_LDA(At, 0, 1); PG8_STAGE(PG8_SA(0, 0), a2, oc[0]);
            PG8_BAR; PG8_WAIT_L(0); PG8_MMA(1, 0, At, B0); PG8_BAR; PG8_SCHED;
            PG8_STAGE(PG8_SB(0, 1), b2 + hstep, voffB);
            PG8_WAIT_V(6); PG8_BAR; PG8_MMA(1, 1, At, B1); PG8_BAR;
            PG8_LDB(B0, 1, 0); PG8_SCHED; PG8_LDA(At, 1, 0); PG8_STAGE(PG8_SA(0, 1), a2, oc[1]);
            PG8_WAIT_L(8); PG8_BAR; PG8_WAIT_L(0); PG8_MMA(0, 0, At, B0); PG8_BAR; PG8_SCHED;
            PG8_LDB(B1, 1, 1); PG8_STAGE(PG8_SB(1, 0), b3, voffB);
            PG8_BAR; PG8_WAIT_L(0); PG8_MMA(0, 1, At, B1); PG8_BAR;
            PG8_LDA(At, 1, 1); PG8_STAGE(PG8_SA(1, 0), a3, oc[0]);
            PG8_BAR; PG8_WAIT_L(0); PG8_MMA(1, 0, At, B0); PG8_BAR; PG8_SCHED;
            PG8_STAGE(PG8_SB(1, 1), b3 + hstep, voffB);
            PG8_WAIT_V(6); PG8_BAR; PG8_MMA(1, 1, At, B1); PG8_BAR;
        }
        if (wr == 0) PG8_BAR;
        if constexpr (FP8) {
#pragma unroll
            for (int a = 0; a < 2; ++a)
#pragma unroll
                for (int b = 0; b < 2; ++b)
#pragma unroll
                    for (int m = 0; m < 4; ++m)
#pragma unroll
                        for (int n = 0; n < 2; ++n) acc[a][b][m][n] *= 0.03125f;
        }
        E(acc, cur, wr, wc, fr, fq);
        if (!has_next) break;
#pragma unroll
        for (int a = 0; a < 2; ++a)
#pragma unroll
            for (int b = 0; b < 2; ++b)
#pragma unroll
                for (int m = 0; m < 4; ++m)
#pragma unroll
                    for (int n = 0; n < 2; ++n) acc[a][b][m][n] = (f32x4){0.f, 0.f, 0.f, 0.f};
        cur = nxt; cB = nB; ++ui;
        if (wr == 1) PG8_BAR;
    }
    PG8_WAIT_V(0);
    PG8_BAR;
#undef PG8_SA
#undef PG8_SB
#undef PG8_STAGE
#undef PG8_LDA
#undef PG8_LDB
#undef PG8_MMA
#undef PG8_WAIT_V
#undef PG8_WAIT_L
#undef PG8_BAR
#undef PG8_SCHED
}
}

struct DenseUnit { int pm, pn; };
template <bool F8 = false> struct DenseSchedT {
    typedef DenseUnit Unit;
    int nM, nN, nwg, G, c, K; const char* Bt;
    __device__ __forceinline__ void init(int M_, int N_, int K_, int G_, int c_, const void* Bt_) { nM = M_ / 256; nN = N_ / 256; nwg = nM * nN; G = G_; c = c_; K = K_; Bt = (const char*)Bt_; }
    __device__ __forceinline__ bool next(int i, Unit& u) const {
        const long L = (long)i * G + c; if (L >= nwg) return false;
        int wgid = (int)L; { const int q = nwg / 8, r = nwg % 8, xcd = wgid % 8, off = wgid / 8; wgid = (xcd < r ? xcd * (q + 1) : r * (q + 1) + (xcd - r) * q) + off; }
        const int nig = 8 * nN, gid = wgid / nig, fm = gid * 8, gsz = (nM - fm) < 8 ? (nM - fm) : 8;
        u.pm = fm + ((wgid % nig) % gsz); u.pn = (wgid % nig) / gsz; return true;
    }
    __device__ __forceinline__ const char* bptr(const Unit& u) const { return Bt + (size_t)u.pn * 256 * K * (F8 ? 1 : 2); }
    __device__ __forceinline__ void aoffs(const Unit& u, int tid, unsigned (&o)[2][2]) const {
#pragma unroll
        for (int i = 0; i < 2; ++i) { int R, C; pg8::stage_rc(tid * 16 + i * 8192, R, C);
#pragma unroll
            for (int h = 0; h < 2; ++h) o[h][i] = F8 ? (unsigned)((u.pm * 256 + 128 * h + R) * K + C * 2) : (unsigned)((u.pm * 256 + 128 * h + R) * K + C) * 2u; }
    }
};
typedef DenseSchedT<false> DenseSched;
struct MoeUnit { int e, rb, pn, nvalid, blk; };
template <bool UP> struct MoeSched {
    typedef MoeUnit Unit;
    int x, w, W, nunits, NBr; int pe[9]; int pend, cntl;
    int sbx, sbase;
    const int* lts; const char* Wt;
    static constexpr int NPN = UP ? 4 : 8, BPG = 32 / NPN;
    __device__ __forceinline__ void init(int G_, int bid, const unsigned* cnt, const int* lts_, const void* W_, int lane) {
        x = bid & 7; w = bid >> 3; W = (G_ - x + 7) >> 3; lts = lts_; Wt = (const char*)W_;
        cntl = (int)cnt[lane * 16]; const int nb = (cntl + 255) >> 8; int s = nb;
#pragma unroll
        for (int o = 1; o < 64; o <<= 1) { const int t = __shfl_up(s, o); if (lane >= o) s += t; }
        pend = s; NBr = __builtin_amdgcn_readlane(s, 63);
        pe[0] = 0;
#pragma unroll
        for (int k = 0; k < 8; ++k) pe[k + 1] = pe[k] + __builtin_amdgcn_readlane(nb, x + 8 * k);
        int R[8];
#pragma unroll
        for (int y = 0; y < 8; ++y) { int t = 0;
#pragma unroll
            for (int k = 0; k < 8; ++k) t += __builtin_amdgcn_readlane(nb, y + 8 * k);
            R[y] = t; }
        int L = (NBr + 64) / 8 + 1, fill;
        for (;;) { fill = 0;
#pragma unroll
            for (int y = 0; y < 8; ++y) fill += (L > R[y]) ? (L - R[y]) : 0;
            if (fill <= 64 || L == 0) break; --L; }
        int rem = 64 - fill, base = 0; sbx = 0; sbase = 0;
#pragma unroll
        for (int y = 0; y < 8; ++y) { int sy = (L > R[y]) ? (L - R[y]) : 0; if (rem > 0 && R[y] <= L) { ++sy; --rem; } if (y == 7) sy += rem;
            if (y == x) { sbx = sy; sbase = base; } base += sy; }
        nunits = (pe[8] + sbx) * NPN;
    }
    __device__ __forceinline__ bool next(int i, Unit& u) const {
        const int j = i * W + w; if (j >= nunits) return false;
        const int Bx = pe[8] + sbx, FG = Bx / BPG; int bi;
        if (j < FG * 32) { bi = (j >> 5) * BPG + (j & 31) / NPN; u.pn = j % NPN; }
        else { const int j2 = j - FG * 32; bi = FG * BPG + j2 / NPN; u.pn = j2 % NPN; }
        if (bi < pe[8]) {
            int k = 0, st = 0;
#pragma unroll
            for (int q = 1; q < 8; ++q) if (bi >= pe[q]) { k = q; st = pe[q]; }
            const int e = x + 8 * k;
            const int base = e ? __builtin_amdgcn_readlane(pend, e - 1) : 0;
            const int ce = __builtin_amdgcn_readlane(cntl, e);
            u.e = e; u.rb = bi - st; u.blk = base + u.rb; const int rem = ce - u.rb * 256; u.nvalid = rem < 256 ? rem : 256;
        } else { u.e = 64; u.rb = sbase + (bi - pe[8]); u.blk = NBr + u.rb; u.nvalid = 256; }
        return true;
    }
    __device__ __forceinline__ const char* bptr(const Unit& u) const {
        return UP ? Wt + ((size_t)u.e * 1024 + (size_t)u.pn * 256) * 2048 : Wt + ((size_t)u.e * 2048 + (size_t)u.pn * 256) * 512;
    }
    __device__ __forceinline__ void aoffs(const Unit& u, int tid, unsigned (&o)[2][2]) const {
#pragma unroll
        for (int i = 0; i < 2; ++i) { int R, C; pg8::stage_rc(tid * 16 + i * 8192, R, C);
#pragma unroll
            for (int h = 0; h < 2; ++h) {
                const int r = 128 * h + R;
                if (UP) {
                    int tok;
                    if (u.e < 64) { tok = 0; if (r < u.nvalid) tok = lts[u.e * 16384 + u.rb * 256 + r] >> 4; }
                    else tok = u.rb * 256 + r;
                    o[h][i] = (unsigned)(tok * 2048 + C * 2);
                } else o[h][i] = (unsigned)((u.blk * 256 + r) * 512 + C * 2);
            } }
    }
};

struct EpiStoreBf16 {
    static constexpr int PERM = 1, MID = 0;
    bf16* O; int ldc; int coff;
    __device__ __forceinline__ void operator()(const f32x4 (&acc)[2][2][4][2], const DenseUnit& u, int wr, int wc, int fr, int fq) const {
        const int row0 = u.pm * 256 + wr * 64 + fr, col0 = coff + u.pn * 256 + wc * 32 + 8 * fq;
#pragma unroll
        for (int ai = 0; ai < 2; ++ai)
#pragma unroll
            for (int m = 0; m < 4; ++m) { bf16* rowp = O + (size_t)(row0 + ai * 128 + m * 16) * ldc + col0;
#pragma unroll
                for (int bj = 0; bj < 2; ++bj) { const f32x4 v0 = acc[ai][bj][m][0], v1 = acc[ai][bj][m][1];
                    u32x4 w; w.x = pk2(v0[0], v0[1]); w.y = pk2(v0[2], v0[3]); w.z = pk2(v1[0], v1[1]); w.w = pk2(v1[2], v1[3]);
                    st16_wt(rowp + bj * 128, w); } }
    }
};
struct EpiStoreF8 {
    static constexpr int PERM = 2, MID = 0;
    unsigned char* Gd; unsigned char* Qd;
    __device__ __forceinline__ void operator()(const f32x4 (&acc)[2][2][4][2], const DenseUnit& u, int wr, int wc, int fr, int fq) const {
        const bool isq = u.pn >= 24;
        unsigned char* O = isq ? Qd : Gd; const int ldc = isq ? 5120 : 6144;
        const int row0 = u.pm * 256 + wr * 64 + fr, col0 = (isq ? u.pn - 24 : u.pn) * 256 + wc * 64 + 16 * fq;
#pragma unroll
        for (int ai = 0; ai < 2; ++ai)
#pragma unroll
            for (int m = 0; m < 4; ++m) { const f32x4 v0 = acc[ai][0][m][0], v1 = acc[ai][0][m][1], v2 = acc[ai][1][m][0], v3 = acc[ai][1][m][1];
                u32x4 o; o.x = pk4_fp8(v0[0], v0[1], v0[2], v0[3]); o.y = pk4_fp8(v1[0], v1[1], v1[2], v1[3]); o.z = pk4_fp8(v2[0], v2[1], v2[2], v2[3]); o.w = pk4_fp8(v3[0], v3[1], v3[2], v3[3]);
                st16_wt(O + (size_t)(row0 + ai * 128 + m * 16) * ldc + col0, o); }
    }
};
template <int MODE> struct EpiGate {
    static constexpr int PERM = 1, MID = 0;
    const bf16* proj; const float* bg; bf16* mb; int gcol;
    __device__ __forceinline__ void operator()(const f32x4 (&acc)[2][2][4][2], const DenseUnit& u, int wr, int wc, int fr, int fq) const {
        const int row0 = u.pm * 256 + wr * 64 + fr, col0 = u.pn * 256 + wc * 32 + 8 * fq;
        f32x4 bv[2][2];
#pragma unroll
        for (int bj = 0; bj < 2; ++bj) { bv[bj][0] = *(const f32x4*)(bg + gcol + col0 + bj * 128); bv[bj][1] = *(const f32x4*)(bg + gcol + col0 + bj * 128 + 4); }
#pragma unroll
        for (int ai = 0; ai < 2; ++ai)
#pragma unroll
            for (int mh = 0; mh < 2; ++mh) {
                u32x4 gr[2][2], pm[2][2];
#pragma unroll
                for (int mm = 0; mm < 2; ++mm) { const size_t row = (size_t)(row0 + ai * 128 + (2 * mh + mm) * 16);
#pragma unroll
                    for (int bj = 0; bj < 2; ++bj) { gr[mm][bj] = *(const u32x4*)(proj + row * LD + COL_G + gcol + col0 + bj * 128);
                        if (MODE >= 1) pm[mm][bj] = *(const u32x4*)(mb + row * D + col0 + bj * 128); } }
#pragma unroll
                for (int mm = 0; mm < 2; ++mm) { const int m = 2 * mh + mm; const size_t row = (size_t)(row0 + ai * 128 + m * 16);
#pragma unroll
                    for (int bj = 0; bj < 2; ++bj) { const u32x4 g = gr[mm][bj];
                        f32x4 g0, g1;
                        g0[0] = sigmoidf_(bflo(g.x) + bv[bj][0][0]); g0[1] = sigmoidf_(bfhi(g.x) + bv[bj][0][1]); g0[2] = sigmoidf_(bflo(g.y) + bv[bj][0][2]); g0[3] = sigmoidf_(bfhi(g.y) + bv[bj][0][3]);
                        g1[0] = sigmoidf_(bflo(g.z) + bv[bj][1][0]); g1[1] = sigmoidf_(bfhi(g.z) + bv[bj][1][1]); g1[2] = sigmoidf_(bflo(g.w) + bv[bj][1][2]); g1[3] = sigmoidf_(bfhi(g.w) + bv[bj][1][3]);
                        f32x4 v0 = acc[ai][bj][m][0] * g0, v1 = acc[ai][bj][m][1] * g1;
                        if (MODE >= 1) { const u32x4 p = pm[mm][bj]; v0[0] += bflo(p.x); v0[1] += bfhi(p.x); v0[2] += bflo(p.y); v0[3] += bfhi(p.y); v1[0] += bflo(p.z); v1[1] += bfhi(p.z); v1[2] += bflo(p.w); v1[3] += bfhi(p.w); }
                        u32x4 w; w.x = pk2(v0[0], v0[1]); w.y = pk2(v0[2], v0[3]); w.z = pk2(v1[0], v1[1]); w.w = pk2(v1[2], v1[3]); *(u32x4*)(mb + row * D + col0 + bj * 128) = w;
                    } }
                asm volatile("" ::: "memory"); }
    }
};
struct EpiGate3 {
    static constexpr int PERM = 2, MID = 16;
    const unsigned char* g8; const float* bg; bf16* mb;
    static __device__ __forceinline__ float rat(float a, float b) { return (1.0f + __builtin_amdgcn_exp2f(b * -1.44269504f)) * __builtin_amdgcn_rcpf(1.0f + __builtin_amdgcn_exp2f(a * -1.44269504f)); }
    __device__ __forceinline__ void mid(f32x4 (&acc)[2][2][4][2], const DenseUnit& u, int s, int wr, int wc, int fr, int fq) const {
        const int row0 = u.pm * 256 + wr * 64 + fr, col0 = u.pn * 256 + wc * 64 + 16 * fq;
        const unsigned char* pa = g8 + (s - 1) * 2048 + col0; const float* ba = bg + (s - 1) * 2048 + col0;
#pragma unroll
        for (int ai = 0; ai < 2; ++ai) {
            u32x4 ga[4], gb[4];
#pragma unroll
            for (int m = 0; m < 4; ++m) { const size_t row = (size_t)(row0 + ai * 128 + m * 16); ga[m] = *(const u32x4*)(pa + row * 6144); gb[m] = *(const u32x4*)(pa + row * 6144 + 2048); }
#pragma unroll
            for (int q = 0; q < 4; ++q) {
                const f32x4 a = *(const f32x4*)(ba + 4 * q), b = *(const f32x4*)(ba + 2048 + 4 * q);
#pragma unroll
                for (int m = 0; m < 4; ++m) { const int pw = (int)ga[m][q], qw = (int)gb[m][q];
                    const f32x2 p0 = __builtin_amdgcn_cvt_pk_f32_fp8(pw, false), p1 = __builtin_amdgcn_cvt_pk_f32_fp8(pw, true), q0 = __builtin_amdgcn_cvt_pk_f32_fp8(qw, false), q1 = __builtin_amdgcn_cvt_pk_f32_fp8(qw, true);
                    f32x4 r; r[0] = rat(p0[0] + a[0], q0[0] + b[0]); r[1] = rat(p0[1] + a[1], q0[1] + b[1]); r[2] = rat(p1[0] + a[2], q1[0] + b[2]); r[3] = rat(p1[1] + a[3], q1[1] + b[3]);
                    acc[ai][q >> 1][m][q & 1] *= r; } }
            asm volatile("" ::: "memory"); }
    }
    __device__ __forceinline__ void operator()(const f32x4 (&acc)[2][2][4][2], const DenseUnit& u, int wr, int wc, int fr, int fq) const {
        const int row0 = u.pm * 256 + wr * 64 + fr, col0 = u.pn * 256 + wc * 64 + 16 * fq;
        const unsigned char* pa = g8 + 4096 + col0; const float* ba = bg + 4096 + col0;
#pragma unroll
        for (int ai = 0; ai < 2; ++ai) {
            u32x4 ga[4];
#pragma unroll
            for (int m = 0; m < 4; ++m) ga[m] = *(const u32x4*)(pa + (size_t)(row0 + ai * 128 + m * 16) * 6144);
#pragma unroll
            for (int m = 0; m < 4; ++m) { u32x4 w[2];
#pragma unroll
                for (int q = 0; q < 4; ++q) { const f32x4 a = *(const f32x4*)(ba + 4 * q); const int pw = (int)ga[m][q];
                    const f32x2 p0 = __builtin_amdgcn_cvt_pk_f32_fp8(pw, false), p1 = __builtin_amdgcn_cvt_pk_f32_fp8(pw, true); const f32x4 v = acc[ai][q >> 1][m][q & 1];
                    w[q >> 1][2 * (q & 1)] = pk2(v[0] * sigmoidf_(p0[0] + a[0]), v[1] * sigmoidf_(p0[1] + a[1])); w[q >> 1][2 * (q & 1) + 1] = pk2(v[2] * sigmoidf_(p1[0] + a[2]), v[3] * sigmoidf_(p1[1] + a[3])); }
                bf16* op = mb + (size_t)(row0 + ai * 128 + m * 16) * D + col0; *(u32x4*)op = w[0]; *(u32x4*)(op + 8) = w[1]; }
            asm volatile("" ::: "memory"); }
    }
};
template <bool HB> struct EpiResid {
    static constexpr int PERM = 1, MID = 0, DEFER = 0;
    const void* h; bf16* pre;
    __device__ __forceinline__ void operator()(const f32x4 (&acc)[2][2][4][2], const DenseUnit& u, int wr, int wc, int fr, int fq) const {
        const int row0 = u.pm * 256 + wr * 64 + fr, col0 = u.pn * 256 + wc * 32 + 8 * fq;
#pragma unroll
        for (int ai = 0; ai < 2; ++ai)
#pragma unroll
            for (int mh = 0; mh < 2; ++mh) { u32x4 hv[2][2]; f32x4 hf[2][2][2];
#pragma unroll
                for (int mm = 0; mm < 2; ++mm) { const size_t off = (size_t)(row0 + ai * 128 + (2 * mh + mm) * 16) * D + col0;
#pragma unroll
                    for (int bj = 0; bj < 2; ++bj) { if (HB) hv[mm][bj] = *(const u32x4*)((const bf16*)h + off + bj * 128);
                        else { hf[mm][bj][0] = *(const f32x4*)((const float*)h + off + bj * 128); hf[mm][bj][1] = *(const f32x4*)((const float*)h + off + bj * 128 + 4); } } }
#pragma unroll
                for (int mm = 0; mm < 2; ++mm) { const int m = 2 * mh + mm; const size_t off = (size_t)(row0 + ai * 128 + m * 16) * D + col0;
#pragma unroll
                    for (int bj = 0; bj < 2; ++bj) { f32x4 h0, h1v;
                        if (HB) { const u32x4 p = hv[mm][bj]; h0[0] = bflo(p.x); h0[1] = bfhi(p.x); h0[2] = bflo(p.y); h0[3] = bfhi(p.y); h1v[0] = bflo(p.z); h1v[1] = bfhi(p.z); h1v[2] = bflo(p.w); h1v[3] = bfhi(p.w); }
                        else { h0 = hf[mm][bj][0]; h1v = hf[mm][bj][1]; }
                        const f32x4 v0 = h0 * ALPHA + acc[ai][bj][m][0], v1 = h1v * ALPHA + acc[ai][bj][m][1];
                        u32x4 w; w.x = pk2(v0[0], v0[1]); w.y = pk2(v0[2], v0[3]); w.z = pk2(v1[0], v1[1]); w.w = pk2(v1[2], v1[3]);
                        st16_wt(pre + off + bj * 128, w); } }
                asm volatile("" ::: "memory"); }
    }
};
struct EpiMoeUp {
    static constexpr int PERM = 1, MID = 0;
    unsigned char* H;
    __device__ __forceinline__ void operator()(const f32x4 (&acc)[2][2][4][2], const MoeUnit& u, int wr, int wc, int fr, int fq) const {
        const int row0 = u.blk * 256 + wr * 64 + fr, col0 = u.pn * 128 + wc * 32 + 8 * fq;
#pragma unroll
        for (int ai = 0; ai < 2; ++ai)
#pragma unroll
            for (int m = 0; m < 4; ++m) {
                const f32x4 g0 = acc[ai][0][m][0], g1 = acc[ai][0][m][1], u0 = acc[ai][1][m][0], u1 = acc[ai][1][m][1];
                u32x2 w; w.x = pk4_fp8(siluf_(g0[0]) * u0[0], siluf_(g0[1]) * u0[1], siluf_(g0[2]) * u0[2], siluf_(g0[3]) * u0[3]);
                w.y = pk4_fp8(siluf_(g1[0]) * u1[0], siluf_(g1[1]) * u1[1], siluf_(g1[2]) * u1[2], siluf_(g1[3]) * u1[3]);
                *(u32x2*)(H + (size_t)(row0 + ai * 128 + m * 16) * 512 + col0) = w; }
    }
};
struct EpiMoeDown {
    static constexpr int PERM = 2, MID = 0;
    bf16* Y;
    __device__ __forceinline__ void operator()(const f32x4 (&acc)[2][2][4][2], const MoeUnit& u, int wr, int wc, int fr, int fq) const {
        const int col0 = u.pn * 256 + wc * 64 + 16 * fq;
#pragma unroll
        for (int ai = 0; ai < 2; ++ai)
#pragma unroll
            for (int m = 0; m < 4; ++m) { const int r = ai * 128 + wr * 64 + m * 16 + fr;
                if (r < u.nvalid) {
                    unsigned char* rowp = (unsigned char*)Y + (size_t)(u.blk * 256 + r) * D + col0;
                    const f32x4 v0 = acc[ai][0][m][0], v1 = acc[ai][0][m][1], v2 = acc[ai][1][m][0], v3 = acc[ai][1][m][1];
                    u32x4 o; o.x = pk4_fp8(v0[0], v0[1], v0[2], v0[3]); o.y = pk4_fp8(v1[0], v1[1], v1[2], v1[3]); o.z = pk4_fp8(v2[0], v2[1], v2[2], v2[3]); o.w = pk4_fp8(v3[0], v3[1], v3[2], v3[3]);
                    *(u32x4*)rowp = o;
                } }
    }
};

#define XB_TMO      128
#define XB_XCNT(j)  (256  + 64 * (j))
#define XB_XSUB(j)  (1280 + 64 * (j))
#define XB_XGEN(j)  (2304 + 64 * (j))
#define XB_TOP      3328
#define XB_TOPGEN   3392
#define XCD_BAR_WORDS 3456
#define XB_SPIN_CAP (1u << 18)
__device__ __forceinline__ unsigned xb_ld(unsigned* p)              { return __hip_atomic_load(p, __ATOMIC_RELAXED, __HIP_MEMORY_SCOPE_AGENT); }
__device__ __forceinline__ unsigned xb_add(unsigned* p, unsigned v) { return __hip_atomic_fetch_add(p, v, __ATOMIC_RELAXED, __HIP_MEMORY_SCOPE_AGENT); }
__device__ __forceinline__ unsigned xb_xcc_id() { return (unsigned)__builtin_amdgcn_s_getreg((3 << 11) | 20) & 0xFu; }
#define XB_SPIN(cond, bar) do { unsigned _sp = 0; while (cond) { __builtin_amdgcn_s_sleep(1); \
    if ((++_sp & 255u) == 0u) { if (xb_ld(&(bar)[XB_TMO])) break; if (_sp > XB_SPIN_CAP) { atomicAdd(&(bar)[XB_TMO], 1u); break; } } } } while (0)
struct XcdBarrier { unsigned* bar; unsigned x; volatile LAS unsigned* st; };
__device__ __forceinline__ XcdBarrier xcd_barrier_post(unsigned* bar, volatile LAS unsigned* st) {
    XcdBarrier b; b.bar = bar; b.x = xb_xcc_id(); b.st = st;
    if (threadIdx.x == 0) (void)xb_add(&bar[XB_XCNT(b.x)], 1u);
    return b;
}
__device__ __forceinline__ void xcd_barrier_complete(unsigned* bar, unsigned x, unsigned& nloc, unsigned& nx) {
    const unsigned G = gridDim.x * gridDim.y * gridDim.z;
    unsigned sum, cnt, mine, sp = 0u;
    for (;;) {
        sum = 0u; cnt = 0u; mine = 0u;
#pragma unroll
        for (unsigned j = 0; j < 16; ++j) { const unsigned c = xb_ld(&bar[XB_XCNT(j)]); sum += c; cnt += (c > 0u) ? 1u : 0u; mine = (j == x) ? c : mine; }
        if (sum == G) break;
        __builtin_amdgcn_s_sleep(1);
        if ((++sp & 255u) == 0u) { if (xb_ld(&bar[XB_TMO])) break; if (sp > XB_SPIN_CAP) { atomicAdd(&bar[XB_TMO], 1u); break; } }
    }
    nloc = mine > 0u ? mine : 1u; nx = cnt > 0u ? cnt : 1u;
}
__device__ __forceinline__ void xcd_barrier(const XcdBarrier& b) {
    asm volatile("s_waitcnt vmcnt(0)" ::: "memory");
    __syncthreads();
    if (threadIdx.x == 0) {
        unsigned* bar = b.bar;
        __builtin_amdgcn_s_waitcnt(0);
        unsigned nloc = b.st[0], nx = b.st[1];
        if (nloc == 0u) { xcd_barrier_complete(bar, b.x, nloc, nx); b.st[0] = nloc; b.st[1] = nx; }
        const unsigned old = xb_add(&bar[XB_XSUB(b.x)], 1u);
        const unsigned gen = old / nloc;
        if (old + 1u == (gen + 1u) * nloc) {
            __builtin_amdgcn_fence(__ATOMIC_RELEASE, "agent");
            asm volatile("s_waitcnt vmcnt(0)" ::: "memory");
            const unsigned og = xb_add(&bar[XB_TOP], 1u);
            const unsigned tg = og / nx;
            if (og + 1u == (tg + 1u) * nx) xb_add(&bar[XB_TOPGEN], 1u);
            else XB_SPIN(xb_ld(&bar[XB_TOPGEN]) == tg, bar);
            __builtin_amdgcn_fence(__ATOMIC_ACQUIRE, "agent");
            xb_add(&bar[XB_XGEN(b.x)], 1u);
            asm volatile("s_waitcnt vmcnt(0)" ::: "memory");
        } else {
            XB_SPIN(xb_ld(&bar[XB_XGEN(b.x)]) == gen, bar);
            __builtin_amdgcn_fence(__ATOMIC_ACQUIRE, "agent");
            asm volatile("s_waitcnt vmcnt(0)" ::: "memory");
        }
    }
    __syncthreads();
}

typedef const float* cfp_t;
typedef const cfp_t __attribute__((address_space(4)))* InTab;
__device__ __forceinline__ void stagger(int bid, unsigned step_10ns) {
    const unsigned cls = (unsigned)(bid >> 3) & 3u;
    if (cls) { const unsigned long long t0 = __builtin_amdgcn_s_memrealtime(); while (__builtin_amdgcn_s_memrealtime() - t0 < (unsigned long long)(cls * step_10ns)) __builtin_amdgcn_s_sleep(8); }
}
template <int F8 = 0> __device__ __forceinline__ void cvt_item(const float* W, int ld, int Kd, bf16* WT, LAS float* scr, int k0, int nsrc, int drow, int nvalid, int lane, size_t lo_off = 0) {
    const int nn = lane & 31;
    { float t[32]; const float* wp = W + (size_t)(k0 + (lane >> 5)) * ld + nsrc + nn;
#pragma unroll
      for (int i = 0; i < 32; ++i) t[i] = (nn < nvalid) ? __builtin_nontemporal_load(wp + (size_t)(2 * i) * ld) : 0.f;
#pragma unroll
      for (int i = 0; i < 32; ++i) scr[(2 * i + (lane >> 5)) * 33 + nn] = t[i]; }
    LDS_WAIT(); asm volatile("" ::: "memory");
    const int c = lane & 7;
#pragma unroll
    for (int j = 0; j < 4; ++j) { const int n = (lane >> 3) + 8 * j; const LAS float* s = scr + (8 * c) * 33 + n;
        if constexpr (F8 == 2) { float hi[8], lo[8];
#pragma unroll
            for (int e = 0; e < 8; ++e) { const float x = s[e * 33]; hi[e] = bf2f(pk2(x, 0.f) & 0xffffu); lo[e] = x - hi[e]; }
            const int kk = k0 + 8 * c, nn2 = drow + n; const size_t off = ((size_t)((kk >> 5) * 4 + (nn2 >> 4)) * 64 + ((kk & 31) >> 3) * 16 + (nn2 & 15)) * 8;
            if (n < nvalid) { *(u32x4*)(WT + off) = pack8(hi); *(u32x4*)(WT + lo_off + off) = pack8(lo); } }
        else if constexpr (F8 == 1) { u32x2 o; o.x = pk4_fp8(s[0 * 33] * 32.f, s[1 * 33] * 32.f, s[2 * 33] * 32.f, s[3 * 33] * 32.f); o.y = pk4_fp8(s[4 * 33] * 32.f, s[5 * 33] * 32.f, s[6 * 33] * 32.f, s[7 * 33] * 32.f);
            if (n < nvalid) *(u32x2*)((unsigned char*)WT + (size_t)(drow + n) * Kd + k0 + 8 * c) = o; }
        else { u32x4 o; o.x = pk2(s[0 * 33], s[1 * 33]); o.y = pk2(s[2 * 33], s[3 * 33]); o.z = pk2(s[4 * 33], s[5 * 33]); o.w = pk2(s[6 * 33], s[7 * 33]);
            if (n < nvalid) *(u32x4*)(WT + (size_t)(drow + n) * Kd + k0 + 8 * c) = o; } }
    LDS_WAIT(); asm volatile("" ::: "memory");
}
template <bool OFB = false> __device__ __forceinline__ void ln_store(float (&v)[4][8], const float* g, const float* b, int lane, float* of, bf16* ob, unsigned char* oq = nullptr) {
    float s = 0.f;
#pragma unroll
    for (int j = 0; j < 4; ++j)
#pragma unroll
        for (int e = 0; e < 8; ++e) s += v[j][e];
    const float mean = wave_sum(s) * (1.f / D); float s2 = 0.f;
#pragma unroll
    for (int j = 0; j < 4; ++j)
#pragma unroll
        for (int e = 0; e < 8; ++e) { v[j][e] -= mean; s2 += v[j][e] * v[j][e]; }
    const float rstd = 1.f / sqrtf(wave_sum(s2) * (1.f / D) + LN_EPS);
#pragma unroll
    for (int j = 0; j < 4; ++j) { const int c0 = 512 * j + 8 * lane;
        const f32x4 g0 = *(const f32x4*)(g + c0), g1 = *(const f32x4*)(g + c0 + 4), b0 = *(const f32x4*)(b + c0), b1 = *(const f32x4*)(b + c0 + 4);
        f32x4 y0, y1;
#pragma unroll
        for (int e = 0; e < 4; ++e) { y0[e] = v[j][e] * rstd * g0[e] + b0[e]; y1[e] = v[j][4 + e] * rstd * g1[e] + b1[e]; }
        if (of) { if (OFB) { u32x4 w; w.x = pk2(y0[0], y0[1]); w.y = pk2(y0[2], y0[3]); w.z = pk2(y1[0], y1[1]); w.w = pk2(y1[2], y1[3]); *(u32x4*)((bf16*)of + c0) = w; }
                  else { *(f32x4*)(of + c0) = y0; *(f32x4*)(of + c0 + 4) = y1; } }
        if (ob) { u32x4 w; w.x = pk2(y0[0], y0[1]); w.y = pk2(y0[2], y0[3]); w.z = pk2(y1[0], y1[1]); w.w = pk2(y1[2], y1[3]); *(u32x4*)(ob + c0) = w; }
        if (oq) { u32x2 w; w.x = pk4_fp8(y0[0], y0[1], y0[2], y0[3]); w.y = pk4_fp8(y1[0], y1[1], y1[2], y1[3]); *(u32x2*)(oq + c0) = w; } }
}
struct XItem { const float* W; unsigned char* WT; int ld, Kd, k0, drow; };
template <bool UPF> __device__ __forceinline__ XItem x_decode(int r, InTab in, int l, unsigned char* wbase) {
    XItem q;
    if (UPF) { const int e = r / 512, p = r % 512, w = p / 256, kb = (p % 256) / 16, nb = p % 16, j0 = nb * 32;
        q.W = (e < 64 ? in[26 + w] + ((size_t)l * NE + e) * 2048 * 512 : in[29 + w] + (size_t)l * 2048 * 512) + j0;
        q.WT = wbase + W_UP + (size_t)e * 1024 * 2048; q.ld = 512; q.Kd = 2048; q.k0 = kb * 128; q.drow = (j0 / 128) * 256 + w * 128 + (j0 % 128); }
    else { const int e = r / 256, p = r % 256, kb = p / 64, nb = p % 64;
        q.W = (e < 64 ? in[28] + ((size_t)l * NE + e) * 512 * 2048 : in[31] + (size_t)l * 512 * 2048) + nb * 32;
        q.WT = wbase + W_DN + (size_t)e * 2048 * 512; q.ld = 2048; q.Kd = 512; q.k0 = kb * 128; q.drow = nb * 32; }
    return q;
}
template <bool UPF> __device__ __forceinline__ void x_family(LAS float* scr, InTab in, int l, unsigned char* wbase, int gw, int NGW, int lane) {
    constexpr int NI = UPF ? 65 * 2 * 256 : 65 * 256;
#pragma unroll 1
    for (int it = gw; it < NI; it += NGW) {
        const XItem q = x_decode<UPF>(it, in, l, wbase);
        float t[64]; const float* wp = q.W + (size_t)(q.k0 + (lane >> 5)) * q.ld + (lane & 31);
#pragma unroll
        for (int i = 0; i < 64; ++i) t[i] = __builtin_nontemporal_load(wp + (size_t)(2 * i) * q.ld);
#pragma unroll
        for (int hf = 0; hf < 2; ++hf) {
            const int nn = lane & 31;
#pragma unroll
            for (int i = 0; i < 32; ++i) scr[(2 * i + (lane >> 5)) * 33 + nn] = t[32 * hf + i];
            LDS_WAIT(); asm volatile("" ::: "memory");
            const int c = lane & 7;
#pragma unroll
            for (int j = 0; j < 4; ++j) { const int n = (lane >> 3) + 8 * j; const LAS float* s = scr + (8 * c) * 33 + n;
                u32x2 o; o.x = pk4_fp8(s[0 * 33] * 32.f, s[1 * 33] * 32.f, s[2 * 33] * 32.f, s[3 * 33] * 32.f); o.y = pk4_fp8(s[4 * 33] * 32.f, s[5 * 33] * 32.f, s[6 * 33] * 32.f, s[7 * 33] * 32.f);
                *(u32x2*)(q.WT + (size_t)(q.drow + n) * q.Kd + q.k0 + 64 * hf + 8 * c) = o; }
            LDS_WAIT(); asm volatile("" ::: "memory");
        }
    }
}
__device__ __forceinline__ void p0_convert(LAS unsigned char* lds, InTab in, int l, unsigned char* wbase, int gw, int NGW, int wave, int lane) {
    LAS float* scr = (LAS float*)(lds + wave * 16384);
    constexpr int I_IN = 32 * 497, I_PR = 1024, I_OUT = 2048, I_LR = 128, I_UP = 65 * 2 * 512, I_DN = 65 * 512;
    constexpr int I_RT = 64;
    constexpr int NITEMS = I_IN + 3 * I_PR + I_OUT + I_LR + I_RT;
    bf16* Win = (bf16*)(wbase + W_IN);
    for (int it = gw; it < NITEMS; it += NGW) {
        int r = it;
        if (r < I_IN) { const int kb = r / 497, nb = r % 497;
            int nsrc, drow, nv = 32;
            if (nb < 192) { nsrc = nb * 32; drow = nb * 32; }
            else if (nb < 224) { nsrc = nb * 32; drow = COL_LX + (nb - 192) * 32; }
            else if (nb < 256) { nsrc = nb * 32; drow = COL_LG + (nb - 224) * 32; }
            else if (nb < 288) { nsrc = nb * 32; drow = COL_Z + (nb - 256) * 32; }
            else if (nb < 336) { nsrc = nb * 32; drow = COL_XBC + (nb - 288) * 32; }
            else if (nb < 432) { nsrc = 10768 + (nb - 336) * 32; drow = COL_Q + (nb - 336) * 32; }
            else if (nb < 464) { nsrc = 10768 + (nb - 336) * 32; drow = COL_K + (nb - 432) * 32; }
            else if (nb < 496) { nsrc = 10768 + (nb - 336) * 32; drow = COL_V + (nb - 464) * 32; }
            else { nsrc = 10752; drow = COL_DT; nv = 16; }
            if (drow < N8) cvt_item<1>(in[3] + (size_t)l * D * D_IN, D_IN, 2048, (bf16*)(wbase + W_IN8), scr, kb * 64, nsrc, drow, nv, lane);
            else cvt_item(in[3] + (size_t)l * D * D_IN, D_IN, 2048, Win, scr, kb * 64, nsrc, drow, nv, lane);
            continue; }
        r -= I_IN;
        if (r < 3 * I_PR) { const int w = r / I_PR, q = r % I_PR, kb = q / 64, nb = q % 64;
            const float* src = in[18 + w] + (size_t)l * 1024 * D; bf16* dst = (bf16*)(wbase + W_PL) + w * 1024;
            cvt_item(src, 2048, YLD, dst, scr, kb * 64, nb * 32, nb * 32, 32, lane); continue; }
        r -= 3 * I_PR;
        if (r < I_OUT) { const int kb = r / 64, nb = r % 64; cvt_item(in[21] + (size_t)l * D * D, 2048, 2048, (bf16*)(wbase + W_OUT), scr, kb * 64, nb * 32, nb * 32, 32, lane); continue; }
        r -= I_OUT;
        if (r < I_LR) { const int w = r / 64, q = r % 64, blk = q / 8, kb = (q % 8) / 4, nb = q % 4;
            cvt_item(in[7 + 2 * w] + (size_t)l * 8 * 16384 + blk * 16384, 128, 128, (bf16*)(wbase + W_LR + (size_t)w * 262144) + blk * 16384, scr, kb * 64, nb * 32, nb * 32, 32, lane); continue; }
        r -= I_LR;
        { const int kb = r / 2, nb = r % 2;
            cvt_item<2>(in[24] + (size_t)l * D * NE, NE, 2048, (bf16*)(wbase + W_RH), scr, kb * 64, nb * 32, nb * 32, 32, lane, (W_RL - W_RH) / 2); }
    }
    x_family<true>(scr, in, l, wbase, gw, NGW, lane);
    x_family<false>(scr, in, l, wbase, gw, NGW, lane);
    { u32x4* z = (u32x4*)(wbase + W_IN8 + (size_t)(COL_DT + 16) * 2048); const int n16 = 240 * 2048 / 16;
      for (int i = gw * 64 + lane; i < n16; i += NGW * 64) z[i] = (u32x4){0u, 0u, 0u, 0u}; }
}

template <int TPT> __device__ __forceinline__ void conv8(const bf16* src, int l0g, const float* cw, int cstride, const float* cb, float (&out)[TPT][8]) {
    u32x4 rows[TPT + 3];
#pragma unroll
    for (int j = 0; j < TPT + 3; ++j) { rows[j] = (u32x4){0u, 0u, 0u, 0u}; if (l0g + j - 3 >= 0) rows[j] = *(const u32x4*)(src + (ptrdiff_t)(j - 3) * LD); }
    float w[4][8], bb[8];
#pragma unroll
    for (int k = 0; k < 4; ++k) { const f32x4 a = *(const f32x4*)(cw + k * cstride), b = *(const f32x4*)(cw + k * cstride + 4);
#pragma unroll
        for (int e = 0; e < 4; ++e) { w[k][e] = a[e]; w[k][4 + e] = b[e]; } }
    { const f32x4 a = *(const f32x4*)cb, b = *(const f32x4*)(cb + 4);
#pragma unroll
      for (int e = 0; e < 4; ++e) { bb[e] = a[e]; bb[4 + e] = b[e]; } }
#pragma unroll
    for (int j = 0; j < TPT; ++j) {
#pragma unroll
        for (int e = 0; e < 8; ++e) out[j][e] = bb[e];
#pragma unroll
        for (int k = 0; k < 4; ++k) { const u32x4 x = rows[j + k];
            out[j][0] += w[k][0] * bflo(x.x); out[j][1] += w[k][1] * bfhi(x.x); out[j][2] += w[k][2] * bflo(x.y); out[j][3] += w[k][3] * bfhi(x.y);
            out[j][4] += w[k][4] * bflo(x.z); out[j][5] += w[k][5] * bfhi(x.z); out[j][6] += w[k][6] * bflo(x.w); out[j][7] += w[k][7] * bfhi(x.w); }
    }
}

__device__ __forceinline__ int lru_idx(int tok, int d) { return tok * 32 + (d ^ (4 * ((tok >> 3) & 7))); }
#define LDS_BAR() do { asm volatile("s_waitcnt lgkmcnt(0)" ::: "memory"); __builtin_amdgcn_s_barrier(); asm volatile("" ::: "memory"); } while (0)
constexpr int KS = 272;
struct AttnTask { int grp, b, h, dil, r, tb; };
__device__ __forceinline__ AttnTask attn_decode(int run, int k) {
    AttnTask t; t.grp = run >> 8; const int bh = (run >> 2) & 63, ti = 4 * (run & 3) + k; t.b = bh >> 3; t.h = bh & 7;
    if (t.grp == 0) { t.dil = 1; t.r = 0; t.tb = ti; } else if (t.grp == 1) { t.dil = 4; t.r = ti >> 2; t.tb = ti & 3; } else { t.dil = 16; t.r = ti; t.tb = 0; }
    return t;
}
__device__ __forceinline__ void attn_prefetch(const unsigned char* __restrict__ q8, const AttnTask& t, bool prev, int tid, u32x2 (&kr)[8], u32x2 (&vr)[8]) {
#pragma unroll
    for (int j = 0; j < 8; ++j) { const int idx = tid + 512 * j, row = idx >> 4, ch = idx & 15;
        if (prev || j >= 4) { const int tk = (t.tb * 128 - 128 + row) * t.dil + t.r; const unsigned char* src = q8 + (size_t)(t.b * T + tk) * 5120 + t.h * 128 + ch * 8;
            kr[j] = *(const u32x2*)(src + 3072); vr[j] = *(const u32x2*)(src + 4096); } }
}
__device__ __forceinline__ u32x4 f8x8_to_bf16(u32x2 q) {
    const f32x2 c0 = __builtin_amdgcn_cvt_pk_f32_fp8((int)q.x, false), c1 = __builtin_amdgcn_cvt_pk_f32_fp8((int)q.x, true), c2 = __builtin_amdgcn_cvt_pk_f32_fp8((int)q.y, false), c3 = __builtin_amdgcn_cvt_pk_f32_fp8((int)q.y, true);
    u32x4 w; w.x = pk2(c0[0], c0[1]); w.y = pk2(c1[0], c1[1]); w.z = pk2(c2[0], c2[1]); w.w = pk2(c3[0], c3[1]); return w;
}
__device__ __forceinline__ void attn_phase(LAS unsigned char* lds, const bf16* __restrict__ proj, const unsigned char* __restrict__ q8, bf16* __restrict__ og, float* __restrict__ lse, int G, int bid, int tid) {
    const int lane = tid & 63, wave = __builtin_amdgcn_readfirstlane(tid >> 6);
    const int lr = lane & 15, lg = lane >> 4, lq = (lane & 15) >> 2, lp = lane & 3;
    LAS unsigned char* Kl = lds; LAS unsigned char* Vl = lds + 256 * KS;
    const unsigned vbase = (unsigned)(uintptr_t)Vl;
    u32x2 kr[8], vr[8];
    constexpr int NRUN = 768;
    if (bid < NRUN) { const AttnTask t0 = attn_decode(bid, 0); attn_prefetch(q8, t0, t0.tb != 0, tid, kr, vr); }
    for (int it = 0; bid + (it >> 2) * G < NRUN; ++it) {
        const int run = bid + (it >> 2) * G, k = it & 3;
        const AttnTask t = attn_decode(run, k);
        const int grp = t.grp, b = t.b, h = t.h, dil = t.dil, r = t.r, tb = t.tb;
        const int ub = tb * 128;
        const int ph = (k & 1) * 128;
        const bool prev = (k == 0) && tb != 0;
        LDS_BAR();
#pragma unroll
        for (int j = 0; j < 8; ++j) { const int idx = tid + 512 * j, row = (idx >> 4) ^ ph, ch = idx & 15;
            if (prev || j >= 4) { *(LAS u32x4*)(Kl + row * KS + ch * 16) = f8x8_to_bf16(kr[j]); *(LAS u32x4*)(Vl + row * KS + ch * 16) = f8x8_to_bf16(vr[j]); } }
        const int iq = 16 * wave + lr; const int tq = (ub + iq) * dil + r;
        const unsigned char* qp = q8 + (size_t)(b * T + tq) * 5120 + grp * 1024 + h * 128 + 8 * lg;
        bf16x8 qf[4];
#pragma unroll
        for (int ks = 0; ks < 4; ++ks) { const u32x2 qw = *(const u32x2*)(qp + 32 * ks);
            const f32x2 c0 = __builtin_amdgcn_cvt_pk_f32_fp8((int)qw.x, false), c1 = __builtin_amdgcn_cvt_pk_f32_fp8((int)qw.x, true), c2 = __builtin_amdgcn_cvt_pk_f32_fp8((int)qw.y, false), c3 = __builtin_amdgcn_cvt_pk_f32_fp8((int)qw.y, true);
            u32x4 w; w.x = pk2(c0[0], c0[1]); w.y = pk2(c1[0], c1[1]); w.z = pk2(c2[0], c2[1]); w.w = pk2(c3[0], c3[1]); qf[ks] = as_bf16x8(w); }
        { const int itn = it + 1, runn = bid + (itn >> 2) * G;
          if (runn < NRUN) { const AttnTask tn = attn_decode(runn, itn & 3); attn_prefetch(q8, tn, ((itn & 3) == 0) && tn.tb != 0, tid, kr, vr); } }
        LDS_BAR();
        const float slope = exp2f(-8.0f * (float)(grp * 8 + h + 1) / 24.0f) * (float)dil;
        const float scale = 0.08838834764831845f;
        int kb_lo = wave >> 1; const int kb_hi = (16 * wave + 143) >> 5; if (tb == 0 && kb_lo < 4) kb_lo = 4;
        float sj[2][4];
#pragma unroll
        for (int sb = 0; sb < 2; ++sb)
#pragma unroll
            for (int e = 0; e < 4; ++e) sj[sb][e] = slope * (float)(16 * sb + 4 * lg + e);
        float m_run = -1e30f, l_run = 0.f;
        f32x4 accO[8];
#pragma unroll
        for (int c = 0; c < 8; ++c) accO[c] = (f32x4){0.f, 0.f, 0.f, 0.f};
        for (int kb = kb_lo; kb <= kb_hi; ++kb) {
            const unsigned va = vbase + (unsigned)(((32 * kb + 4 * lg + lq) ^ ph) * KS + 8 * lp);
            u32x2 vlo[8], vhi[8]; tr_issue16(va, va + 16 * KS, vlo, vhi);
            f32x4 sacc[2];
#pragma unroll
            for (int sb = 0; sb < 2; ++sb) { sacc[sb] = (f32x4){0.f, 0.f, 0.f, 0.f};
#pragma unroll
                for (int ks = 0; ks < 4; ++ks) { const bf16x8 kf = *(const LAS bf16x8*)(Kl + ((32 * kb + 16 * sb + lr) ^ ph) * KS + 64 * ks + 16 * lg);
                    sacc[sb] = __builtin_amdgcn_mfma_f32_16x16x32_bf16(kf, qf[ks], sacc[sb], 0, 0, 0); } }
            const float kbt = slope * (float)(32 * kb);
            float sv[2][4];
#pragma unroll
            for (int sb = 0; sb < 2; ++sb)
#pragma unroll
                for (int e = 0; e < 4; ++e) sv[sb][e] = sacc[sb][e] * scale + (sj[sb][e] + kbt);
            if (!((32 * kb >= 16 * wave + 15) && (32 * kb + 31 <= 16 * wave + 128))) {
#pragma unroll
                for (int sb = 0; sb < 2; ++sb)
#pragma unroll
                    for (int e = 0; e < 4; ++e) { const int dist = iq + 128 - (32 * kb + 16 * sb + 4 * lg + e); if (dist < 0 || dist > 128) sv[sb][e] = -1e30f; }
            }
            float mx = fmaxf(fmaxf(fmaxf(sv[0][0], sv[0][1]), fmaxf(sv[0][2], sv[0][3])), fmaxf(fmaxf(sv[1][0], sv[1][1]), fmaxf(sv[1][2], sv[1][3])));
            mx = fmaxf(mx, __shfl_xor(mx, 16)); mx = fmaxf(mx, __shfl_xor(mx, 32));
            if (__builtin_amdgcn_ballot_w64(mx > m_run + 8.0f) != 0ull) {
                const float m_new = fmaxf(m_run, mx); const float alpha = __expf(m_run - m_new);
                l_run *= alpha; m_run = m_new;
#pragma unroll
                for (int c = 0; c < 8; ++c) accO[c] *= alpha;
            }
            float p[2][4]; float ps = 0.f;
#pragma unroll
            for (int sb = 0; sb < 2; ++sb)
#pragma unroll
                for (int e = 0; e < 4; ++e) { p[sb][e] = __expf(sv[sb][e] - m_run); ps += p[sb][e]; }
            l_run += ps;
            u32x4 pw; pw.x = pk2(p[0][0], p[0][1]); pw.y = pk2(p[0][2], p[0][3]); pw.z = pk2(p[1][0], p[1][1]); pw.w = pk2(p[1][2], p[1][3]);
            const bf16x8 pf = as_bf16x8(pw);
            tr_wait16(vlo, vhi);
#pragma unroll
            for (int c = 0; c < 8; ++c) { u32x4 vw; vw.x = vlo[c].x; vw.y = vlo[c].y; vw.z = vhi[c].x; vw.w = vhi[c].y;
                accO[c] = __builtin_amdgcn_mfma_f32_16x16x32_bf16(as_bf16x8(vw), pf, accO[c], 0, 0, 0); }
        }
        float lt = l_run; lt += __shfl_xor(lt, 16); lt += __shfl_xor(lt, 32);
        const float inv = 1.0f / lt;
        bf16* op = og + ((size_t)grp * M + (size_t)(b * T + tq)) * 1024 + h * 128 + 4 * lg;
#pragma unroll
        for (int c = 0; c < 8; ++c) { u32x2 w; w.x = pk2(accO[c][0] * inv, accO[c][1] * inv); w.y = pk2(accO[c][2] * inv, accO[c][3] * inv); *(u32x2*)(op + 16 * c) = w; }
        if (lg == 0) lse[((size_t)grp * M + (size_t)(b * T + tq)) * 8 + h] = m_run + __logf(lt) - slope * (float)(iq + 128);
    }
}
__device__ __forceinline__ void attn_merge(const bf16* __restrict__ og, const float* __restrict__ lse, bf16* __restrict__ ya, int gw, int NGW, int lane) {
    for (int row = gw; row < M; row += NGW) {
#pragma unroll
        for (int j = 0; j < 2; ++j) { const int cb = lane + 64 * j, h = cb >> 4;
            const float l0 = lse[(size_t)row * 8 + h], l1 = lse[((size_t)M + row) * 8 + h], l2 = lse[((size_t)2 * M + row) * 8 + h];
            const float mx = fmaxf(l0, fmaxf(l1, l2)); float w0 = __expf(l0 - mx), w1 = __expf(l1 - mx), w2 = __expf(l2 - mx); const float inv = 1.0f / (w0 + w1 + w2); w0 *= inv; w1 *= inv; w2 *= inv;
            const u32x4 a = *(const u32x4*)(og + (size_t)row * 1024 + cb * 8), b = *(const u32x4*)(og + ((size_t)M + row) * 1024 + cb * 8), c = *(const u32x4*)(og + ((size_t)2 * M + row) * 1024 + cb * 8);
            u32x4 o;
            o.x = pk2(w0 * bflo(a.x) + w1 * bflo(b.x) + w2 * bflo(c.x), w0 * bfhi(a.x) + w1 * bfhi(b.x) + w2 * bfhi(c.x));
            o.y = pk2(w0 * bflo(a.y) + w1 * bflo(b.y) + w2 * bflo(c.y), w0 * bfhi(a.y) + w1 * bfhi(b.y) + w2 * bfhi(c.y));
            o.z = pk2(w0 * bflo(a.z) + w1 * bflo(b.z) + w2 * bflo(c.z), w0 * bfhi(a.z) + w1 * bfhi(b.z) + w2 * bfhi(c.z));
            o.w = pk2(w0 * bflo(a.w) + w1 * bflo(b.w) + w2 * bflo(c.w), w0 * bfhi(a.w) + w1 * bfhi(b.w) + w2 * bfhi(c.w));
            *(u32x4*)(ya + (size_t)row * YLD + cb * 8) = o; }
    }
}

__device__ __forceinline__ float ssd_dt_acum(LAS float* DT, LAS float* AC, const bf16* __restrict__ proj, const float* dt_bias, const float* a_log, int b, int c, int g, int wave, int lane) {
    const int h = 8 * g + wave; const float bias = dt_bias[h], a = -__expf(a_log[h]);
    const size_t rowb = (size_t)(b * T + c * 128 + 2 * lane) * LD + COL_DT + h;
    const float d0 = softplusf_(bf2f(proj[rowb]) + bias), d1 = softplusf_(bf2f(proj[rowb + LD]) + bias);
    const float v0 = d0 * a, v1 = d1 * a; float s = v0 + v1;
#pragma unroll
    for (int o = 1; o < 64; o <<= 1) { const float t = __shfl_up(s, o); if (lane >= o) s += t; }
    DT[wave * 128 + 2 * lane] = d0; DT[wave * 128 + 2 * lane + 1] = d1;
    AC[wave * 128 + 2 * lane] = s - v1; AC[wave * 128 + 2 * lane + 1] = s;
    return __shfl(s, 63);
}
__device__ __forceinline__ void ssd_stage_bc(LAS unsigned char* img, const bf16* __restrict__ proj, const float* cw, const float* cb, int b, int c, int chan0, int tid) {
    const int ch = tid & 15, tg = tid >> 4;
    const int l0 = tg * 4, col = chan0 + ch * 8;
    float o[4][8];
    conv8<4>(proj + (size_t)(b * T + c * 128 + l0) * LD + COL_XBC + col, c * 128 + l0, cw + col, 1536, cb + col, o);
#pragma unroll
    for (int j = 0; j < 4; ++j) { float v[8];
#pragma unroll
        for (int e = 0; e < 8; ++e) v[e] = siluf_(o[j][e]);
        *(LAS u32x4*)(img + (l0 + j) * KS + ch * 16) = pack8(v); }
}
constexpr int XS = 528;
template <bool SCALE> __device__ __forceinline__ void ssd_stage_x(LAS unsigned char* img, const bf16* __restrict__ proj, const float* cw, const float* cb, int b, int c, int chan0, LAS const float* WL, int hb, int tid) {
    const int ch = tid & 31, tg = tid >> 5;
    const int col = chan0 + ch * 8;
#pragma unroll 1
    for (int sub = 0; sub < 2; ++sub) {
        const int l0 = tg * 8 + sub * 4;
        float o[4][8];
        conv8<4>(proj + (size_t)(b * T + c * 128 + l0) * LD + COL_XBC + col, c * 128 + l0, cw + col, 1536, cb + col, o);
#pragma unroll
        for (int j = 0; j < 4; ++j) { float v[8]; const float sc = SCALE ? WL[(hb + (ch >> 3)) * 128 + l0 + j] : 1.0f;
#pragma unroll
            for (int e = 0; e < 8; ++e) v[e] = siluf_(o[j][e]) * sc;
            *(LAS u32x4*)(img + (l0 + j) * XS + ch * 16) = pack8(v); }
    }
}
__device__ __forceinline__ void ssd_states_phase(LAS unsigned char* lds, const bf16* __restrict__ proj, const float* cw, const float* cb, const float* dt_bias, const float* a_log,
                                                 bf16* __restrict__ sst, float* __restrict__ alast, int G, int bid, int tid) {
    const int lane = tid & 63, wave = __builtin_amdgcn_readfirstlane(tid >> 6);
    LAS float* DT = (LAS float*)lds; LAS float* AC = DT + 1024; LAS float* WL = AC + 1024;
    LAS unsigned char* BMi = lds + 12288; LAS unsigned char* Xi = BMi + 128 * KS;
    const unsigned bbase = (unsigned)(uintptr_t)BMi, xbase = (unsigned)(uintptr_t)Xi;
    for (int unit = bid; unit < 256; unit += G) {
        const int b = unit >> 5, c = (unit >> 1) & 15, g = unit & 1;
        __syncthreads();
        const float al = ssd_dt_acum(DT, AC, proj, dt_bias, a_log, b, c, g, wave, lane);
        if (lane == 0) alast[(b * 16 + c) * 16 + 8 * g + wave] = al;
        LDS_WAIT();
        WL[wave * 128 + 2 * lane] = DT[wave * 128 + 2 * lane] * __expf(al - AC[wave * 128 + 2 * lane]);
        WL[wave * 128 + 2 * lane + 1] = DT[wave * 128 + 2 * lane + 1] * __expf(al - AC[wave * 128 + 2 * lane + 1]);
        ssd_stage_bc(BMi, proj, cw, cb, b, c, 1024 + 128 * g, tid);
        __syncthreads();
#pragma unroll 1
        for (int pass = 0; pass < 2; ++pass) {
            if (pass) __syncthreads();
            ssd_stage_x<true>(Xi, proj, cw, cb, b, c, 512 * g + 256 * pass, WL, 4 * pass, tid);
            __syncthreads();
            int ln = lane; asm volatile("" : "+v"(ln));
            const int lr = ln & 15, lg = ln >> 4, lq = (ln & 15) >> 2, lp = ln & 3;
            const int hl = wave >> 1, ph = wave & 1;
            f32x4 acc[2][8];
#pragma unroll
            for (int mt = 0; mt < 2; ++mt)
#pragma unroll
                for (int nt = 0; nt < 8; ++nt) acc[mt][nt] = (f32x4){0.f, 0.f, 0.f, 0.f};
            const unsigned xa = xbase + (unsigned)((8 * lg + lq) * XS + (64 * hl + 32 * ph + 4 * lp) * 2);
            const unsigned ba = bbase + (unsigned)((8 * lg + lq) * KS + (4 * lp) * 2);
#pragma unroll
            for (int ks = 0; ks < 4; ++ks) {
                bf16x8 af[2];
#pragma unroll
                for (int mt = 0; mt < 2; ++mt) { const unsigned a0 = xa + (unsigned)(32 * ks * XS + 32 * mt);
                    u32x2 lo, hi; tr_read2(a0, a0 + 4 * XS, lo, hi); u32x4 w; w.x = lo.x; w.y = lo.y; w.z = hi.x; w.w = hi.y; af[mt] = as_bf16x8(w); }
#pragma unroll
                for (int nt = 0; nt < 8; ++nt) { const unsigned b0 = ba + (unsigned)(32 * ks * KS + 32 * nt);
                    u32x2 lo, hi; tr_read2(b0, b0 + 4 * KS, lo, hi); u32x4 w; w.x = lo.x; w.y = lo.y; w.z = hi.x; w.w = hi.y; const bf16x8 bfr = as_bf16x8(w);
#pragma unroll
                    for (int mt = 0; mt < 2; ++mt) acc[mt][nt] = __builtin_amdgcn_mfma_f32_16x16x32_bf16(bfr, af[mt], acc[mt][nt], 0, 0, 0); }
            }
            const int h = 8 * g + 4 * pass + hl;
#pragma unroll
            for (int mt = 0; mt < 2; ++mt) {
                bf16* sp = sst + ((size_t)((b * 16 + c) * 16 + h) * 64 + 32 * ph + 16 * mt + lr) * 128 + 4 * lg;
                asm volatile("" : "+v"(sp));
                float one = 1.0f; asm volatile("" : "+v"(one));
#pragma unroll
                for (int nt = 0; nt < 8; ++nt) { const f32x4 a = acc[mt][nt] * one; u32x2 w; w.x = pk2(a[0], a[1]); w.y = pk2(a[2], a[3]); *(u32x2*)(sp + 16 * nt) = w; }
            }
        }
    }
}
__device__ __forceinline__ void ssd_pass_phase(const bf16* __restrict__ sst, bf16* __restrict__ sstb, const float* __restrict__ alast, int G, int bid, int tid) {
    for (int i = bid * 512 + tid; i < 262144; i += G * 512) {
        const int b = i >> 15, q = i & 32767, h = q >> 11;
        const u32x2* base = (const u32x2*)sst + (size_t)b * 16 * 32768 + q; u32x2* ob = (u32x2*)sstb + (size_t)b * 16 * 32768 + q;
        u32x2 v[16];
#pragma unroll
        for (int c = 0; c < 16; ++c) v[c] = base[(size_t)c * 32768];
        f32x4 e = (f32x4){0.f, 0.f, 0.f, 0.f};
#pragma unroll
        for (int c = 0; c < 16; ++c) { u32x2 w; w.x = pk2(e[0], e[1]); w.y = pk2(e[2], e[3]); ob[(size_t)c * 32768] = w; const float dec = __expf(alast[(b * 16 + c) * 16 + h]); const f32x4 vc = {bflo(v[c].x), bfhi(v[c].x), bflo(v[c].y), bfhi(v[c].y)}; e = e * dec + vc; }
    }
}
__device__ __forceinline__ void ssd_out_phase(LAS unsigned char* lds, const bf16* __restrict__ proj, const float* cw, const float* cb, const float* dt_bias, const float* a_log,
                                              const float* dskip, const float* norm_g, const bf16* __restrict__ sst, bf16* ys, int G, int bid, int tid) {
    const int lane = tid & 63, wave = __builtin_amdgcn_readfirstlane(tid >> 6);
    LAS float* DT = (LAS float*)lds; LAS float* AC = DT + 1024;
    LAS unsigned char* BMi = lds + 8192; LAS unsigned char* CMi = BMi + 128 * KS; LAS unsigned char* Xi = CMi + 128 * KS;
    const unsigned xbase = (unsigned)(uintptr_t)Xi;
    for (int unit = bid; unit < 256; unit += G) {
        const int b = unit >> 5, c = (unit >> 1) & 15, g = unit & 1;
        __syncthreads();
        (void)ssd_dt_acum(DT, AC, proj, dt_bias, a_log, b, c, g, wave, lane);
        ssd_stage_bc(BMi, proj, cw, cb, b, c, 1024 + 128 * g, tid);
        ssd_stage_bc(CMi, proj, cw, cb, b, c, 1280 + 128 * g, tid);
        ssd_stage_x<false>(Xi, proj, cw, cb, b, c, 512 * g, nullptr, 0, tid);
        __syncthreads();
        int ln0 = lane; asm volatile("" : "+v"(ln0));
        const int l = 16 * wave + (ln0 & 15);
        bf16x8 cf[4];
#pragma unroll
        for (int ks = 0; ks < 4; ++ks) cf[ks] = *(const LAS bf16x8*)(CMi + l * KS + 64 * ks + 16 * (ln0 >> 4));
        f32x4 cbT[8];
#pragma unroll
        for (int sb = 0; sb < 8; ++sb) { cbT[sb] = (f32x4){0.f, 0.f, 0.f, 0.f};
            if (sb <= wave) {
#pragma unroll
                for (int ks = 0; ks < 4; ++ks) { const bf16x8 bfr = *(const LAS bf16x8*)(BMi + (16 * sb + (ln0 & 15)) * KS + 64 * ks + 16 * (ln0 >> 4));
                    cbT[sb] = __builtin_amdgcn_mfma_f32_16x16x32_bf16(bfr, cf[ks], cbT[sb], 0, 0, 0); } } }
        float ssq = 0.f;
        const size_t tokrow = (size_t)(b * T + c * 128 + l);
        const int ep_p = tid >> 3, ep_n0 = (tid & 7) * 16;
        u32x4 er[2];
#define SSD_E_LOAD(hh_) do { const bf16* q_ = sst + ((size_t)((b * 16 + c) * 16 + 8 * g + (hh_)) * 64 + ep_p) * 128 + ep_n0; er[0] = *(const u32x4*)q_; er[1] = *(const u32x4*)(q_ + 8); } while (0)
#define SSD_E_WRITE(buf_) do { LAS unsigned char* d_ = BMi + (buf_) * 17408 + ep_p * KS + ep_n0 * 2; *(LAS u32x4*)d_ = er[0]; *(LAS u32x4*)(d_ + 16) = er[1]; } while (0)
        SSD_E_LOAD(0);
        __syncthreads();
        SSD_E_WRITE(0);
        __syncthreads();
#pragma unroll 1
        for (int hh = 0; hh < 8; ++hh) {
            const int pass = hh >> 2, hl = hh & 3;
            if (hh == 4) { ssd_stage_x<false>(Xi, proj, cw, cb, b, c, 512 * g + 256, nullptr, 0, tid); __syncthreads(); }
            {
                int ln = lane; asm volatile("" : "+v"(ln));
                const int lr = ln & 15, lg = ln >> 4, lq = (ln & 15) >> 2, lp = ln & 3;
                const int h = 8 * g + hh;
                const float acl = AC[hh * 128 + l];
                f32x4 acc[4];
#pragma unroll
                for (int mt = 0; mt < 4; ++mt) acc[mt] = (f32x4){0.f, 0.f, 0.f, 0.f};
                u32x2 zv[4];
#pragma unroll
                for (int mt = 0; mt < 4; ++mt) zv[mt] = *(const u32x2*)(proj + tokrow * LD + COL_Z + 512 * g + 256 * pass + 64 * hl + 16 * mt + 4 * lg);
                if (hh + 1 < 8) SSD_E_LOAD(hh + 1);
                const LAS unsigned char* eb = BMi + (hh & 1) * 17408 + lr * KS + 16 * lg;
#pragma unroll
                for (int mt = 0; mt < 4; ++mt)
#pragma unroll
                    for (int ks = 0; ks < 4; ++ks) { const bf16x8 ef = *(const LAS bf16x8*)(eb + 16 * mt * KS + 64 * ks);
                        acc[mt] = __builtin_amdgcn_mfma_f32_16x16x32_bf16(ef, cf[ks], acc[mt], 0, 0, 0); }
                const float eal = __expf(acl);
#pragma unroll
                for (int mt = 0; mt < 4; ++mt) acc[mt] *= eal;
#pragma unroll
                for (int kk = 0; kk < 4; ++kk) {
                    if (2 * kk <= wave) {
                        float pv[8];
#pragma unroll
                        for (int hb2 = 0; hb2 < 2; ++hb2) { const int sb = 2 * kk + hb2, s0 = 16 * sb + 4 * lg;
                            const f32x4 av = *(const LAS f32x4*)(AC + hh * 128 + s0), dv = *(const LAS f32x4*)(DT + hh * 128 + s0);
#pragma unroll
                            for (int e = 0; e < 4; ++e) { const float w = (s0 + e <= l) ? __expf(acl - av[e]) * dv[e] : 0.f; pv[4 * hb2 + e] = cbT[sb][e] * w; } }
                        const bf16x8 pf = as_bf16x8(pack8(pv));
                        const unsigned va = xbase + (unsigned)((32 * kk + 4 * lg + lq) * XS + (64 * hl + 4 * lp) * 2);
#pragma unroll
                        for (int mt = 0; mt < 4; ++mt) { u32x2 lo, hi; tr_read2(va + 32 * mt, va + 32 * mt + 16 * XS, lo, hi); u32x4 vw; vw.x = lo.x; vw.y = lo.y; vw.z = hi.x; vw.w = hi.y;
                            acc[mt] = __builtin_amdgcn_mfma_f32_16x16x32_bf16(as_bf16x8(vw), pf, acc[mt], 0, 0, 0); }
                    } }
                const float dsk = dskip[h];
#pragma unroll
                for (int mt = 0; mt < 4; ++mt) { const int chl = 64 * hl + 16 * mt + 4 * lg;
                    const u32x2 xv = *(const LAS u32x2*)(Xi + l * XS + chl * 2);
                    float y0 = (acc[mt][0] + dsk * bflo(xv.x)) * siluf_(bflo(zv[mt].x)), y1 = (acc[mt][1] + dsk * bfhi(xv.x)) * siluf_(bfhi(zv[mt].x));
                    float y2 = (acc[mt][2] + dsk * bflo(xv.y)) * siluf_(bflo(zv[mt].y)), y3 = (acc[mt][3] + dsk * bfhi(xv.y)) * siluf_(bfhi(zv[mt].y));
                    ssq += y0 * y0 + y1 * y1 + y2 * y2 + y3 * y3;
                    u32x2 o; o.x = pk2(y0, y1); o.y = pk2(y2, y3);
                    *(u32x2*)(ys + tokrow * YLD + 512 * g + 256 * pass + chl) = o; }
                if (hh + 1 < 8) SSD_E_WRITE((hh + 1) & 1);
            }
            __syncthreads();
        }
#undef SSD_E_LOAD
#undef SSD_E_WRITE
        VM_WAIT();
        ssq += __shfl_xor(ssq, 16); ssq += __shfl_xor(ssq, 32);
        const float rstd = 1.0f / sqrtf(ssq * (1.0f / 512.0f) + RMS_EPS);
        { int ln = lane; asm volatile("" : "+v"(ln));
          const int lg = ln >> 4;
          bf16* yp = ys + tokrow * YLD + 512 * g + 4 * lg;
          u32x2 yv[8][4];
#pragma unroll
          for (int hh = 0; hh < 8; ++hh)
#pragma unroll
              for (int mt = 0; mt < 4; ++mt) yv[hh][mt] = *(const u32x2*)(yp + 64 * hh + 16 * mt);
#pragma unroll
          for (int hh = 0; hh < 8; ++hh)
#pragma unroll
              for (int mt = 0; mt < 4; ++mt) { const f32x4 ng = *(const f32x4*)(norm_g + 512 * g + 64 * hh + 16 * mt + 4 * lg); const u32x2 y = yv[hh][mt];
                  u32x2 o; o.x = pk2(bflo(y.x) * rstd * ng[0], bfhi(y.x) * rstd * ng[1]); o.y = pk2(bflo(y.y) * rstd * ng[2], bfhi(y.y) * rstd * ng[3]);
                  *(u32x2*)(yp + 64 * hh + 16 * mt) = o; } }
    }
}

__device__ __forceinline__ void lru_phase(LAS unsigned char* lds, const bf16* __restrict__ proj, const float* cw, const float* cb, const bf16* __restrict__ wrt, const bf16* __restrict__ wit,
                                          const float* br, const float* bi, const float* lam, bf16* __restrict__ yl, int G, int bid, int tid) {
    const int wave = __builtin_amdgcn_readfirstlane(tid >> 6);
    LAS unsigned char* XC = lds;
    LAS float* Aa = (LAS float*)(lds + 128 * KS);
    LAS float* Uu = Aa + 4096;
    LAS float* CW = Uu + 4096;
    for (int unit = bid; unit < 256; unit += G) {
        const int b = unit >> 5, n = (unit >> 2) & 7, dq = unit & 3;
        const int dch = 128 * n + 32 * dq;
        __syncthreads();
        for (int i = tid; i < 640; i += 512) { const int k = i >> 7, c = i & 127; CW[i] = k < 4 ? cw[k * 1024 + 128 * n + c] : cb[128 * n + c]; }
        int t2 = tid; asm volatile("" : "+v"(t2));
        const int lane = t2 & 63, lr = lane & 15, lg = lane >> 4;
        bf16x8 wrf[2][4], wif[2][4]; float brv[2], biv[2], spl[2];
#pragma unroll
        for (int nt = 0; nt < 2; ++nt) { const size_t wo = (size_t)n * 16384 + (size_t)(32 * dq + 16 * nt + lr) * 128 + 8 * lg;
#pragma unroll
            for (int ks = 0; ks < 4; ++ks) { wrf[nt][ks] = *(const bf16x8*)(wrt + wo + 32 * ks); wif[nt][ks] = *(const bf16x8*)(wit + wo + 32 * ks); }
            const int dl = dch + 16 * nt + lr; brv[nt] = br[dl]; biv[nt] = bi[dl]; spl[nt] = -8.0f * softplusf_(-lam[dl]); }
        const int cch = t2 & 15, l0 = (t2 >> 4) * 4;
        const int tok_o = t2 >> 2, qo = t2 & 3;
        const bf16* xsrc = proj + (size_t)(b * T + l0) * LD + COL_LX + 128 * n + cch * 8;
        const bf16* gsrc = proj + (size_t)(b * T + tok_o) * LD + COL_LG + dch + 8 * qo;
        u32x4 rows[7];
#pragma unroll
        for (int j = 0; j < 7; ++j) { rows[j] = (u32x4){0u, 0u, 0u, 0u}; if (l0 + j - 3 >= 0) rows[j] = *(const u32x4*)(xsrc + (ptrdiff_t)(j - 3) * LD); }
        u32x4 gate_n = *(const u32x4*)gsrc;
        float carry = 0.f;
        __syncthreads();
#pragma unroll 1
        for (int c = 0; c < 16; ++c) {
            { float w[4][8], o[8];
#pragma unroll
              for (int k = 0; k < 4; ++k) { const f32x4 a = *(const LAS f32x4*)(CW + k * 128 + cch * 8), bq = *(const LAS f32x4*)(CW + k * 128 + cch * 8 + 4);
#pragma unroll
                  for (int e = 0; e < 4; ++e) { w[k][e] = a[e]; w[k][4 + e] = bq[e]; } }
              const f32x4 ba = *(const LAS f32x4*)(CW + 512 + cch * 8), bb = *(const LAS f32x4*)(CW + 512 + cch * 8 + 4);
#pragma unroll
              for (int j = 0; j < 4; ++j) {
#pragma unroll
                  for (int e = 0; e < 4; ++e) { o[e] = ba[e]; o[4 + e] = bb[e]; }
#pragma unroll
                  for (int k = 0; k < 4; ++k) { const u32x4 x = rows[j + k];
                      o[0] += w[k][0] * bflo(x.x); o[1] += w[k][1] * bfhi(x.x); o[2] += w[k][2] * bflo(x.y); o[3] += w[k][3] * bfhi(x.y);
                      o[4] += w[k][4] * bflo(x.z); o[5] += w[k][5] * bfhi(x.z); o[6] += w[k][6] * bflo(x.w); o[7] += w[k][7] * bfhi(x.w); }
                  *(LAS u32x4*)(XC + (l0 + j) * KS + cch * 16) = pack8(o); } }
            const u32x4 gate_c = gate_n;
            if (c < 15) {
#pragma unroll
                for (int j = 0; j < 7; ++j) rows[j] = *(const u32x4*)(xsrc + (ptrdiff_t)((c + 1) * 128 + j - 3) * LD);
                gate_n = *(const u32x4*)(gsrc + (size_t)(c + 1) * 128 * LD);
            }
            LDS_BAR();
            { bf16x8 af[4];
#pragma unroll
              for (int ks = 0; ks < 4; ++ks) af[ks] = *(const LAS bf16x8*)(XC + (16 * wave + lr) * KS + 64 * ks + 16 * lg);
#pragma unroll
              for (int nt = 0; nt < 2; ++nt) { f32x4 ar = (f32x4){0.f, 0.f, 0.f, 0.f}, ai = ar;
#pragma unroll
                  for (int ks = 0; ks < 4; ++ks) { ar = __builtin_amdgcn_mfma_f32_16x16x32_bf16(af[ks], wrf[nt][ks], ar, 0, 0, 0); ai = __builtin_amdgcn_mfma_f32_16x16x32_bf16(af[ks], wif[nt][ks], ai, 0, 0, 0); }
                  const int dl = 16 * nt + lr;
#pragma unroll
                  for (int e = 0; e < 4; ++e) { const int tok = 16 * wave + 4 * lg + e;
                      const float rg = sigmoidf_(ar[e] + brv[nt]), ig = sigmoidf_(ai[e] + biv[nt]);
                      const float la = rg * spl[nt]; const float a = __expf(la);
                      const float xc = bf2f(*(const LAS bf16*)(XC + tok * KS + (32 * dq + dl) * 2));
                      Aa[lru_idx(tok, dl)] = a; Uu[lru_idx(tok, dl)] = __builtin_amdgcn_sqrtf(fmaxf(1.0f - a * a, 0.f)) * ig * xc; } } }
            LDS_BAR();
            { const int d = t2 >> 4, seg = t2 & 15;
              float hl[8], ac[8]; float hh = 0.f, aa = 1.f;
#pragma unroll
              for (int k = 0; k < 8; ++k) { const float a = Aa[lru_idx(8 * seg + k, d)], u = Uu[lru_idx(8 * seg + k, d)]; hh = a * hh + u; aa *= a; hl[k] = hh; ac[k] = aa; }
              float pa = aa, ph = hh;
              { float qa, qh;
                qa = row_shr<1>(1.f, pa); qh = row_shr<1>(0.f, ph); ph = pa * qh + ph; pa = pa * qa;
                qa = row_shr<2>(1.f, pa); qh = row_shr<2>(0.f, ph); ph = pa * qh + ph; pa = pa * qa;
                qa = row_shr<4>(1.f, pa); qh = row_shr<4>(0.f, ph); ph = pa * qh + ph; pa = pa * qa;
                qa = row_shr<8>(1.f, pa); qh = row_shr<8>(0.f, ph); ph = pa * qh + ph; pa = pa * qa; }
              const float ea = row_shr<1>(1.f, pa), eh = row_shr<1>(0.f, ph);
              const float cin = ea * carry + eh;
              const float ta = __shfl(pa, 15, 16), th = __shfl(ph, 15, 16); carry = ta * carry + th;
#pragma unroll
              for (int k = 0; k < 8; ++k) Uu[lru_idx(8 * seg + k, d)] = hl[k] + ac[k] * cin; }
            LDS_BAR();
            { const f32x4 h0 = *(const LAS f32x4*)(Uu + lru_idx(tok_o, 8 * qo)), h1v = *(const LAS f32x4*)(Uu + lru_idx(tok_o, 8 * qo + 4));
              float y[8];
              y[0] = h0[0] * gelu_tanh(bflo(gate_c.x)); y[1] = h0[1] * gelu_tanh(bfhi(gate_c.x)); y[2] = h0[2] * gelu_tanh(bflo(gate_c.y)); y[3] = h0[3] * gelu_tanh(bfhi(gate_c.y));
              y[4] = h1v[0] * gelu_tanh(bflo(gate_c.z)); y[5] = h1v[1] * gelu_tanh(bfhi(gate_c.z)); y[6] = h1v[2] * gelu_tanh(bflo(gate_c.w)); y[7] = h1v[3] * gelu_tanh(bfhi(gate_c.w));
              *(u32x4*)(yl + (size_t)(b * T + c * 128 + tok_o) * YLD + dch + 8 * qo) = pack8(y); }
        }
    }
}

__device__ __forceinline__ void router_phase(LAS unsigned char* lds, const bf16* __restrict__ pre, const float* lg_, const float* lb_, const bf16* __restrict__ rwh, const bf16* __restrict__ rwl, const float* rbias,
                                             bf16* __restrict__ h1, bf16* __restrict__ h1b, unsigned* gcnt, int* __restrict__ lts, float* __restrict__ lw, int* __restrict__ tmap, int* __restrict__ wgcnt, int G, int bid, int tid, int pflags) {
    const int lane = tid & 63, wave = __builtin_amdgcn_readfirstlane(tid >> 6);
    const bool table = MK_ONE && (M / 16 + G - 1) / G <= 4;
    constexpr int XS2 = 4112;
    LAS unsigned char* XH = lds; LAS unsigned char* XL = lds + 16 * XS2;
    LAS float* PART = (LAS float*)(lds + 32 * XS2);
    LAS int* SELT = (LAS int*)(PART + 2048);
    LAS float* SELW = (LAS float*)(SELT + 512);
    LAS int* LCNT = (LAS int*)(SELW + 512);
    LAS int* LBASE = LCNT + 64;
    LAS int* LPOS = LBASE + 64;
    if (tid < 64) LCNT[tid] = 0;
    const int ntiles = M / 16;
    int nflush = 0;
    for (int tile = bid; ; tile += G) {
        const bool have = tile < ntiles;
        if (have) {
            __syncthreads();
#pragma unroll 1
            for (int rr = 0; rr < 2; ++rr) { const int rl = 2 * wave + rr; const size_t row = (size_t)tile * 16 + rl;
                float v[4][8];
#pragma unroll
                for (int j = 0; j < 4; ++j) { const u32x4 a = *(const u32x4*)(pre + row * D + 512 * j + 8 * lane);
                    v[j][0] = bflo(a.x); v[j][1] = bfhi(a.x); v[j][2] = bflo(a.y); v[j][3] = bfhi(a.y); v[j][4] = bflo(a.z); v[j][5] = bfhi(a.z); v[j][6] = bflo(a.w); v[j][7] = bfhi(a.w); }
                float s = 0.f;
#pragma unroll
                for (int j = 0; j < 4; ++j)
#pragma unroll
                    for (int e = 0; e < 8; ++e) s += v[j][e];
                const float mean = wave_sum(s) * (1.f / D); float s2 = 0.f;
#pragma unroll
                for (int j = 0; j < 4; ++j)
#pragma unroll
                    for (int e = 0; e < 8; ++e) { v[j][e] -= mean; s2 += v[j][e] * v[j][e]; }
                const float rstd = 1.f / sqrtf(wave_sum(s2) * (1.f / D) + LN_EPS);
#pragma unroll
                for (int j = 0; j < 4; ++j) { const int c0 = 512 * j + 8 * lane;
                    const f32x4 g0 = *(const f32x4*)(lg_ + c0), g1 = *(const f32x4*)(lg_ + c0 + 4), b0 = *(const f32x4*)(lb_ + c0), b1 = *(const f32x4*)(lb_ + c0 + 4);
                    f32x4 y0, y1;
#pragma unroll
                    for (int e = 0; e < 4; ++e) { y0[e] = v[j][e] * rstd * g0[e] + b0[e]; y1[e] = v[j][4 + e] * rstd * g1[e] + b1[e]; }
                    if (!(pflags & 2)) { u32x4 hw; hw.x = pk2(y0[0], y0[1]); hw.y = pk2(y0[2], y0[3]); hw.z = pk2(y1[0], y1[1]); hw.w = pk2(y1[2], y1[3]); *(u32x4*)(h1 + row * D + c0) = hw; }
                    u32x2 w; w.x = pk4_fp8(y0[0], y0[1], y0[2], y0[3]); w.y = pk4_fp8(y1[0], y1[1], y1[2], y1[3]); *(u32x2*)((unsigned char*)h1b + row * D + c0) = w;
                    float yh[8], yl[8];
#pragma unroll
                    for (int e = 0; e < 4; ++e) { yh[e] = bf2f(pk2(y0[e], 0.f) & 0xffffu); yl[e] = y0[e] - yh[e]; yh[4 + e] = bf2f(pk2(y1[e], 0.f) & 0xffffu); yl[4 + e] = y1[e] - yh[4 + e]; }
                    *(LAS u32x4*)(XH + rl * XS2 + c0 * 2) = pack8(yh); *(LAS u32x4*)(XL + rl * XS2 + c0 * 2) = pack8(yl); }
            }
            __syncthreads();
            { const int nt = wave & 3, kh = wave >> 2, r = lane & 15, g = lane >> 4;
              f32x4 acc = (f32x4){0.f, 0.f, 0.f, 0.f}, acc2 = acc, acc3 = acc;
              const size_t wo = ((size_t)(32 * kh * 4 + nt) * 64 + lane) * 8;
              const LAS unsigned char* xh = XH + r * XS2 + (1024 * kh + 8 * g) * 2; const LAS unsigned char* xl = XL + r * XS2 + (1024 * kh + 8 * g) * 2;
#pragma unroll 4
              for (int ks = 0; ks < ((pflags & 1) ? 4 : 32); ++ks) {
                  const bf16x8 bh = *(const bf16x8*)(rwh + wo + (size_t)ks * 2048), bl = *(const bf16x8*)(rwl + wo + (size_t)ks * 2048);
                  const bf16x8 ah = *(const LAS bf16x8*)(xh + 64 * ks), al = *(const LAS bf16x8*)(xl + 64 * ks);
                  acc = __builtin_amdgcn_mfma_f32_16x16x32_bf16(ah, bh, acc, 0, 0, 0); acc2 = __builtin_amdgcn_mfma_f32_16x16x32_bf16(ah, bl, acc2, 0, 0, 0); acc3 = __builtin_amdgcn_mfma_f32_16x16x32_bf16(al, bh, acc3, 0, 0, 0); }
              acc += acc2 + acc3;
#pragma unroll
              for (int e = 0; e < 4; ++e) PART[(kh * 16 + 4 * g + e) * 64 + 16 * nt + r] = acc[e]; }
            __syncthreads();
#pragma unroll 1
            for (int rr = 0; rr < 2; ++rr) { const int rl = 2 * wave + rr; const int tok = tile * 16 + rl;
                const float logit = PART[rl * 64 + lane] + PART[(16 + rl) * 64 + lane];
                const float score = 1.0f / (1.0f + __expf(-logit)); const float choice = score + rbias[lane];
                const int grp = lane >> 3;
                float m1 = choice; m1 = fmaxf(m1, __shfl_xor(m1, 1)); m1 = fmaxf(m1, __shfl_xor(m1, 2)); m1 = fmaxf(m1, __shfl_xor(m1, 4));
                const unsigned long long bm = __ballot(choice == m1); const unsigned gm = (unsigned)(bm >> (8 * grp)) & 0xffu; const int first = __builtin_ctz(gm) + 8 * grp;
                float m2 = (lane == first) ? -INFINITY : choice; m2 = fmaxf(m2, __shfl_xor(m2, 1)); m2 = fmaxf(m2, __shfl_xor(m2, 2)); m2 = fmaxf(m2, __shfl_xor(m2, 4));
                const float gs = m1 + m2;
                int grank = 0;
#pragma unroll
                for (int j = 0; j < 8; ++j) { const float o = __shfl(gs, 8 * j); grank += (o > gs || (o == gs && j < grp)) ? 1 : 0; }
                const bool keep = grank < 4;
                const float masked = keep ? choice : -INFINITY;
                int rank = 64; float cur = masked;
#pragma unroll 1
                for (int it8 = 0; it8 < 8; ++it8) {
                    float v = cur;
                    v = fmaxf(v, __int_as_float(__builtin_amdgcn_update_dpp(__float_as_int(v), __float_as_int(v), 0xb1, 0xf, 0xf, false)));
                    v = fmaxf(v, __int_as_float(__builtin_amdgcn_update_dpp(__float_as_int(v), __float_as_int(v), 0x4e, 0xf, 0xf, false)));
                    v = fmaxf(v, __int_as_float(__builtin_amdgcn_update_dpp(__float_as_int(v), __float_as_int(v), 0x141, 0xf, 0xf, false)));
                    v = fmaxf(v, __int_as_float(__builtin_amdgcn_update_dpp(__float_as_int(v), __float_as_int(v), 0x140, 0xf, 0xf, false)));
                    const float r0 = __int_as_float(__builtin_amdgcn_readlane(__float_as_int(v), 0)), r1 = __int_as_float(__builtin_amdgcn_readlane(__float_as_int(v), 16));
                    const float r2 = __int_as_float(__builtin_amdgcn_readlane(__float_as_int(v), 32)), r3 = __int_as_float(__builtin_amdgcn_readlane(__float_as_int(v), 48));
                    const float mxw = fmaxf(fmaxf(r0, r1), fmaxf(r2, r3));
                    const unsigned long long eq = __ballot(cur == mxw);
                    const int win = __builtin_ctzll(eq);
                    if (lane == win) { rank = it8; cur = -INFINITY; }
                }
                const bool sel = keep && rank < 8;
                const float wsum = wave_sum(sel ? score : 0.f);
                if (sel) { const int idx = (nflush * 16 + rl) * 8 + rank; SELT[idx] = (tok * 16 + rank) | (lane << 24); SELW[idx] = score / wsum * 2.5f; }
            }
            ++nflush;
        }
        const bool more = (tile + G) < ntiles;
        if (table) {
            if (!more) {
                __syncthreads();
                const int nent = nflush * 128;
                if (tid < nent) { const int e = (SELT[tid] >> 24) & 63; LPOS[tid] = atomicAdd((int*)&LCNT[e], 1); }
                __syncthreads();
                if (tid < 64) wgcnt[bid * 64 + tid] = LCNT[tid];
                if (tid == 64) LBASE[0] = nent;
            }
        } else if (nflush == 4 || (!more && nflush > 0)) {
            __syncthreads();
            const int nent = nflush * 128; int e = 0, lp = 0;
            if (tid < nent) { e = (SELT[tid] >> 24) & 63; lp = atomicAdd((int*)&LCNT[e], 1); LPOS[tid] = lp; }
            __syncthreads();
            if (tid < 64) { const int n = LCNT[tid]; LBASE[tid] = n ? (int)__hip_atomic_fetch_add(gcnt + tid * 16, (unsigned)n, __ATOMIC_RELAXED, __HIP_MEMORY_SCOPE_AGENT) : 0; LCNT[tid] = 0; }
            __syncthreads();
            if (tid < nent) { const int pos = LBASE[e] + lp; const int ts = SELT[tid] & 0xffffff; lts[e * 16384 + pos] = ts; lw[e * 16384 + pos] = SELW[tid]; tmap[(ts >> 4) * 8 + (ts & 15)] = (e << 16) | pos; }
            nflush = 0;
        }
        if (!more) break;
    }
}

__device__ __forceinline__ void router_lists(LAS unsigned char* lds, const int* __restrict__ wgcnt, unsigned* gcnt, int* __restrict__ lts, float* __restrict__ lw, int* __restrict__ tmap, int G, int bid, int tid) {
    if (!MK_ONE || (M / 16 + G - 1) / G > 4) return;
    constexpr int XS2 = 4112;
    LAS float* PART = (LAS float*)(lds + 32 * XS2);
    LAS int* SELT = (LAS int*)(PART + 2048); LAS float* SELW = (LAS float*)(SELT + 512); LAS int* LCNT = (LAS int*)(SELW + 512); LAS int* LBASE = LCNT + 64; LAS int* LPOS = LBASE + 64;
    LAS int* RED = (LAS int*)PART;
    const int nent = LBASE[0];
    __syncthreads();
    { const int e = tid & 63, part = tid >> 6; int sum = 0;
      const int w0 = part * ((G + 7) / 8), w1 = min(min(w0 + (G + 7) / 8, G), bid);
      for (int w = w0; w < w1; ++w) sum += wgcnt[w * 64 + e];
      RED[part * 64 + e] = sum; }
    __syncthreads();
    if (tid < 64) { int b = 0;
#pragma unroll
        for (int p = 0; p < 8; ++p) b += RED[p * 64 + tid];
        LBASE[tid] = b;
        if (bid == G - 1) gcnt[tid * 16] = (unsigned)(b + LCNT[tid]); }
    __syncthreads();
    if (tid < nent) { const int v = SELT[tid]; const int e = (v >> 24) & 63, ts = v & 0xffffff; const int pos = LBASE[e] + LPOS[tid];
        lts[e * 16384 + pos] = ts; lw[e * 16384 + pos] = SELW[tid]; tmap[(ts >> 4) * 8 + (ts & 15)] = (e << 16) | pos; }
}

template <bool OFB> __device__ __forceinline__ void combine_phase(const bf16* __restrict__ Y, const bf16* __restrict__ h1, const int* __restrict__ tmap, const float* __restrict__ lw, const unsigned* cnt, const float* g, const float* b, float* of, bf16* ob, unsigned char* oq, int gw, int NGW, int lane) {
    int nb = ((int)cnt[lane * 16] + 255) >> 8, s = nb;
#pragma unroll
    for (int o = 1; o < 64; o <<= 1) { const int t = __shfl_up(s, o); if (lane >= o) s += t; }
    const int pex = s - nb, NBr = __builtin_amdgcn_readlane(s, 63);
    for (int row = gw; row < M; row += NGW) {
        int ln_ = lane; asm volatile("" : "+v"(ln_)); const int lane = ln_;
        const int tm = tmap[row * 8 + (lane & 7)];
        const int yrow = __shfl(pex, tm >> 16) * 256 + (tm & 0xffff);
        const float wsl = lw[(tm >> 16) * 16384 + (tm & 0xffff)];
        float v[4][8];
        u32x4 hr[4];
#pragma unroll
        for (int j = 0; j < 4; ++j) { hr[j] = *(const u32x4*)(h1 + (size_t)row * D + 512 * j + 8 * lane);
#pragma unroll
            for (int e = 0; e < 8; ++e) v[j][e] = 0.f; }
#pragma unroll
        for (int sl = 0; sl < 9; ++sl) { const int yr = sl < 8 ? __builtin_amdgcn_readlane(yrow, sl) : NBr * 256 + row; const float w = sl < 8 ? __builtin_bit_cast(float, __builtin_amdgcn_readlane(__builtin_bit_cast(int, wsl), sl)) : 1.0f;
#pragma unroll
            for (int j = 0; j < 4; ++j) { const u32x2 y = *(const u32x2*)((const unsigned char*)Y + (size_t)yr * D + 512 * j + 8 * lane);
                const f32x2 a0 = __builtin_amdgcn_cvt_pk_f32_fp8((int)y.x, false), a1 = __builtin_amdgcn_cvt_pk_f32_fp8((int)y.x, true), a2 = __builtin_amdgcn_cvt_pk_f32_fp8((int)y.y, false), a3 = __builtin_amdgcn_cvt_pk_f32_fp8((int)y.y, true);
                v[j][0] += w * a0[0]; v[j][1] += w * a0[1]; v[j][2] += w * a1[0]; v[j][3] += w * a1[1]; v[j][4] += w * a2[0]; v[j][5] += w * a2[1]; v[j][6] += w * a3[0]; v[j][7] += w * a3[1]; }
            if (sl == 4) {
#pragma unroll
                for (int j = 0; j < 4; ++j) asm volatile("" : "+v"(v[j][0]), "+v"(v[j][1]), "+v"(v[j][2]), "+v"(v[j][3]), "+v"(v[j][4]), "+v"(v[j][5]), "+v"(v[j][6]), "+v"(v[j][7]) :: "memory"); } }
#pragma unroll
        for (int j = 0; j < 4; ++j) { const u32x4 a = hr[j];
            v[j][0] += ALPHA * bflo(a.x); v[j][1] += ALPHA * bfhi(a.x); v[j][2] += ALPHA * bflo(a.y); v[j][3] += ALPHA * bfhi(a.y); v[j][4] += ALPHA * bflo(a.z); v[j][5] += ALPHA * bfhi(a.z); v[j][6] += ALPHA * bflo(a.w); v[j][7] += ALPHA * bfhi(a.w); }
        ln_store<OFB>(v, g, b, lane, of ? (OFB ? (float*)((bf16*)of + (size_t)row * D) : of + (size_t)row * D) : nullptr, ob ? ob + (size_t)row * D : nullptr, oq ? oq + (size_t)row * D : nullptr);
    }
}

struct Args { const float* in[34]; float* out; unsigned char* ws; int ph_lo, ph_hi, flags, pad; };
typedef const Args __attribute__((address_space(4)))* ArgP;
#ifndef PH_MASK
#define PH_MASK 0x7ff
#endif
#if MK_ONE
#define GRID_BAR() do { XcdBarrier b2_ = bar; asm volatile("" : "+s"(b2_.bar)); xcd_barrier(b2_); } while (0)
#else
#define GRID_BAR() do { } while (0)
#endif
#define IN(k) (((PH_MASK >> (((k)) % NPH)) & 1) && lo <= (k) && (k) < hi)
#define SEAM(k) do { if (IN(k) && IN((k) + 1)) GRID_BAR(); } while (0)
template <int L> __device__ __forceinline__ void layer_body(LAS unsigned char* lds, const int tid0, const int bid0, const int G, const int NGW, ArgP ap0, const XcdBarrier& bar, const int lo, const int hi) {
    {
        constexpr int l = L; constexpr int P = l * NPH;
#define PHASE_ENV() int tid = tid0 * 64 + (int)__builtin_amdgcn_mbcnt_hi(~0u, __builtin_amdgcn_mbcnt_lo(~0u, 0u)), bid = bid0; asm volatile("" : "+v"(tid)); asm volatile("" : "+s"(bid));     const int lane = tid & 63, wave = __builtin_amdgcn_readfirstlane(tid >> 6), gw = bid * 8 + wave; (void)lane; (void)gw; \
        ArgP ap = ap0; asm volatile("" : "+s"(ap)); InTab in = ap->in; unsigned char* ws = ap->ws; unsigned* ctl = (unsigned*)(ws + WS_CTL); bf16* projb = (bf16*)(ws + WS_PROJ); \
        float* hbuf = (float*)(ws + WS_H); bf16* hb = (bf16*)(ws + WS_HB); bf16* h1 = (bf16*)(ws + WS_H1); bf16* h1b = (bf16*)(ws + WS_H1B); unsigned char* wbase = ws + WS_W; \
        (void)in; (void)ctl; (void)projb; (void)hbuf; (void)hb; (void)h1; (void)h1b; (void)wbase
        if (IN(P + 0)) {
            PHASE_ENV();
            p0_convert(lds, in, l, wbase, gw, NGW, wave, lane);
            if (l == 0) {
                for (int row = gw; row < M; row += NGW) { float v[4][8];
#pragma unroll
                    for (int j = 0; j < 4; ++j) { const f32x4 x0 = *(const f32x4*)(in[0] + (size_t)row * D + 512 * j + 8 * lane), x1 = *(const f32x4*)(in[0] + (size_t)row * D + 512 * j + 8 * lane + 4);
#pragma unroll
                        for (int e = 0; e < 4; ++e) { v[j][e] = x0[e]; v[j][4 + e] = x1[e]; } }
                    ln_store(v, in[1], in[2], lane, nullptr, hb + (size_t)row * D, ws + WS_HQ + (size_t)row * D); }
            }
        }
        SEAM(P + 0);
        if (IN(P + 1)) {
            PHASE_ENV();
            { DenseSchedT<true> S; S.init(M, 11264, D, G, bid, wbase + W_IN8); EpiStoreF8 E{ws + WS_G8, ws + WS_Q8};
              pg8::gemm_phase<EpiStoreF8, DenseSchedT<true>, true>(lds, (const char*)(ws + WS_HQ), D, S, E, tid); }
            { int t2 = tid; asm volatile("" : "+v"(t2));
              DenseSchedT<true> S; S.init(M, N8 - 11264, D, G, bid, wbase + W_IN8 + (size_t)11264 * D); EpiStoreBf16 E{projb, LD, 11264};
              pg8::gemm_phase<EpiStoreBf16, DenseSchedT<true>, true>(lds, (const char*)(ws + WS_HQ), D, S, E, t2); }
        }
        SEAM(P + 1);
        if (IN(P + 2)) {
            PHASE_ENV();
#ifndef NO_SSD1
            ssd_states_phase(lds, projb, in[12] + (size_t)l * 4 * 1536, in[13] + (size_t)l * 1536, in[14] + l * 16, in[15] + l * 16,
                             (bf16*)(ws + WS_SST), (float*)(ws + WS_ALAST), G, bid, tid);
#endif
#ifndef NO_ATTN
            attn_phase(lds, projb, ws + WS_Q8, (bf16*)(ws + WS_OG), (float*)(ws + WS_LSE), G, bid, tid);
#endif
        }
        SEAM(P + 2);
        if (IN(P + 3)) {
            PHASE_ENV();
            ssd_pass_phase((const bf16*)(ws + WS_SST), (bf16*)(ws + WS_SSTB), (const float*)(ws + WS_ALAST), G, bid, tid);
            attn_merge((const bf16*)(ws + WS_OG), (const float*)(ws + WS_LSE), (bf16*)(ws + WS_YL) + 2048, gw, NGW, lane);
            lru_phase(lds, projb, in[5] + (size_t)l * 4 * 1024, in[6] + (size_t)l * 1024, (const bf16*)(wbase + W_LR), (const bf16*)(wbase + W_LI),
                      in[8] + l * 1024, in[10] + l * 1024, in[11] + l * 1024, (bf16*)(ws + WS_YL), G, bid, tid);
        }
        SEAM(P + 3);
        if (IN(P + 4)) {
            PHASE_ENV();
            ssd_out_phase(lds, projb, in[12] + (size_t)l * 4 * 1536, in[13] + (size_t)l * 1536, in[14] + l * 16, in[15] + l * 16,
                          in[16] + l * 16, in[17] + l * 1024, (const bf16*)(ws + WS_SSTB), (bf16*)(ws + WS_YL) + 1024, G, bid, tid);
        }
        SEAM(P + 4);
        if (IN(P + 5)) {
            PHASE_ENV();
            const float* bg = in[4] + (size_t)l * 3 * D;
            { DenseSched S; S.init(M, D, YLD, G, bid, wbase + W_PL); EpiGate3 E{ws + WS_G8, bg, (bf16*)(ws + WS_MB)};
              pg8::gemm_phase(lds, (const char*)(ws + WS_YL), YLD, S, E, tid); }
        }
        SEAM(P + 5);
        if (IN(P + 6)) {
            PHASE_ENV();
            DenseSched S; S.init(M, D, D, G, bid, wbase + W_OUT); EpiResid<true> E{(const void*)hb, (bf16*)(ws + WS_PRE)};
            pg8::gemm_phase(lds, (const char*)(ws + WS_MB), D, S, E, tid);
        }
        SEAM(P + 6);
        if (IN(P + 7)) {
            PHASE_ENV();
            router_phase(lds, (const bf16*)(ws + WS_PRE), in[22] + (size_t)l * D, in[23] + (size_t)l * D, (const bf16*)(wbase + W_RH), (const bf16*)(wbase + W_RL), in[25] + l * NE,
                         h1, h1b, ctl + CW_CNT + l * 64 * 16, (int*)(ws + WS_LTS), (float*)(ws + WS_LW), (int*)(ws + WS_TMAP), (int*)(ws + WS_WGCNT), G, bid, tid, ap->flags);
            GRID_BAR();
            router_lists(lds, (const int*)(ws + WS_WGCNT), ctl + CW_CNT + l * 64 * 16, (int*)(ws + WS_LTS), (float*)(ws + WS_LW), (int*)(ws + WS_TMAP), G, bid, tid);
        }
        SEAM(P + 7);
        if (IN(P + 8)) {
            PHASE_ENV();
            MoeSched<true> S; S.init(G, bid, ctl + CW_CNT + l * 64 * 16, (const int*)(ws + WS_LTS), wbase + W_UP, lane);
            EpiMoeUp E{ws + WS_HID};
            pg8::gemm_phase<EpiMoeUp, MoeSched<true>, true>(lds, (const char*)h1b, D, S, E, tid);
        }
        SEAM(P + 8);
        if (IN(P + 9)) {
            PHASE_ENV();
            MoeSched<false> S; S.init(G, bid, ctl + CW_CNT + l * 64 * 16, (const int*)(ws + WS_LTS), wbase + W_DN, lane);
            EpiMoeDown E{(bf16*)(ws + WS_Y)};
            pg8::gemm_phase<EpiMoeDown, MoeSched<false>, true>(lds, (const char*)(ws + WS_HID), EDIM, S, E, tid);
        }
        SEAM(P + 9);
        if (IN(P + 10)) {
            PHASE_ENV();
            const bool lastl = (l == DEPTH - 1);
            combine_phase<!lastl>((const bf16*)(ws + WS_Y), h1, (const int*)(ws + WS_TMAP), (const float*)(ws + WS_LW), ctl + CW_CNT + l * 64 * 16, in[32] + (size_t)l * D, in[33] + (size_t)l * D, lastl ? ap->out : (float*)hb, nullptr, lastl ? nullptr : ws + WS_HQ, gw, NGW, lane);
        }
        if (l + 1 < DEPTH) SEAM(P + 10);
    }
}
#undef IN
#undef SEAM
__global__ void __launch_bounds__(512, 2) fwd_kernel(Args args) {
    extern __shared__ __attribute__((aligned(16))) unsigned char lds_raw[];
    LAS unsigned char* lds = (LAS unsigned char*)lds_raw;
    const int tid0 = threadIdx.x;
    const int G = gridDim.x, bid0 = blockIdx.x, NGW = G * 8;
    ArgP ap0 = (ArgP)__builtin_amdgcn_kernarg_segment_ptr();
    volatile LAS unsigned* MISC = (volatile LAS unsigned*)(lds + MISC_OFF);
    if (tid0 < 16) MISC[tid0] = 0u;
    __syncthreads();
    XcdBarrier bar; bar.bar = (unsigned*)(ap0->ws + WS_CTL) + CW_BAR; bar.x = 0; bar.st = MISC;
#if MK_ONE
    bar = xcd_barrier_post((unsigned*)(ap0->ws + WS_CTL) + CW_BAR, MISC);
#endif
    const int lo = ap0->ph_lo, hi = ap0->ph_hi;
    const int wave0 = __builtin_amdgcn_readfirstlane(tid0 >> 6);
    layer_body<0>(lds, wave0, bid0, G, NGW, ap0, bar, lo, hi);
    layer_body<1>(lds, wave0, bid0, G, NGW, ap0, bar, lo, hi);
}


extern "C" void kernel_launch(void* const* d_in, const int* in_sizes, int n_in, void* d_out, int out_size, void* d_ws, size_t ws_size, hipStream_t stream) {
    static int grid = 0;
    if (grid == 0) {
        if (n_in != 34 || out_size != M * D || ws_size < WS_END) { fprintf(stderr, "kernel_launch: unexpected shapes (n_in %d out %d ws %zu)\n", n_in, out_size, ws_size); grid = -1; return; }
        int dev = 0, cus = 0, per_cu = 0;
        if (hipGetDevice(&dev) != hipSuccess || hipDeviceGetAttribute(&cus, hipDeviceAttributeMultiprocessorCount, dev) != hipSuccess) { grid = -1; return; }
        if (hipFuncSetAttribute((const void*)fwd_kernel, hipFuncAttributeMaxDynamicSharedMemorySize, LDS_BYTES) != hipSuccess) { fprintf(stderr, "kernel_launch: hipFuncSetAttribute failed\n"); grid = -1; return; }
        if (hipOccupancyMaxActiveBlocksPerMultiprocessor(&per_cu, (const void*)fwd_kernel, 512, LDS_BYTES) != hipSuccess || per_cu < 1)
            fprintf(stderr, "kernel_launch: occupancy query reports %d\n", per_cu);
        (void)hipGetLastError();
        grid = cus;
    }
    if (grid < 0) return;
    (void)hipMemsetAsync((char*)d_ws + WS_CTL, 0, CTL_BYTES, stream);
    Args a{};
    for (int i = 0; i < 34; ++i) a.in[i] = (const float*)d_in[i];
    a.out = (float*)d_out; a.ws = (unsigned char*)d_ws;
#if MK_ONE
    a.ph_lo = 0; a.ph_hi = DEPTH * NPH;
    hipLaunchKernelGGL(fwd_kernel, dim3(grid), dim3(512), LDS_BYTES, stream, a);
#ifdef PROBE_PHASE
    a.ph_lo = NPH + PROBE_PHASE; a.ph_hi = NPH + PROBE_PHASE + 1;
#ifdef PROBE_FLAGS
    a.flags = PROBE_FLAGS;
#endif
    hipLaunchKernelGGL(fwd_kernel, dim3(grid), dim3(512), LDS_BYTES, stream, a);
#endif
#else
    for (int p = 0; p < DEPTH * NPH; ++p) { a.ph_lo = p; a.ph_hi = p + 1; hipLaunchKernelGGL(fwd_kernel, dim3(grid), dim3(512), LDS_BYTES, stream, a); }
#endif
}
```
